# Optimizing an MI355X kernel written in HIP

```python
import math
import jax
import jax.numpy as jnp
from jax import lax
import numpy as np

D_MODEL = 1024
BATCH = 8
SEQ = 4096
DEPTH = 2

HEAD_DIM = 64
Q_BLOCK = 128
NORM_EPS = 1e-6

REL_BUCKETS = 32
REL_MAX_DIST = 2048

A_HEADS = 8
A_IDX_HEADS = 4
A_IDX_DIM = 64
A_TOPK_MAX = 256

B_HEADS = 8
B_KV_HEADS = 2
B_GROUP = B_HEADS // B_KV_HEADS
B_CMP_LEN = 32
B_CMP_STRIDE = 16
B_SEL_LEN = 64
B_SEL_TOPK_MAX = 16
B_WINDOW = 512
B_Q_BLOCK = 64

C_GROUPS = ((128, 1), (512, 4), (2048, 16))
C_HEADS_PER_GROUP = 4
C_HEADS = C_HEADS_PER_GROUP * len(C_GROUPS)
C_PAD = 2048

REL_HEADS = A_HEADS + B_HEADS + C_HEADS

D_FF = ((8 * D_MODEL + 3 * 256 - 1) // (3 * 256)) * 256

IN_SIZES = (
    A_HEADS * HEAD_DIM,
    HEAD_DIM,
    HEAD_DIM,
    A_IDX_HEADS * A_IDX_DIM,
    A_IDX_DIM,
    A_IDX_HEADS,
    B_HEADS * HEAD_DIM,
    6 * B_KV_HEADS * HEAD_DIM,
    3 * B_HEADS,
    3 * C_HEADS * HEAD_DIM,
    3 * D_MODEL,
)
IN_TOTAL = sum(IN_SIZES)

kernel_name = "hybrid_dsa_nsa_dilated_gated_block"


def _rms(x, g):
    xf = x.astype(jnp.float32)
    y = xf * lax.rsqrt(jnp.mean(xf * xf, axis=-1, keepdims=True) + NORM_EPS)
    return (y * g.astype(jnp.float32)).astype(x.dtype)


def _split_last(y, sizes):
    out, off = [], 0
    for n in sizes:
        out.append(y[..., off:off + n])
        off += n
    return out


def _rel_bucket(dist):
    n = jnp.maximum(dist, 0)
    exact = REL_BUCKETS // 2
    nf = jnp.maximum(n, 1).astype(jnp.float32)
    large = exact + (jnp.log(nf / exact) / math.log(REL_MAX_DIST / exact)
                     * (REL_BUCKETS - exact)).astype(jnp.int32)
    return jnp.where(n < exact, n, jnp.minimum(large, REL_BUCKETS - 1))


def _masked_softmax(logits, mask):
    s = jnp.where(mask, logits, -jnp.inf)
    m = jnp.max(s, axis=-1, keepdims=True)
    m = jnp.where(jnp.isfinite(m), m, 0.0)
    e = jnp.exp(s - m)
    den = jnp.sum(e, axis=-1, keepdims=True)
    p = e / jnp.maximum(den, 1e-30)
    lse = (m + jnp.log(den))[..., 0]
    return p, lse


def _sweep(fn, seq, block):
    out = lax.map(fn, jnp.arange(seq // block))
    out = jnp.moveaxis(out, 0, 1)
    return out.reshape((out.shape[0], seq) + out.shape[3:])


_gather_rows = jax.vmap(lambda a, i: a[i])


def _dsa_attention(q, k, v, iq, ik, iw, rel_tab):
    seq = q.shape[1]
    topk = min(A_TOPK_MAX, seq // 4)
    scale = HEAD_DIM ** -0.5
    keys = jnp.arange(seq)

    def block(i):
        q0 = i * Q_BLOCK
        t = q0 + jnp.arange(Q_BLOCK)
        qb = lax.dynamic_slice_in_dim(q, q0, Q_BLOCK, axis=1)
        iqb = lax.dynamic_slice_in_dim(iq, q0, Q_BLOCK, axis=1)
        iwb = lax.dynamic_slice_in_dim(iw, q0, Q_BLOCK, axis=1).astype(jnp.float32)
        rel = jax.nn.relu(jnp.einsum("bqhd,bsd->bqhs", iqb, ik, preferred_element_type=jnp.float32))
        score = jnp.einsum("bqhs,bqh->bqs", rel, iwb)
        score = jnp.where(keys[None, None, :] <= t[None, :, None], score, -jnp.inf)
        _, idx = lax.top_k(score, topk)
        kg = _gather_rows(k, idx)
        vg = _gather_rows(v, idx)
        dist = t[None, :, None] - idx
        bias = jnp.moveaxis(rel_tab[_rel_bucket(dist)], -1, 1)
        logits = jnp.einsum("bqhd,bqkd->bhqk", qb, kg, preferred_element_type=jnp.float32) * scale + bias
        p, _ = _masked_softmax(logits, (dist >= 0)[:, None])
        return jnp.einsum("bhqk,bqkd->bqhd", p.astype(vg.dtype), vg).astype(q.dtype)

    o = _sweep(block, seq, Q_BLOCK)
    return o.reshape(o.shape[:2] + (A_HEADS * HEAD_DIM,))


def _nsa_attention(q, kc, vc, ks, vs, kw, vw, gates, cmp_pos, cmp_w, k_gain, rel_tab):
    bsz, seq = q.shape[:2]
    G, Hg, Dh = B_KV_HEADS, B_GROUP, HEAD_DIM
    scale = Dh ** -0.5
    n_cmp = (seq - B_CMP_LEN) // B_CMP_STRIDE + 1
    n_sel = seq // B_SEL_LEN
    n_top = min(B_SEL_TOPK_MAX, n_sel)

    cidx = jnp.arange(n_cmp)[:, None] * B_CMP_STRIDE + jnp.arange(B_CMP_LEN)[None, :]

    def compress(src, pos, w):
        blk = src[:, cidx] + pos[:, None, :]
        return jnp.einsum("bnlgd,lde->bnge", blk, w)

    kcmp = _rms(compress(kc, cmp_pos[0], cmp_w[0]), k_gain)
    vcmp = compress(vc, cmp_pos[1], cmp_w[1])
    cstart = cidx[:, 0]
    cend = cidx[:, -1]
    sstart = jnp.arange(n_sel) * B_SEL_LEN
    overlap = ((cstart[:, None] < sstart[None, :] + B_SEL_LEN)
               & (cstart[:, None] + B_CMP_LEN > sstart[None, :])).astype(jnp.float32)
    ksb = jnp.moveaxis(ks.reshape(bsz, n_sel, B_SEL_LEN, G, Dh), 3, 1)
    vsb = jnp.moveaxis(vs.reshape(bsz, n_sel, B_SEL_LEN, G, Dh), 3, 1)
    wpad = ((0, 0), (B_WINDOW, 0), (0, 0), (0, 0))
    kw_pad = jnp.pad(kw, wpad)
    vw_pad = jnp.pad(vw, wpad)
    tab = rel_tab.reshape(REL_BUCKETS, G, Hg)
    sel_blocks = jnp.arange(n_sel)
    gather_blocks = jax.vmap(jax.vmap(lambda a, i: a[i]))
    bias_per_group = jax.vmap(lambda tb, bk: tb[bk], in_axes=(1, 1), out_axes=1)

    def block(i):
        q0 = i * B_Q_BLOCK
        t = q0 + jnp.arange(B_Q_BLOCK)
        qb = lax.dynamic_slice_in_dim(q, q0, B_Q_BLOCK, axis=1).reshape(bsz, B_Q_BLOCK, G, Hg, Dh)
        gb = lax.dynamic_slice_in_dim(gates, q0, B_Q_BLOCK, axis=1).reshape(bsz, B_Q_BLOCK, G, Hg, 3)
        lc = jnp.einsum("bqghd,bngd->bghqn", qb, kcmp, preferred_element_type=jnp.float32) * scale
        pc, _ = _masked_softmax(lc, cend[None, :] <= t[:, None])
        oc = jnp.einsum("bghqn,bngd->bqghd", pc.astype(vcmp.dtype), vcmp)
        imp = jnp.einsum("bghqn,nm->bgqm", pc, overlap)
        jt = (t // B_SEL_LEN)[:, None]
        forced = (sel_blocks[None] == 0) | (sel_blocks[None] == jt) | (sel_blocks[None] == jt - 1)
        imp = jnp.where(forced, jnp.inf, jnp.where(sel_blocks[None] <= jt, imp, -jnp.inf))
        _, sel = lax.top_k(imp, n_top)
        kg = gather_blocks(ksb, sel).reshape(bsz, G, B_Q_BLOCK, n_top * B_SEL_LEN, Dh)
        vg = gather_blocks(vsb, sel).reshape(bsz, G, B_Q_BLOCK, n_top * B_SEL_LEN, Dh)
        pos = (sel[..., None] * B_SEL_LEN + jnp.arange(B_SEL_LEN)).reshape(bsz, G, B_Q_BLOCK, -1)
        dist = t[None, None, :, None] - pos
        bias_s = jnp.moveaxis(bias_per_group(tab, _rel_bucket(dist)), -1, 2)
        ls = jnp.einsum("bqghd,bgqkd->bghqk", qb, kg, preferred_element_type=jnp.float32) * scale + bias_s
        ps, _ = _masked_softmax(ls, (dist >= 0)[:, :, None])
        osel = jnp.einsum("bghqk,bgqkd->bqghd", ps.astype(vg.dtype), vg)
        kwb = lax.dynamic_slice_in_dim(kw_pad, q0, B_Q_BLOCK + B_WINDOW, axis=1)
        vwb = lax.dynamic_slice_in_dim(vw_pad, q0, B_Q_BLOCK + B_WINDOW, axis=1)
        kpos = q0 - B_WINDOW + jnp.arange(B_Q_BLOCK + B_WINDOW)
        dw = t[:, None] - kpos[None, :]
        mw = (dw >= 0) & (dw < B_WINDOW) & (kpos[None, :] >= 0)
        bias_w = jnp.transpose(tab[_rel_bucket(dw)], (2, 3, 0, 1))
        lw = jnp.einsum("bqghd,bkgd->bghqk", qb, kwb, preferred_element_type=jnp.float32) * scale + bias_w
        pw, _ = _masked_softmax(lw, mw)
        ow = jnp.einsum("bghqk,bkgd->bqghd", pw.astype(vwb.dtype), vwb)
        o = gb[..., 0:1] * oc + gb[..., 1:2] * osel + gb[..., 2:3] * ow
        return o.reshape(bsz, B_Q_BLOCK, G * Hg * Dh).astype(q.dtype)

    return _sweep(block, seq, B_Q_BLOCK)


def _dilated_attention(q, k, v, rel_tab):
    bsz, seq = q.shape[:2]
    scale = HEAD_DIM ** -0.5
    pad = ((0, 0), (C_PAD, 0), (0, 0), (0, 0))
    hsl = [slice(g * C_HEADS_PER_GROUP, (g + 1) * C_HEADS_PER_GROUP) for g in range(len(C_GROUPS))]
    kps = [jnp.pad(k[:, :, hs], pad) for hs in hsl]
    vps = [jnp.pad(v[:, :, hs], pad) for hs in hsl]

    def block(i):
        q0 = i * Q_BLOCK
        t = q0 + jnp.arange(Q_BLOCK)
        qb = lax.dynamic_slice_in_dim(q, q0, Q_BLOCK, axis=1)
        outs, lses = [], []
        for gi, (win, dil) in enumerate(C_GROUPS):
            steps = jnp.arange(win // dil + 1) * dil
            pos = t[:, None] - steps[None, :]
            kg = jnp.take(kps[gi], pos + C_PAD, axis=1)
            vg = jnp.take(vps[gi], pos + C_PAD, axis=1)
            bias = rel_tab[_rel_bucket(steps), hsl[gi]].T[None, :, None, :]
            logits = jnp.einsum("bqhd,bqkhd->bhqk", qb[:, :, hsl[gi]], kg,
                                preferred_element_type=jnp.float32) * scale + bias
            p, lse = _masked_softmax(logits, (pos >= 0)[None, None])
            outs.append(jnp.einsum("bhqk,bqkhd->bqhd", p.astype(vg.dtype), vg))
            lses.append(lse)
        w = jax.nn.softmax(jnp.stack(lses), axis=0)
        w = jnp.transpose(w, (0, 1, 3, 2))[..., None]
        o = w[0] * outs[0]
        for gi in range(1, len(C_GROUPS)):
            o = o + w[gi] * outs[gi]
        return o.reshape(bsz, Q_BLOCK, C_HEADS_PER_GROUP * HEAD_DIM).astype(q.dtype)

    return _sweep(block, seq, Q_BLOCK)


def setup_inputs(seed: int = 0) -> dict:
    key = jax.random.key(seed)
    ks = jax.random.split(key, 14)

    def nrm(k, shape, scale):
        return jax.random.normal(k, shape, jnp.float32) * scale

    return {
        "x": nrm(ks[0], (BATCH, SEQ, D_MODEL), 1.0),
        "norm1_g": 1.0 + nrm(ks[1], (DEPTH, D_MODEL), 0.1),
        "norm2_g": 1.0 + nrm(ks[2], (DEPTH, D_MODEL), 0.1),
        "w_in": nrm(ks[3], (DEPTH, D_MODEL, IN_TOTAL), D_MODEL ** -0.5),
        "qk_norm_g": 1.0 + nrm(ks[4], (DEPTH, 6, HEAD_DIM), 0.1),
        "nsa_cmp_pos": nrm(ks[5], (DEPTH, 2, B_CMP_LEN, HEAD_DIM), 0.5),
        "nsa_cmp_w": nrm(ks[6], (DEPTH, 2, B_CMP_LEN, HEAD_DIM, HEAD_DIM), (B_CMP_LEN * HEAD_DIM) ** -0.5),
        "w_branch_a": nrm(ks[7], (DEPTH, A_HEADS * HEAD_DIM, D_MODEL), (A_HEADS * HEAD_DIM) ** -0.5),
        "w_branch_b": nrm(ks[8], (DEPTH, B_HEADS * HEAD_DIM, D_MODEL), (B_HEADS * HEAD_DIM) ** -0.5),
        "w_branch_c": nrm(ks[9], (DEPTH, C_HEADS_PER_GROUP * HEAD_DIM, D_MODEL), (C_HEADS_PER_GROUP * HEAD_DIM) ** -0.5),
        "w_out": nrm(ks[10], (DEPTH, D_MODEL, D_MODEL), D_MODEL ** -0.5),
        "w_ffn_in": nrm(ks[11], (DEPTH, D_MODEL, 2 * D_FF), D_MODEL ** -0.5),
        "w_ffn_out": nrm(ks[12], (DEPTH, D_FF, D_MODEL), D_FF ** -0.5),
        "rel_bias": nrm(ks[13], (REL_BUCKETS, REL_HEADS), 0.5),
    }


def reference(x, norm1_g, norm2_g, w_in, qk_norm_g, nsa_cmp_pos, nsa_cmp_w, w_branch_a, w_branch_b,
              w_branch_c, w_out, w_ffn_in, w_ffn_out, rel_bias):
    bsz, seq, _ = x.shape
    rel_a = rel_bias[:, :A_HEADS]
    rel_b = rel_bias[:, A_HEADS:A_HEADS + B_HEADS]
    rel_c = rel_bias[:, A_HEADS + B_HEADS:]
    for layer in range(DEPTH):
        h = _rms(x, norm1_g[layer])
        (a_q, a_k, a_v, i_q, i_k, i_w, b_q, b_kv, b_g, c_qkv, mix_g) = _split_last(h @ w_in[layer], IN_SIZES)
        qk = qk_norm_g[layer]
        a_q = _rms(a_q.reshape(bsz, seq, A_HEADS, HEAD_DIM), qk[0])
        a_k = _rms(a_k, qk[1])
        y_a = _dsa_attention(a_q, a_k, a_v, i_q.reshape(bsz, seq, A_IDX_HEADS, A_IDX_DIM), i_k, i_w,
                             rel_a) @ w_branch_a[layer]
        b_q = _rms(b_q.reshape(bsz, seq, B_HEADS, HEAD_DIM), qk[2])
        b_kv = b_kv.reshape(bsz, seq, 6, B_KV_HEADS, HEAD_DIM)
        b_gates = jax.nn.sigmoid(b_g).reshape(bsz, seq, B_HEADS, 3)
        y_b = _nsa_attention(b_q, b_kv[:, :, 0], b_kv[:, :, 1], _rms(b_kv[:, :, 2], qk[3]), b_kv[:, :, 3],
                             _rms(b_kv[:, :, 4], qk[3]), b_kv[:, :, 5], b_gates, nsa_cmp_pos[layer],
                             nsa_cmp_w[layer], qk[3], rel_b) @ w_branch_b[layer]
        c_qkv = c_qkv.reshape(bsz, seq, 3, C_HEADS, HEAD_DIM)
        y_c = _dilated_attention(_rms(c_qkv[:, :, 0], qk[4]), _rms(c_qkv[:, :, 1], qk[5]), c_qkv[:, :, 2],
                                 rel_c) @ w_branch_c[layer]
        g = jax.nn.sigmoid(mix_g).reshape(bsz, seq, 3, D_MODEL)
        x = x + (g[:, :, 0] * y_a + g[:, :, 1] * y_b + g[:, :, 2] * y_c) @ w_out[layer]
        h = _rms(x, norm2_g[layer])
        gate, up = jnp.split(h @ w_ffn_in[layer], 2, axis=-1)
        x = x + (jax.nn.silu(gate) * up) @ w_ffn_out[layer]
    return x
```

```cpp
#include <hip/hip_runtime.h>
#include <cstdio>
#include <cstdint>

#ifndef MK_SINGLE
#define MK_SINGLE 1
#endif
#ifndef DUP
#define DUP 0
#endif
#ifndef PHMASK
#define PHMASK 0xff
#define DUPA 0
#endif
#ifndef MK_MIXERS
#define MK_MIXERS 7
#endif

#define GAS __attribute__((address_space(1)))
#define LAS __attribute__((address_space(3)))
typedef unsigned short bf16;
typedef short bf16x8 __attribute__((ext_vector_type(8)));
typedef float f32x4 __attribute__((ext_vector_type(4)));
typedef float f32x2 __attribute__((ext_vector_type(2)));
typedef float f32x16 __attribute__((ext_vector_type(16)));
typedef unsigned u32x4 __attribute__((ext_vector_type(4)));
typedef unsigned u32x2 __attribute__((ext_vector_type(2)));
typedef short s16x4_t __attribute__((ext_vector_type(4)));
typedef short v4i16_t __attribute__((ext_vector_type(4)));

constexpr int BATCH = 8, SEQ = 4096, DM = 1024, NTOK = BATCH * SEQ, DFF = 2816, NLAYER = 2, IN_TOTAL = 7644;
constexpr int N_MAIN = 6656, N_VT = 1280, N_FF2 = 5632;
constexpr float NEPS = 1e-6f, LOG2E = 1.4426950408889634f, QSCALE = 0.125f * LOG2E;
constexpr int TABS = 1668;
constexpr int TABC = 192;

typedef __bf16 bf16x2_t __attribute__((ext_vector_type(2)));
__device__ __forceinline__ unsigned cvt_pk_bf16(float lo, float hi) { const f32x2 v = {lo, hi}; return __builtin_bit_cast(unsigned, __builtin_convertvector(v, bf16x2_t)); }
__device__ __forceinline__ unsigned f2bf(float f) { unsigned u = __builtin_bit_cast(unsigned, f); return (u + 0x7fffu + ((u >> 16) & 1u)) >> 16; }
__device__ __forceinline__ unsigned pk2(float lo, float hi) { return f2bf(lo) | (f2bf(hi) << 16); }
__device__ __forceinline__ float bflo(unsigned w) { return __builtin_bit_cast(float, w << 16); }
__device__ __forceinline__ float bfhi(unsigned w) { return __builtin_bit_cast(float, w & 0xffff0000u); }
__device__ __forceinline__ float fsigmoid(float v) { return __builtin_amdgcn_rcpf(1.f + __builtin_amdgcn_exp2f(-v * LOG2E)); }
__device__ __forceinline__ float shx(float v, int m) { return __shfl_xor(v, m); }
__device__ __forceinline__ float xsum16(float v) { const auto r = __builtin_amdgcn_permlane16_swap(__float_as_uint(v), __float_as_uint(v), false, false); return __uint_as_float(r[0]) + __uint_as_float(r[1]); }
__device__ __forceinline__ float xsum32(float v) { const auto r = __builtin_amdgcn_permlane32_swap(__float_as_uint(v), __float_as_uint(v), false, false); return __uint_as_float(r[0]) + __uint_as_float(r[1]); }

namespace pg8 {
constexpr int BM = 256, BK = 64, HALF = 128, HTB = HALF * BK * 2, STAGE_BYTES = 8 * HTB, NXCD = 8, WGM = 8;
__host__ __device__ __forceinline__ int lds_byte(int r, int c) { const int st = (r >> 4) * 2 + (c >> 5), rr = r & 15, cc = c & 31, ob = rr * 64 + cc * 2; return st * 1024 + (ob ^ (((ob >> 9) & 1) << 5)); }
__host__ __device__ __forceinline__ void stage_rc(int b, int& R, int& C) { const int st = b / 1024, sb = b % 1024, swz = sb ^ (((sb >> 9) & 1) << 5); R = (st >> 1) * 16 + swz / 64; C = (st & 1) * 32 + (swz % 64) / 2; }
__host__ __device__ __forceinline__ int perm32(int rho) { const int n = rho >> 4, i = rho & 15; return 8 * (i >> 2) + 4 * n + (i & 3); }

struct Unit { int pm, pn, w; };
struct Gemm { const bf16* A; const bf16* Bt; int M, N, K, lda, ldb_;
    __device__ __forceinline__ const char* aptr(const Unit& u) const { return (const char*)A + (size_t)u.pm * BM * lda * 2; }
    __device__ __forceinline__ const char* bptr(const Unit& u) const { return (const char*)Bt + (size_t)u.pn * BM * ldb_ * 2; }
    __device__ __forceinline__ int ldb(const Unit&) const { return ldb_; }
};
struct GemmP1 { const bf16* xb; const bf16* win; const bf16* wvt; static constexpr int K = 1024, lda = 1024;
    __device__ __forceinline__ const char* aptr(const Unit& u) const {
        if (u.w == 0) return (const char*)xb + (size_t)u.pm * BM * 1024 * 2;
        const int rb = u.w == 1 ? 0 : (u.w == 2 ? 768 : 1024);
        return (const char*)wvt + ((size_t)rb + (size_t)u.pm * BM) * 1024 * 2; }
    __device__ __forceinline__ const char* bptr(const Unit& u) const {
        if (u.w == 0) return (const char*)win + (size_t)u.pn * BM * 1024 * 2;
        const int dil = u.w == 1 ? 1 : (u.w == 2 ? 4 : 16);
        const int p0 = (u.pn & 15) * 256, bl = u.pn >> 4, L = SEQ / dil, r = p0 / L, n0 = p0 % L;
        return (const char*)xb + ((size_t)bl * SEQ + r + (size_t)dil * n0) * 1024 * 2; }
    __device__ __forceinline__ int ldb(const Unit& u) const { return u.w <= 1 ? 1024 : (u.w == 2 ? 4096 : 16384); }
};
struct StaticOrder {
    int nM, nN, nwg, G, c;
    __host__ __device__ void init(int M, int N, int G_, int c_) { nM = M / BM; nN = N / BM; nwg = nM * nN; G = G_; c = c_; }
    __host__ __device__ void map(int L, Unit& u) const {
        int wgid = L; { const int q = nwg / NXCD, r = nwg % NXCD, xcd = wgid % NXCD, off = wgid / NXCD; wgid = (xcd < r ? xcd * (q + 1) : r * (q + 1) + (xcd - r) * q) + off; }
        const int nig = WGM * nN, gid = wgid / nig, fm = gid * WGM, gsz = (nM - fm) < WGM ? (nM - fm) : WGM;
        u.pm = fm + ((wgid % nig) % gsz); u.pn = (wgid % nig) / gsz; u.w = 0; }
    __host__ __device__ bool next(int i, Unit& u) const { const long L = (long)i * G + c; if (L >= nwg) return false; map((int)L, u); return true; }
};
template <int T>
struct P1Order {
    static constexpr int ntn = T / BM, nwg0 = ntn * (N_MAIN / BM);
    int G, c;
    __host__ __device__ void init(int G_, int c_) { G = G_; c = c_; }
    __host__ __device__ bool next(int i, Unit& u) const {
        const int L = i * G + c;
        if (L < nwg0) { StaticOrder so; so.nM = ntn; so.nN = N_MAIN / BM; so.nwg = nwg0; so.G = G; so.c = c; so.map(L, u); return true; }
        const int q = L - nwg0;
        if (q < 3 * ntn) { u.w = 1; u.pm = q % 3; u.pn = q / 3; return true; }
        if (q < 5 * ntn) { const int q2 = q - 3 * ntn; u.w = 2 + q2 / ntn; u.pm = 0; u.pn = q2 % ntn; return true; }
        return false; }
};

template <class Epi, class GD = Gemm, class Sched = StaticOrder>
__device__ __forceinline__ void gemm_phase(LAS unsigned char* lds, const GD g, const Sched& S, const Epi& E) {
    int tid = threadIdx.x; asm volatile("" : "+v"(tid));
    const int wid = __builtin_amdgcn_readfirstlane(tid >> 6), lane = tid & 63, wr = wid >> 2, wc = wid & 3, fr = lane & 15, fq = lane >> 4;
    const int K = g.K, nt = K / BK;
    unsigned voffA[2], voffB[2];
#pragma unroll
    for (int i = 0; i < 2; ++i) { int R, C; stage_rc(tid * 16 + i * 8192, R, C); voffA[i] = (unsigned)(R * g.lda + C) * 2u; }
#define PG8_VOFFB(ldb_) do { int _t = tid; asm volatile("" : "+v"(_t)); _Pragma("unroll") for (int _i = 0; _i < 2; ++_i) { int R, C; stage_rc(_t * 16 + _i * 8192, R, C); \
        const int Rb = (R & ~31) + perm32(R & 31); voffB[_i] = (unsigned)(Rb * (ldb_) + C) * 2u; } } while (0)
    const size_t kstep = (size_t)(BK * 2);
    const size_t hsA = (size_t)HALF * g.lda * 2;
    const unsigned ldsw = (unsigned)wid * 1024u;
    const int aoff = lds_byte(wr * 64 + fr, fq * 8), boff = lds_byte(wc * 32 + fr, fq * 8);
#define PG8_SA(b, h) (((b) * 2 + (h)) * HTB)
#define PG8_SB(b, h) ((4 + (b) * 2 + (h)) * HTB)
#define PG8_STAGE(bufoff, gbase, voff) do { _Pragma("unroll") for (int _i = 0; _i < 2; ++_i) \
        __builtin_amdgcn_global_load_lds((const unsigned*)((const char*)(gbase) + (voff)[_i]), (LAS unsigned*)(lds + (bufoff) + ldsw + _i * 8192), 16, 0, 0); } while (0)
#define PG8_LDA(dst, b, h) do { _Pragma("unroll") for (int m = 0; m < 4; ++m) _Pragma("unroll") for (int k = 0; k < 2; ++k) dst[m][k] = *(const LAS bf16x8*)(lds + PG8_SA(b, h) + aoff + m * 2048 + k * 1024); } while (0)
#define PG8_LDB(dst, b, h) do { _Pragma("unroll") for (int n = 0; n < 2; ++n) _Pragma("unroll") for (int k = 0; k < 2; ++k) dst[n][k] = *(const LAS bf16x8*)(lds + PG8_SB(b, h) + boff + n * 2048 + k * 1024); } while (0)
#define PG8_MMA(ai, bj, At, Bt) do { __builtin_amdgcn_s_setprio(1); _Pragma("unroll") for (int m = 0; m < 4; ++m) _Pragma("unroll") for (int n = 0; n < 2; ++n) _Pragma("unroll") for (int k = 0; k < 2; ++k) \
        acc[ai][bj][m][n] = __builtin_amdgcn_mfma_f32_16x16x32_bf16(Bt[n][k], At[m][k], acc[ai][bj][m][n], 0, 0, 0); __builtin_amdgcn_s_setprio(0); } while (0)
#define PG8_WAIT_V(n) asm volatile("s_waitcnt vmcnt(" #n ")" ::: "memory")
#define PG8_WAIT_L(n) asm volatile("s_waitcnt lgkmcnt(" #n ")" ::: "memory")
#define PG8_BAR __builtin_amdgcn_s_barrier()
#define PG8_SCHED __builtin_amdgcn_sched_barrier(0)
    Unit cur, nxt; int ui = 0;
    if (!S.next(0, cur)) return;
    f32x4 acc[2][2][4][2];
#pragma unroll
    for (int a = 0; a < 2; ++a)
#pragma unroll
        for (int b = 0; b < 2; ++b)
#pragma unroll
            for (int m = 0; m < 4; ++m)
#pragma unroll
                for (int n = 0; n < 2; ++n) acc[a][b][m][n] = (f32x4){0.f, 0.f, 0.f, 0.f};
    bf16x8 At[4][2], B0[2][2], B1[2][2];
    const char* cA = g.aptr(cur); const char* cB = g.bptr(cur);
    int ldbc = g.ldb(cur); size_t hsB = (size_t)HALF * ldbc * 2;
    PG8_VOFFB(ldbc);
    PG8_STAGE(PG8_SB(0, 0), cB, voffB); PG8_STAGE(PG8_SB(0, 1), cB + hsB, voffB); PG8_STAGE(PG8_SA(0, 0), cA, voffA); PG8_STAGE(PG8_SA(0, 1), cA + hsA, voffA);
    if (wr == 1) PG8_BAR;
    PG8_WAIT_V(2); PG8_BAR;
    PG8_STAGE(PG8_SB(1, 0), cB + kstep, voffB); PG8_STAGE(PG8_SA(1, 0), cA + kstep, voffA); PG8_STAGE(PG8_SB(1, 1), cB + hsB + kstep, voffB);
    PG8_WAIT_V(6); PG8_BAR;
    for (;;) {
        const bool has_next = S.next(ui + 1, nxt);
        const char* nA = has_next ? g.aptr(nxt) : cA; const char* nB = has_next ? g.bptr(nxt) : cB;
        const int ldbn = has_next ? g.ldb(nxt) : ldbc;
        for (int t = 0; t < nt; t += 2) {
            const bool last = (t == nt - 2);
            if (last && ldbn != ldbc) { ldbc = ldbn; hsB = (size_t)HALF * ldbc * 2; PG8_VOFFB(ldbc); }
            const char* a1 = cA + (size_t)(t + 1) * kstep;
            const char* a2 = last ? nA : cA + (size_t)(t + 2) * kstep; const char* b2 = last ? nB : cB + (size_t)(t + 2) * kstep;
            const char* a3 = a2 + kstep; const char* b3 = b2 + kstep;
            PG8_LDB(B0, 0, 0); PG8_LDB(B1, 0, 1); PG8_SCHED; PG8_LDA(At, 0, 0); PG8_STAGE(PG8_SA(1, 1), a1 + hsA, voffA);
            PG8_WAIT_V(8); PG8_WAIT_L(0); PG8_BAR; PG8_MMA(0, 0, At, B0); PG8_MMA(0, 1, At, B1); PG8_BAR; PG8_SCHED;
            PG8_LDA(At, 0, 1); PG8_STAGE(PG8_SB(0, 0), b2, voffB); PG8_STAGE(PG8_SB(0, 1), b2 + hsB, voffB); PG8_STAGE(PG8_SA(0, 0), a2, voffA);
            PG8_WAIT_V(8); PG8_WAIT_L(0); PG8_BAR; PG8_MMA(1, 0, At, B0); PG8_MMA(1, 1, At, B1); PG8_BAR; PG8_SCHED;
            PG8_LDB(B0, 1, 0); PG8_LDB(B1, 1, 1); PG8_SCHED; PG8_LDA(At, 1, 0); PG8_STAGE(PG8_SA(0, 1), a2 + hsA, voffA);
            PG8_WAIT_V(8); PG8_WAIT_L(0); PG8_BAR; PG8_MMA(0, 0, At, B0); PG8_MMA(0, 1, At, B1); PG8_BAR; PG8_SCHED;
            PG8_LDA(At, 1, 1); PG8_STAGE(PG8_SB(1, 0), b3, voffB); PG8_STAGE(PG8_SB(1, 1), b3 + hsB, voffB); PG8_STAGE(PG8_SA(1, 0), a3, voffA);
            PG8_WAIT_V(8); PG8_WAIT_L(0); PG8_BAR; PG8_MMA(1, 0, At, B0); PG8_MMA(1, 1, At, B1); PG8_BAR; PG8_SCHED;
        }
        if (wr == 0) PG8_BAR;
        E(acc, cur, wr, wc, fr, fq);
        if (!has_next) break;
#pragma unroll
        for (int a = 0; a < 2; ++a)
#pragma unroll
            for (int b = 0; b < 2; ++b)
#pragma unroll
                for (int m = 0; m < 4; ++m)
#pragma unroll
                    for (int n = 0; n < 2; ++n) acc[a][b][m][n] = (f32x4){0.f, 0.f, 0.f, 0.f};
        cur = nxt; cA = nA; cB = nB; ++ui;
        if (wr == 1) PG8_BAR;
    }
    PG8_WAIT_V(0);
    PG8_BAR;
#undef PG8_VOFFB
#undef PG8_SA
#undef PG8_SB
#undef PG8_STAGE
#undef PG8_LDA
#undef PG8_LDB
#undef PG8_MMA
#undef PG8_WAIT_V
#undef PG8_WAIT_L
#undef PG8_BAR
#undef PG8_SCHED
}
}
typedef f32x4 AccT[2][2][4][2];

constexpr size_t MiB = 1u << 20;
struct WSMap {
    size_t ctl, biasA, biasB, biasC, cmpb, w[NLAYER][10], xb, ssq1, ssq2;
    size_t aq, ak, av, iq, ik, misc, bq, bkc, bvc, bks, bkw, cq, ck, mixg, avt, bvst, bvwt, cvt, kcmp, vcmpt, oa, ob, oc, cgo, cgl, mb, hid, end;
};
enum { W_IN = 0, W_VT, W_BA, W_BB, W_BC, W_OUT, W_FI, W_FO, W_CK, W_CV };
__host__ __device__ constexpr WSMap make_map(int nbc) {
    WSMap m{}; size_t o = 0;
    m.ctl = o; o += MiB;
    m.biasA = o; o += 64 * 1024; m.biasB = o; o += 64 * 1024; m.biasC = o; o += 16 * 1024; m.cmpb = o; o += 16 * 1024;
    o = 2 * MiB;
    const size_t wsz[10] = {(size_t)N_MAIN * 1024 * 2, (size_t)N_VT * 1024 * 2, 1024 * 512 * 2, 1024 * 512 * 2, 1024 * 256 * 2, 1024 * 1024 * 2, (size_t)N_FF2 * 1024 * 2, (size_t)1024 * DFF * 2, 256 * 2048 * 2, 256 * 2048 * 2};
    for (int l = 0; l < NLAYER; ++l) for (int i = 0; i < 10; ++i) { m.w[l][i] = o; o += wsz[i]; }
    o = (o + MiB - 1) / MiB * MiB;
    m.xb = o; o += (size_t)NTOK * DM * 2;
    m.ssq1 = o; o += (size_t)NTOK * 16 * 4; m.ssq2 = o; o += (size_t)NTOK * 16 * 4;
    m.mb = o; o += (size_t)NTOK * 1024 * 2;
    const size_t chunk0 = o;
    const size_t T = (size_t)nbc * SEQ;
    m.aq = o; o += T * 512 * 2; m.ak = o; m.av = o + 128; o += T * 128 * 2;        m.iq = o; o += T * 256 * 2; m.ik = o; o += T * 64 * 2; m.misc = o; o += T * 32 * 4;
    m.bq = o; o += T * 512 * 2; m.bkc = o; o += T * 128 * 2 + 4096; m.bvc = o; o += T * 128 * 2 + 4096; m.bks = o; o += T * 128 * 2; m.bkw = o; o += T * 128 * 2;
    m.cq = o; o += T * 768 * 2; m.ck = o; o += T * 768 * 2; m.mixg = o; o += T * 3072;
    m.avt = o; o += T * 64 * 2; m.bvst = o; o += T * 128 * 2; m.bvwt = o; o += T * 128 * 2; m.cvt = o; o += T * 768 * 2;
    m.kcmp = o; o += (size_t)nbc * 2 * 256 * 64 * 2; m.vcmpt = o; o += (size_t)nbc * 2 * 256 * 64 * 2;
    m.oa = o; o += T * 512 * 2; m.ob = o; o += T * 512 * 2; m.oc = o; o += T * 256 * 2;
    m.cgo = o; o += T * 768 * 2; m.cgl = o; o += T * 12 * 4;
    m.hid = chunk0;
    if (o < chunk0 + (size_t)NTOK * DFF * 2) o = chunk0 + (size_t)NTOK * DFF * 2;
    m.end = o;
    return m;
}

constexpr int NBC = 4, NCH = BATCH / NBC, TCH = NBC * SEQ;
constexpr WSMap MP = make_map(NBC);

#define XB_TMO      128
#define XB_XCNT(j)  (256  + 64 * (j))
#define XB_XSUB(j)  (1280 + 64 * (j))
#define XB_XGEN(j)  (2304 + 64 * (j))
#define XB_TOP      3328
#define XB_TOPGEN   3392
#define XCD_BAR_WORDS 3456
#define XB_SPIN_CAP (1u << 21)
__device__ __forceinline__ unsigned xb_ld(unsigned* p)              { return __hip_atomic_load(p, __ATOMIC_RELAXED, __HIP_MEMORY_SCOPE_AGENT); }
__device__ __forceinline__ unsigned xb_add(unsigned* p, unsigned v) { return __hip_atomic_fetch_add(p, v, __ATOMIC_RELAXED, __HIP_MEMORY_SCOPE_AGENT); }
__device__ __forceinline__ unsigned xb_xcc_id() { return (unsigned)__builtin_amdgcn_s_getreg((3 << 11) | 20) & 0xFu; }
#define XB_SPIN(cond, bar) do { unsigned _sp = 0; while (cond) { __builtin_amdgcn_s_sleep(1); \
    if ((++_sp & 255u) == 0u) { if (xb_ld(&(bar)[XB_TMO])) break; if (_sp > XB_SPIN_CAP) { atomicAdd(&(bar)[XB_TMO], 1u); break; } } } } while (0)
struct XcdBarrier { unsigned* bar; unsigned x; volatile LAS unsigned* st; };
__device__ __forceinline__ XcdBarrier xcd_barrier_post(unsigned* bar, volatile LAS unsigned* st) {
    XcdBarrier b; b.bar = bar; b.x = xb_xcc_id(); b.st = st;
    if (threadIdx.x == 0) (void)xb_add(&bar[XB_XCNT(b.x)], 1u);
    return b;
}
__device__ __forceinline__ void xcd_barrier_complete(unsigned* bar, unsigned x, unsigned& nloc, unsigned& nx) {
    const unsigned G = gridDim.x * gridDim.y * gridDim.z;
    unsigned sum, cnt, mine, sp = 0u;
    for (;;) {
        sum = 0u; cnt = 0u; mine = 0u;
#pragma unroll
        for (unsigned j = 0; j < 16; ++j) { const unsigned c = xb_ld(&bar[XB_XCNT(j)]); sum += c; cnt += (c > 0u) ? 1u : 0u; mine = (j == x) ? c : mine; }
        if (sum == G) break;
        __builtin_amdgcn_s_sleep(1);
        if ((++sp & 255u) == 0u) { if (xb_ld(&bar[XB_TMO])) break; if (sp > XB_SPIN_CAP) { atomicAdd(&bar[XB_TMO], 1u); break; } }
    }
    nloc = mine > 0u ? mine : 1u; nx = cnt > 0u ? cnt : 1u;
}
__device__ __forceinline__ void xcd_barrier(const XcdBarrier& b) {
    asm volatile("s_waitcnt vmcnt(0)" ::: "memory");
    __syncthreads();
    if (threadIdx.x == 0) {
        unsigned* bar = b.bar;
        __builtin_amdgcn_s_waitcnt(0);
        unsigned nloc = b.st[0], nx = b.st[1];
        if (nloc == 0u) { xcd_barrier_complete(bar, b.x, nloc, nx); b.st[0] = nloc; b.st[1] = nx; }
        const unsigned old = xb_add(&bar[XB_XSUB(b.x)], 1u);
        const unsigned gen = old / nloc;
        if (old + 1u == (gen + 1u) * nloc) {
            __builtin_amdgcn_fence(__ATOMIC_RELEASE, "agent");
            asm volatile("s_waitcnt vmcnt(0)" ::: "memory");
            const unsigned og = xb_add(&bar[XB_TOP], 1u);
            const unsigned tg = og / nx;
            if (og + 1u == (tg + 1u) * nx) xb_add(&bar[XB_TOPGEN], 1u);
            else XB_SPIN(xb_ld(&bar[XB_TOPGEN]) == tg, bar);
            __builtin_amdgcn_fence(__ATOMIC_ACQUIRE, "agent");
            xb_add(&bar[XB_XGEN(b.x)], 1u);
            asm volatile("s_waitcnt vmcnt(0)" ::: "memory");
        } else {
            XB_SPIN(xb_ld(&bar[XB_XGEN(b.x)]) == gen, bar);
            __builtin_amdgcn_fence(__ATOMIC_ACQUIRE, "agent");
            asm volatile("s_waitcnt vmcnt(0)" ::: "memory");
        }
    }
    __syncthreads();
}

struct Args {
    const float* in[14];
    float* out; unsigned char* ws; int ph_lo, ph_hi, nbc, li;
};

__device__ __forceinline__ float row_rstd(const float* ssq, int row, int fq) {
    const f32x4 p = *(const f32x4*)(ssq + (size_t)row * 16 + 4 * fq);
    float s = (p[0] + p[1]) + (p[2] + p[3]); s = xsum16(s); s = xsum32(s);
    return __builtin_amdgcn_rsqf(s * (1.f / DM) + NEPS);
}
__device__ __forceinline__ int rowmap_p(int t, int rm) { return rm == 0 ? t : (rm == 1 ? (((t & 3) << 10) | (t >> 2)) : (((t & 15) << 8) | (t >> 4))); }

struct EpiIn {
    const float* ssq; const float* qkg; unsigned char* ws;
    __device__ __forceinline__ void operator()(const AccT& acc, const pg8::Unit& u, int wr, int wc, int fr, int fq) const {
        constexpr int T = TCH;
        bf16 *aq = (bf16*)(ws + MP.aq), *ak = (bf16*)(ws + MP.ak), *iq = (bf16*)(ws + MP.iq), *ik = (bf16*)(ws + MP.ik), *bq = (bf16*)(ws + MP.bq), *bkc = (bf16*)(ws + MP.bkc), *bvc = (bf16*)(ws + MP.bvc),
             *bks = (bf16*)(ws + MP.bks), *bkw = (bf16*)(ws + MP.bkw), *cq = (bf16*)(ws + MP.cq), *ck = (bf16*)(ws + MP.ck), *mixg = (bf16*)(ws + MP.mixg); float* misc = (float*)(ws + MP.misc);
        const int s = 4 * u.pn + wc;
        int gain = -1, sig = 0, rm = 0, pitch = 64; float scale = 1.f; bf16* base; size_t bstr = (size_t)SEQ * 64;
        if (s < 8) { base = aq + 64 * s; pitch = 512; bstr = (size_t)SEQ * 512; gain = 0; scale = QSCALE; }
        else if (s == 8) { base = ak; gain = 1; pitch = 128; bstr = (size_t)SEQ * 128; }
        else if (s < 13) { base = iq + 64 * (s - 9); pitch = 256; bstr = (size_t)SEQ * 256; }
        else if (s == 13) { base = ik; }
        else if (s == 14) { base = nullptr; }
        else if (s < 23) { base = bq + 64 * (s - 15); pitch = 512; bstr = (size_t)SEQ * 512; gain = 2; scale = QSCALE; }
        else if (s < 25) { base = bkc + (size_t)(s - 23) * SEQ * 64; bstr = (size_t)2 * SEQ * 64; }
        else if (s < 27) { base = bvc + (size_t)(s - 25) * SEQ * 64; bstr = (size_t)2 * SEQ * 64; }
        else if (s < 29) { base = bks + (size_t)(s - 27) * SEQ * 64; bstr = (size_t)2 * SEQ * 64; gain = 3; }
        else if (s < 31) { base = bkw + (size_t)(s - 29) * SEQ * 64; bstr = (size_t)2 * SEQ * 64; gain = 3; }
        else if (s < 43) { base = cq + (size_t)(s - 31) * T * 64; gain = 4; scale = QSCALE; rm = (s - 31) >> 2; }
        else if (s < 55) { base = ck + (size_t)(s - 43) * T * 64; gain = 5; rm = (s - 43) >> 2; }
        else if (s < 103) { base = mixg; sig = 1; }
        else { base = (bf16*)(ws + MP.av); pitch = 128; bstr = (size_t)SEQ * 128; }
        f32x4 gv[2][2];
        if (gain >= 0) {
#pragma unroll
            for (int bj = 0; bj < 2; ++bj)
#pragma unroll
                for (int n = 0; n < 2; ++n) gv[bj][n] = *(const f32x4*)(qkg + gain * 64 + 32 * bj + 8 * fq + 4 * n) * scale;
        }
        float rsv[2][4];
        { f32x4 pq[2][4];
#pragma unroll
          for (int ai = 0; ai < 2; ++ai)
#pragma unroll
              for (int m = 0; m < 4; ++m) pq[ai][m] = *(const f32x4*)(ssq + (size_t)(u.pm * 256 + 128 * ai + 64 * wr + 16 * m + fr) * 16 + 4 * fq);
          __builtin_amdgcn_sched_barrier(0);
#pragma unroll
          for (int ai = 0; ai < 2; ++ai)
#pragma unroll
              for (int m = 0; m < 4; ++m) { const f32x4 p = pq[ai][m]; float sm = (p[0] + p[1]) + (p[2] + p[3]); sm = xsum16(sm); sm = xsum32(sm); rsv[ai][m] = __builtin_amdgcn_rsqf(sm * (1.f / DM) + NEPS); } }
        if (sig) rows<0>(acc, u, wr, fr, fq, rsv, s, base, pitch, bstr, rm, gv, misc, mixg);
        else if (s == 14) rows<1>(acc, u, wr, fr, fq, rsv, s, base, pitch, bstr, rm, gv, misc, mixg);
        else if (gain >= 0) rows<2>(acc, u, wr, fr, fq, rsv, s, base, pitch, bstr, rm, gv, misc, mixg);
        else rows<3>(acc, u, wr, fr, fq, rsv, s, base, pitch, bstr, rm, gv, misc, mixg);
    }
    template <int MODE>
    __device__ __forceinline__ void rows(const AccT& acc, const pg8::Unit& u, int wr, int fr, int fq, const float (&rsv)[2][4], int s, bf16* base, int pitch, size_t bstr, int rm,
                                         const f32x4 (&gv)[2][2], float* misc, bf16* mixg) const {
#pragma unroll
        for (int ai = 0; ai < 2; ++ai)
#pragma unroll
            for (int m = 0; m < 4; ++m) {
                const int tl = u.pm * 256 + 128 * ai + 64 * wr + 16 * m + fr;
                const float rs = rsv[ai][m];
                f32x4 v[2][2];
#pragma unroll
                for (int bj = 0; bj < 2; ++bj)
#pragma unroll
                    for (int n = 0; n < 2; ++n) v[bj][n] = acc[ai][bj][m][n] * rs;
                if (MODE == 1) {
#pragma unroll
                    for (int n = 0; n < 2; ++n) { f32x4 o = v[0][n];
#pragma unroll
                        for (int j = 0; j < 4; ++j) { const int col = 8 * fq + 4 * n + j; if (col >= 4) o[j] = fsigmoid(o[j]); }
                        *(f32x4*)(misc + (size_t)tl * 32 + 8 * fq + 4 * n) = o; }
                    continue;
                }
                if (MODE == 2) {
                    float ss = 0.f;
#pragma unroll
                    for (int bj = 0; bj < 2; ++bj)
#pragma unroll
                        for (int n = 0; n < 2; ++n) ss += (v[bj][n][0] * v[bj][n][0] + v[bj][n][1] * v[bj][n][1]) + (v[bj][n][2] * v[bj][n][2] + v[bj][n][3] * v[bj][n][3]);
                    ss = xsum16(ss); ss = xsum32(ss);
                    const float inv = __builtin_amdgcn_rsqf(ss * (1.f / 64.f) + NEPS);
#pragma unroll
                    for (int bj = 0; bj < 2; ++bj)
#pragma unroll
                        for (int n = 0; n < 2; ++n) v[bj][n] = v[bj][n] * inv * gv[bj][n];
                }
                if (MODE == 0) {
                    unsigned q[2][2];
#pragma unroll
                    for (int bj = 0; bj < 2; ++bj)
#pragma unroll
                        for (int n = 0; n < 2; ++n) { unsigned b[4];
#pragma unroll
                            for (int j = 0; j < 4; ++j) b[j] = (unsigned)(fsigmoid(v[bj][n][j]) * 255.f + 0.5f);
                            q[bj][n] = b[0] | (b[1] << 8) | (b[2] << 16) | (b[3] << 24); }
                    const auto ra = __builtin_amdgcn_permlane16_swap(q[0][0], q[1][0], false, false), rb = __builtin_amdgcn_permlane16_swap(q[0][1], q[1][1], false, false);
                    u32x4 w; w.x = ra[0]; w.y = rb[0]; w.z = ra[1]; w.w = rb[1];
                    *(u32x4*)((unsigned char*)mixg + (size_t)tl * 3072 + 64 * (s - 55) + ((fq & 1) ? 32 + 8 * (fq - 1) : 8 * fq)) = w;
                    continue;
                }
                const int bl = tl >> 12, t = tl & (SEQ - 1), p = rowmap_p(t, rm);
                bf16* rowp = base + (size_t)bl * bstr + (size_t)p * pitch + 8 * fq;
#pragma unroll
                for (int bj = 0; bj < 2; ++bj) { u32x4 w; w.x = cvt_pk_bf16(v[bj][0][0], v[bj][0][1]); w.y = cvt_pk_bf16(v[bj][0][2], v[bj][0][3]); w.z = cvt_pk_bf16(v[bj][1][0], v[bj][1][1]); w.w = cvt_pk_bf16(v[bj][1][2], v[bj][1][3]);
                    *(u32x4*)(rowp + 32 * bj) = w; }
            }
    }
};

struct EpiVT {
    const float* ssq; unsigned char* ws; int call, dil;
    __device__ __forceinline__ void operator()(const AccT& acc, const pg8::Unit& u, int wr, int wc, int fr, int fq) const {
        constexpr int T = TCH;
        bf16 *avt = (bf16*)(ws + MP.avt), *bvst = (bf16*)(ws + MP.bvst), *bvwt = (bf16*)(ws + MP.bvwt), *cvt = (bf16*)(ws + MP.cvt);
        float rs;
        {
            const int bj = fr >> 3, n = (fr >> 2) & 1, j = fr & 3;
            const int pc = u.pn * 256 + 128 * bj + 32 * wc + 8 * fq + 4 * n + j;
            const int bl = pc >> 12, p = pc & (SEQ - 1), L = SEQ / dil, t = dil * (p & (L - 1)) + p / L;
            const float* q = ssq + ((size_t)bl * SEQ + t) * 16;
            const f32x4 a = *(const f32x4*)q, b = *(const f32x4*)(q + 4), c = *(const f32x4*)(q + 8), d = *(const f32x4*)(q + 12);
            const float s = ((a[0] + a[1]) + (a[2] + a[3])) + ((b[0] + b[1]) + (b[2] + b[3])) + ((c[0] + c[1]) + (c[2] + c[3])) + ((d[0] + d[1]) + (d[2] + d[3]));
            rs = __builtin_amdgcn_rsqf(s * (1.f / DM) + NEPS);
        }
        const int lane = fq * 16 + fr;
#pragma unroll
        for (int bj = 0; bj < 2; ++bj) {
            const int pc0 = u.pn * 256 + 128 * bj + 32 * wc;
            const int bl = pc0 >> 12, pp = pc0 & (SEQ - 1);
            float r4[2][4];
#pragma unroll
            for (int n = 0; n < 2; ++n)
#pragma unroll
                for (int j = 0; j < 4; ++j) r4[n][j] = __shfl(rs, (lane & 48) | (bj * 8 + n * 4 + j));
#pragma unroll
            for (int ai = 0; ai < 2; ++ai) {
                const int hb = (u.pm * 256 + 128 * ai + 64 * wr) >> 6;
                bf16* base; bool perkv = false;
                if (call == 0) {
                    if (hb == 0) base = avt;
                    else if (hb < 3) { base = bvst + (size_t)(hb - 1) * SEQ * 64; perkv = true; }
                    else if (hb < 5) { base = bvwt + (size_t)(hb - 3) * SEQ * 64; perkv = true; }
                    else if (hb < 9) base = cvt + (size_t)(hb - 5) * T * 64;
                    else continue;
                } else base = cvt + (size_t)(4 * call + hb) * T * 64;
                const size_t off = perkv ? ((size_t)bl * 2 * SEQ * 64 + (size_t)(pp >> 6) * 4096) : ((size_t)(pc0 >> 6) * 4096);
                bf16* tp = base + off + (pp & 32) + 16 * (fq >> 1) + 8 * (fq & 1) + fr * 64;
#pragma unroll
                for (int m = 0; m < 4; ++m) { const f32x4 a0 = acc[ai][bj][m][0], a1 = acc[ai][bj][m][1];
                    const unsigned w0x = cvt_pk_bf16(a0[0] * r4[0][0], a0[1] * r4[0][1]), w0y = cvt_pk_bf16(a0[2] * r4[0][2], a0[3] * r4[0][3]);
                    const unsigned w1x = cvt_pk_bf16(a1[0] * r4[1][0], a1[1] * r4[1][1]), w1y = cvt_pk_bf16(a1[2] * r4[1][2], a1[3] * r4[1][3]);
                    const auto rx = __builtin_amdgcn_permlane16_swap(w0x, w1x, false, false), ry = __builtin_amdgcn_permlane16_swap(w0y, w1y, false, false);
                    u32x4 w; w.x = rx[0]; w.y = ry[0]; w.z = rx[1]; w.w = ry[1];
                    *(u32x4*)(tp + m * 16 * 64) = w; }
            }
        }
    }
};
struct EpiP1 {
    const float* ssq; const float* qkg; unsigned char* ws;
    __device__ __forceinline__ void operator()(const AccT& acc, const pg8::Unit& u, int wr, int wc, int fr, int fq) const {
        if (u.w == 0) { const EpiIn E{ssq, qkg, ws}; E(acc, u, wr, wc, fr, fq); }
        else { const EpiVT E{ssq, ws, u.w - 1, u.w == 1 ? 1 : (u.w == 2 ? 4 : 16)}; E(acc, u, wr, wc, fr, fq); }
    }
};
struct EpiCmpK {
    const float* cb; const float* gain; bf16* kcmp;
    __device__ __forceinline__ void operator()(const AccT& acc, const pg8::Unit& u, int wr, int wc, int fr, int fq) const {
        if (wc != 0) return;
        f32x4 cbv[2][2], gv[2][2];
#pragma unroll
        for (int bj = 0; bj < 2; ++bj)
#pragma unroll
            for (int n = 0; n < 2; ++n) { cbv[bj][n] = *(const f32x4*)(cb + 32 * bj + 8 * fq + 4 * n); gv[bj][n] = *(const f32x4*)(gain + 32 * bj + 8 * fq + 4 * n); }
#pragma unroll
        for (int ai = 0; ai < 2; ++ai)
#pragma unroll
            for (int m = 0; m < 4; ++m) {
                const int row = u.pm * 256 + 128 * ai + 64 * wr + 16 * m + fr;
                f32x4 v[2][2]; float ss = 0.f;
#pragma unroll
                for (int bj = 0; bj < 2; ++bj)
#pragma unroll
                    for (int n = 0; n < 2; ++n) { v[bj][n] = acc[ai][bj][m][n] + cbv[bj][n]; ss += (v[bj][n][0] * v[bj][n][0] + v[bj][n][1] * v[bj][n][1]) + (v[bj][n][2] * v[bj][n][2] + v[bj][n][3] * v[bj][n][3]); }
                ss = xsum16(ss); ss = xsum32(ss);
                const float inv = __builtin_amdgcn_rsqf(ss * (1.f / 64.f) + NEPS);
#pragma unroll
                for (int bj = 0; bj < 2; ++bj) { const f32x4 a = v[bj][0] * inv * gv[bj][0], b = v[bj][1] * inv * gv[bj][1];
                    u32x4 w; w.x = cvt_pk_bf16(a[0], a[1]); w.y = cvt_pk_bf16(a[2], a[3]); w.z = cvt_pk_bf16(b[0], b[1]); w.w = cvt_pk_bf16(b[2], b[3]);
                    *(u32x4*)(kcmp + (size_t)row * 64 + 32 * bj + 8 * fq) = w; }
            }
    }
};
struct EpiCmpV {
    const float* cb; bf16* vcmpt;
    __device__ __forceinline__ void operator()(const AccT& acc, const pg8::Unit& u, int wr, int wc, int fr, int fq) const {
        if (wr != 0) return;
#pragma unroll
        for (int m = 0; m < 4; ++m) {
            const int e = 16 * m + fr; const float c = cb[e];
#pragma unroll
            for (int bj = 0; bj < 2; ++bj) {
                bf16* tp = vcmpt + (size_t)u.pn * 64 * 256 + e * 256 + 128 * bj + 32 * wc + 16 * (fq >> 1) + 4 * (fq & 1);
#pragma unroll
                for (int n = 0; n < 2; ++n) { const f32x4 a = acc[0][bj][m][n];
                    u32x2 w; w.x = cvt_pk_bf16(a[0] + c, a[1] + c); w.y = cvt_pk_bf16(a[2] + c, a[3] + c);
                    *(u32x2*)(tp + 8 * n) = w; }
            }
        }
    }
};
struct EpiBranch {
    const unsigned char* gate; bf16* mb; int first;
    __device__ __forceinline__ void operator()(const AccT& acc, const pg8::Unit& u, int wr, int wc, int fr, int fq) const {
#pragma unroll
        for (int ai = 0; ai < 2; ++ai) {
            u32x2 gr[4][2]; u32x4 orr[4][2];
#pragma unroll
            for (int m = 0; m < 4; ++m)
#pragma unroll
                for (int bj = 0; bj < 2; ++bj) {
                    const int row = u.pm * 256 + 128 * ai + 64 * wr + 16 * m + fr, col = u.pn * 256 + 128 * bj + 32 * wc + 8 * fq;
                    gr[m][bj] = *(const u32x2*)(gate + (size_t)row * 3072 + col);
                    if (!first) orr[m][bj] = *(const u32x4*)(mb + (size_t)row * 1024 + col);
                }
            __builtin_amdgcn_sched_barrier(0);
#pragma unroll
            for (int m = 0; m < 4; ++m) {
                const int row = u.pm * 256 + 128 * ai + 64 * wr + 16 * m + fr;
#pragma unroll
                for (int bj = 0; bj < 2; ++bj) {
                    const int col = u.pn * 256 + 128 * bj + 32 * wc + 8 * fq;
                    const u32x2 g = gr[m][bj];
                    bf16* mp = mb + (size_t)row * 1024 + col;
                    constexpr float k = 1.f / 255.f;
                    f32x4 a = acc[ai][bj][m][0], b = acc[ai][bj][m][1];
                    a[0] *= (float)(g.x & 0xff) * k; a[1] *= (float)((g.x >> 8) & 0xff) * k; a[2] *= (float)((g.x >> 16) & 0xff) * k; a[3] *= (float)(g.x >> 24) * k;
                    b[0] *= (float)(g.y & 0xff) * k; b[1] *= (float)((g.y >> 8) & 0xff) * k; b[2] *= (float)((g.y >> 16) & 0xff) * k; b[3] *= (float)(g.y >> 24) * k;
                    if (!first) { const u32x4 o = orr[m][bj];
                        a[0] += bflo(o.x); a[1] += bfhi(o.x); a[2] += bflo(o.y); a[3] += bfhi(o.y);
                        b[0] += bflo(o.z); b[1] += bfhi(o.z); b[2] += bflo(o.w); b[3] += bfhi(o.w); }
                    u32x4 w; w.x = cvt_pk_bf16(a[0], a[1]); w.y = cvt_pk_bf16(a[2], a[3]); w.z = cvt_pk_bf16(b[0], b[1]); w.w = cvt_pk_bf16(b[2], b[3]);
                    *(u32x4*)mp = w;
                }
            }
        }
    }
};
struct EpiRes {
    bf16* xb; float* xout; float* ssq; int dry;
    __device__ __forceinline__ void operator()(const AccT& acc, const pg8::Unit& u, int wr, int wc, int fr, int fq) const {
#pragma unroll
        for (int ai = 0; ai < 2; ++ai) {
            u32x4 xr[4][2];
#pragma unroll
            for (int m = 0; m < 4; ++m)
#pragma unroll
                for (int bj = 0; bj < 2; ++bj) xr[m][bj] = *(const u32x4*)(xb + (size_t)(u.pm * 256 + 128 * ai + 64 * wr + 16 * m + fr) * DM + u.pn * 256 + 128 * bj + 32 * wc + 8 * fq);
            __builtin_amdgcn_sched_barrier(0);
#pragma unroll
            for (int m = 0; m < 4; ++m) {
                const int row = u.pm * 256 + 128 * ai + 64 * wr + 16 * m + fr; float ss = 0.f;
#pragma unroll
                for (int bj = 0; bj < 2; ++bj) {
                    const size_t o = (size_t)row * DM + u.pn * 256 + 128 * bj + 32 * wc + 8 * fq;
                    const u32x4 xo = xr[m][bj];
                    f32x4 a = acc[ai][bj][m][0], b = acc[ai][bj][m][1];
                    a[0] += bflo(xo.x); a[1] += bfhi(xo.x); a[2] += bflo(xo.y); a[3] += bfhi(xo.y);
                    b[0] += bflo(xo.z); b[1] += bfhi(xo.z); b[2] += bflo(xo.w); b[3] += bfhi(xo.w);
                    ss += (a[0] * a[0] + a[1] * a[1]) + (a[2] * a[2] + a[3] * a[3]) + (b[0] * b[0] + b[1] * b[1]) + (b[2] * b[2] + b[3] * b[3]);
                    if (!dry) {
                        if (xout) { *(f32x4*)(xout + o) = a; *(f32x4*)(xout + o + 4) = b; }
                        else { u32x4 w; w.x = cvt_pk_bf16(a[0], a[1]); w.y = cvt_pk_bf16(a[2], a[3]); w.z = cvt_pk_bf16(b[0], b[1]); w.w = cvt_pk_bf16(b[2], b[3]); *(u32x4*)(xb + o) = w; }
                    }
                }
                ss = xsum16(ss); ss = xsum32(ss);
                if (fq == 0 && !dry) ssq[(size_t)row * 16 + 4 * u.pn + wc] = ss;
            }
        }
    }
};
struct EpiSwiGLU {
    const float* ssq; bf16* hid;
    __device__ __forceinline__ void operator()(const AccT& acc, const pg8::Unit& u, int wr, int wc, int fr, int fq) const {
        float rsv[2][4];
        { f32x4 pq[2][4];
#pragma unroll
          for (int ai = 0; ai < 2; ++ai)
#pragma unroll
              for (int m = 0; m < 4; ++m) pq[ai][m] = *(const f32x4*)(ssq + (size_t)(u.pm * 256 + 128 * ai + 64 * wr + 16 * m + fr) * 16 + 4 * fq);
          __builtin_amdgcn_sched_barrier(0);
#pragma unroll
          for (int ai = 0; ai < 2; ++ai)
#pragma unroll
              for (int m = 0; m < 4; ++m) { const f32x4 p = pq[ai][m]; float sm = (p[0] + p[1]) + (p[2] + p[3]); sm = xsum16(sm); sm = xsum32(sm); rsv[ai][m] = __builtin_amdgcn_rsqf(sm * (1.f / DM) + NEPS); } }
#pragma unroll
        for (int ai = 0; ai < 2; ++ai)
#pragma unroll
            for (int m = 0; m < 4; ++m) {
                const int row = u.pm * 256 + 128 * ai + 64 * wr + 16 * m + fr;
                const float rs = rsv[ai][m];
                float h[8];
#pragma unroll
                for (int n = 0; n < 2; ++n)
#pragma unroll
                    for (int j = 0; j < 4; ++j) { const float g = acc[ai][0][m][n][j] * rs, up = acc[ai][1][m][n][j] * rs; h[4 * n + j] = g * fsigmoid(g) * up; }
                u32x4 w; w.x = cvt_pk_bf16(h[0], h[1]); w.y = cvt_pk_bf16(h[2], h[3]); w.z = cvt_pk_bf16(h[4], h[5]); w.w = cvt_pk_bf16(h[6], h[7]);
                *(u32x4*)(hid + (size_t)row * DFF + u.pn * 128 + 32 * wc + 8 * fq) = w;
            }
    }
};

__device__ __forceinline__ int main_src(int row) {
    const int s = 4 * (row >> 8) + ((row & 127) >> 5), col = 32 * ((row & 255) >> 7) + (row & 31);
    if (s < 8) return 64 * s + col;
    if (s == 8) return 512 + col;
    if (s < 13) return 640 + 64 * (s - 9) + col;
    if (s == 13) return 896 + col;
    if (s == 14) return col < 4 ? 960 + col : (col < 28 ? 2244 + col - 4 : -1);
    if (s < 23) return 964 + 64 * (s - 15) + col;
    if (s < 25) return 1476 + 64 * (s - 23) + col;
    if (s < 27) return 1476 + 128 + 64 * (s - 25) + col;
    if (s < 29) return 1476 + 256 + 64 * (s - 27) + col;
    if (s < 31) return 1476 + 512 + 64 * (s - 29) + col;
    if (s < 43) return 2268 + 64 * (s - 31) + col;
    if (s < 55) return 3036 + 64 * (s - 43) + col;
    if (s < 103) return 4572 + 64 * (s - 55) + col;
    return 576 + col;
}
__device__ __forceinline__ int vt_src(int r) {
    if (r < 64) return 576 + r;
    if (r < 192) return 1860 + (r - 64);
    if (r < 320) return 2116 + (r - 192);
    if (r < 576) return 3804 + (r - 320);
    if (r < 768) return -1;
    return 3804 + 256 + (r - 768);
}
__device__ __forceinline__ int ffn_src(int row) { return ((row & 128) ? DFF : 0) + 128 * (row >> 8) + (row & 127 & ~31) + (row & 31); }
__device__ __forceinline__ void ti_load(const float* W, int Nsrc, int k0, int sc4, const float* gk, int lane, f32x4 (&v)[8]) {
    const int kq = lane >> 3;
#pragma unroll
    for (int i = 0; i < 8; ++i) { const int kk = kq + 8 * i; v[i] = (f32x4){0.f, 0.f, 0.f, 0.f};
        if (sc4 >= 0) { v[i] = *(const f32x4*)(W + (size_t)(k0 + kk) * Nsrc + sc4); if (gk) v[i] = v[i] * gk[k0 + kk]; } }
}
__device__ __forceinline__ void ti_finish(const f32x4 (&v)[8], int K, bf16* WT, LAS float* scr, int k0, int n0, int lane) {
    const int kq = lane >> 3, n4 = lane & 7;
#pragma unroll
    for (int i = 0; i < 8; ++i) { const int kk = kq + 8 * i;
#pragma unroll
        for (int j = 0; j < 4; ++j) scr[kk * 33 + 4 * n4 + j] = v[i][j]; }
    asm volatile("s_waitcnt lgkmcnt(0)" ::: "memory");
    const int c = lane & 7;
#pragma unroll
    for (int j = 0; j < 4; ++j) { const int n = (lane >> 3) + 8 * j; const LAS float* s = scr + (8 * c) * 33 + n;
        u32x4 o; o.x = pk2(s[0 * 33], s[1 * 33]); o.y = pk2(s[2 * 33], s[3 * 33]); o.z = pk2(s[4 * 33], s[5 * 33]); o.w = pk2(s[6 * 33], s[7 * 33]);
        *(u32x4*)(WT + (size_t)(n0 + n) * K + k0 + 8 * c) = o; }
    asm volatile("s_waitcnt lgkmcnt(0)" ::: "memory");
}
__device__ __forceinline__ int rel_bucket(int n) {
    if (n < 16) return n < 0 ? 0 : n;
    const int lg = 16 + (int)(logf((float)n / 16.0f) / 4.852030263919617f * 16.0f);
    return lg < 31 ? lg : 31;
}
__device__ __forceinline__ float wave_sum(float v) {
#pragma unroll
    for (int o = 1; o < 64; o <<= 1) v += __shfl_xor(v, o);
    return v;
}

__device__ __forceinline__ f32x16 mfma32(bf16x8 a, bf16x8 b, f32x16 c) { return __builtin_amdgcn_mfma_f32_32x32x16_bf16(a, b, c, 0, 0, 0); }
__device__ __forceinline__ f32x4 mfma16(bf16x8 a, bf16x8 b, f32x4 c) { return __builtin_amdgcn_mfma_f32_16x16x32_bf16(a, b, c, 0, 0, 0); }
__device__ __forceinline__ f32x16 zero16() { f32x16 z;
#pragma unroll
    for (int i = 0; i < 16; ++i) z[i] = 0.f; return z; }
#define ROWC(reg) (((reg) & 3) + 8 * ((reg) >> 2))
__device__ __forceinline__ f32x16 qk32(const bf16* krow, const bf16x8 (&qf)[4]) {
    f32x16 st = zero16();
#pragma unroll
    for (int ks = 0; ks < 4; ++ks) { const bf16x8 kf = *(const bf16x8*)(krow + 16 * ks); st = mfma32(kf, qf[ks], st); }
    return st;
}
template <int BIAS, bool MASK>
__device__ __forceinline__ void soft32(const f32x16& st, const LAS float* bt, float bc, unsigned keep, float& l, bf16x8 (&pb)[2]) {
    float e[16];
#pragma unroll
    for (int r = 0; r < 16; ++r) {
        float x = st[r];
        if (BIAS == 1) x += bt[27 - ROWC(r)];
        if (BIAS == 2) x += bc;
        float ev = __builtin_amdgcn_exp2f(x);
        if (MASK) { const int sel = ((int)(keep << (31 - ROWC(r)))) >> 31; ev = __builtin_bit_cast(float, __builtin_bit_cast(int, ev) & sel); }
        l += ev; e[r] = ev;
    }
#pragma unroll
    for (int s = 0; s < 2; ++s) { u32x4 w; w.x = cvt_pk_bf16(e[8 * s + 0], e[8 * s + 1]); w.y = cvt_pk_bf16(e[8 * s + 2], e[8 * s + 3]); w.z = cvt_pk_bf16(e[8 * s + 4], e[8 * s + 5]); w.w = cvt_pk_bf16(e[8 * s + 6], e[8 * s + 7]);
        pb[s] = __builtin_bit_cast(bf16x8, w); }
}
__device__ __forceinline__ void pv32(f32x16 (&ot)[2], const bf16* vb, int pitch, const bf16x8 (&pb)[2]) {
#pragma unroll
    for (int db = 0; db < 2; ++db)
#pragma unroll
        for (int s = 0; s < 2; ++s) { const bf16x8 vf = *(const bf16x8*)(vb + (size_t)db * 32 * pitch + 16 * s); ot[db] = mfma32(vf, pb[s], ot[db]); }
}
__device__ __forceinline__ unsigned keep_le(int lim) { return lim < 0 ? 0u : (lim >= 31 ? 0xffffffffu : ((2u << lim) - 1u)); }
__device__ __forceinline__ unsigned keep_ge(int lo) { return lo <= 0 ? 0xffffffffu : (lo > 31 ? 0u : ~((1u << lo) - 1u)); }

template <int BIAS, int MASK>
__device__ __forceinline__ f32x16 acc_init(const LAS float* bt, float bc, unsigned keep) {
    f32x16 st;
#pragma unroll
    for (int r = 0; r < 16; ++r) {
        float b = BIAS == 1 ? bt[27 - ROWC(r)] : (BIAS == 2 ? bc : 0.f);
        if (MASK) { const int sel = MASK == 2 ? (int)keep : __builtin_amdgcn_sbfe((int)keep, ROWC(r), 1); b = __int_as_float(__builtin_amdgcn_bitop3_b32(__float_as_int(b), (int)0xc6ea6000, sel, 0xe4)); }
        st[r] = b;
    }
    return st;
}
__device__ __forceinline__ void exp_pack(const f32x16& st, bf16x8 (&pb)[2]) {
    float e[16];
#pragma unroll
    for (int r = 0; r < 16; ++r) e[r] = __builtin_amdgcn_exp2f(st[r]);
#pragma unroll
    for (int s = 0; s < 2; ++s) { u32x4 w; w.x = cvt_pk_bf16(e[8 * s + 0], e[8 * s + 1]); w.y = cvt_pk_bf16(e[8 * s + 2], e[8 * s + 3]); w.z = cvt_pk_bf16(e[8 * s + 4], e[8 * s + 5]); w.w = cvt_pk_bf16(e[8 * s + 6], e[8 * s + 7]);
        pb[s] = __builtin_bit_cast(bf16x8, w); }
}
template <int BIAS, int MASK>
__device__ __forceinline__ void qks32_l(const LAS bf16* krow, const bf16x8 (&qf)[4], const LAS float* bt, float bc, unsigned keep, bf16x8 (&pb)[2]) {
    f32x16 st = acc_init<BIAS, MASK>(bt, bc, keep);
#pragma unroll
    for (int ks = 0; ks < 4; ++ks) { const bf16x8 kf = *(const LAS bf16x8*)(krow + 16 * ks); st = mfma32(kf, qf[ks], st); }
    exp_pack(st, pb);
}
__device__ __forceinline__ void exp_pack_sum(const f32x16& st, bf16x8 (&pb)[2], float& l) {
    float e[16];
#pragma unroll
    for (int r = 0; r < 16; ++r) { e[r] = __builtin_amdgcn_exp2f(st[r]); l += e[r]; }
#pragma unroll
    for (int s = 0; s < 2; ++s) { u32x4 w; w.x = cvt_pk_bf16(e[8 * s + 0], e[8 * s + 1]); w.y = cvt_pk_bf16(e[8 * s + 2], e[8 * s + 3]); w.z = cvt_pk_bf16(e[8 * s + 4], e[8 * s + 5]); w.w = cvt_pk_bf16(e[8 * s + 6], e[8 * s + 7]);
        pb[s] = __builtin_bit_cast(bf16x8, w); }
}
template <int BIAS, int MASK>
__device__ __forceinline__ void qks32_ls(const LAS bf16* krow, const bf16x8 (&qf)[4], const LAS float* bt, float bc, unsigned keep, bf16x8 (&pb)[2], float& l) {
    f32x16 st = acc_init<BIAS, MASK>(bt, bc, keep);
#pragma unroll
    for (int ks = 0; ks < 4; ++ks) { const bf16x8 kf = *(const LAS bf16x8*)(krow + 16 * ks); st = mfma32(kf, qf[ks], st); }
    exp_pack_sum(st, pb, l);
}
template <int BIAS, int MASK>
__device__ __forceinline__ void qks32_g(const bf16* krow, const bf16x8 (&qf)[4], const LAS float* bt, float bc, unsigned keep, bf16x8 (&pb)[2]) {
    f32x16 st = acc_init<BIAS, MASK>(bt, bc, keep);
#pragma unroll
    for (int ks = 0; ks < 4; ++ks) { const bf16x8 kf = *(const bf16x8*)(krow + 16 * ks); st = mfma32(kf, qf[ks], st); }
    exp_pack(st, pb);
}
__device__ __forceinline__ bf16x8 ones_frag() { const u32x4 w = {0x3f803f80u, 0x3f803f80u, 0x3f803f80u, 0x3f803f80u}; return __builtin_bit_cast(bf16x8, w); }
struct Ctx {
    unsigned char* ws; static constexpr int T = TCH;
    __device__ __forceinline__ bf16* aq() const { return (bf16*)(ws + MP.aq); }
    __device__ __forceinline__ bf16* ak() const { return (bf16*)(ws + MP.ak); }
    __device__ __forceinline__ bf16* av() const { return (bf16*)(ws + MP.av); }
    __device__ __forceinline__ bf16* iq() const { return (bf16*)(ws + MP.iq); }
    __device__ __forceinline__ bf16* ik() const { return (bf16*)(ws + MP.ik); }
    __device__ __forceinline__ bf16* bq() const { return (bf16*)(ws + MP.bq); }
    __device__ __forceinline__ bf16* bks() const { return (bf16*)(ws + MP.bks); }
    __device__ __forceinline__ bf16* bkw() const { return (bf16*)(ws + MP.bkw); }
    __device__ __forceinline__ bf16* cq() const { return (bf16*)(ws + MP.cq); }
    __device__ __forceinline__ bf16* ck() const { return (bf16*)(ws + MP.ck); }
    __device__ __forceinline__ bf16* avt() const { return (bf16*)(ws + MP.avt); }
    __device__ __forceinline__ bf16* bvst() const { return (bf16*)(ws + MP.bvst); }
    __device__ __forceinline__ bf16* bvwt() const { return (bf16*)(ws + MP.bvwt); }
    __device__ __forceinline__ bf16* cvt() const { return (bf16*)(ws + MP.cvt); }
    __device__ __forceinline__ bf16* kcmp() const { return (bf16*)(ws + MP.kcmp); }
    __device__ __forceinline__ bf16* vcmpt() const { return (bf16*)(ws + MP.vcmpt); }
    __device__ __forceinline__ bf16* oa() const { return (bf16*)(ws + MP.oa); }
    __device__ __forceinline__ bf16* ob() const { return (bf16*)(ws + MP.ob); }
    __device__ __forceinline__ bf16* oc() const { return (bf16*)(ws + MP.oc); }
    __device__ __forceinline__ bf16* cgo() const { return (bf16*)(ws + MP.cgo); }
    __device__ __forceinline__ float* misc() const { return (float*)(ws + MP.misc); }
    __device__ __forceinline__ float* cgl() const { return (float*)(ws + MP.cgl); }
};

__device__ __forceinline__ void mixC_combine(const Ctx& X, int gw, int ngw, int lane) {
    const int nitem = X.T * 32;
#pragma unroll 1
    for (int idx0 = gw * 64 + lane; idx0 < nitem; idx0 += 4 * ngw * 64) {
        u32x4 a[4], b[4], c[4]; float l0[4], l1[4], l2[4];
#pragma unroll
        for (int k = 0; k < 4; ++k) {
            int idx = idx0 + k * ngw * 64; if (idx >= nitem) idx = nitem - 1;
            const int tl = idx >> 5, i = (idx >> 3) & 3, oct = idx & 7;
            const int bl = tl >> 12, t = tl & (SEQ - 1);
            const size_t r0 = (size_t)bl * SEQ + t, r1 = (size_t)bl * SEQ + rowmap_p(t, 1), r2 = (size_t)bl * SEQ + rowmap_p(t, 2);
            const size_t h0 = (size_t)i * X.T + r0, h1 = (size_t)(4 + i) * X.T + r1, h2 = (size_t)(8 + i) * X.T + r2;
            a[k] = *(const u32x4*)(X.cgo() + h0 * 64 + 8 * oct); b[k] = *(const u32x4*)(X.cgo() + h1 * 64 + 8 * oct); c[k] = *(const u32x4*)(X.cgo() + h2 * 64 + 8 * oct);
            l0[k] = X.cgl()[h0]; l1[k] = X.cgl()[h1]; l2[k] = X.cgl()[h2];
        }
#pragma unroll
        for (int k = 0; k < 4; ++k) {
            const int idx = idx0 + k * ngw * 64;
            if (idx < nitem) {
                const int tl = idx >> 5, i = (idx >> 3) & 3, oct = idx & 7;
                const float inv = 1.f / (l0[k] + l1[k] + l2[k]);
                u32x4 w;
                w.x = cvt_pk_bf16((bflo(a[k].x) + bflo(b[k].x) + bflo(c[k].x)) * inv, (bfhi(a[k].x) + bfhi(b[k].x) + bfhi(c[k].x)) * inv);
                w.y = cvt_pk_bf16((bflo(a[k].y) + bflo(b[k].y) + bflo(c[k].y)) * inv, (bfhi(a[k].y) + bfhi(b[k].y) + bfhi(c[k].y)) * inv);
                w.z = cvt_pk_bf16((bflo(a[k].z) + bflo(b[k].z) + bflo(c[k].z)) * inv, (bfhi(a[k].z) + bfhi(b[k].z) + bfhi(c[k].z)) * inv);
                w.w = cvt_pk_bf16((bflo(a[k].w) + bflo(b[k].w) + bflo(c[k].w)) * inv, (bfhi(a[k].w) + bfhi(b[k].w) + bfhi(c[k].w)) * inv);
                *(u32x4*)(X.oc() + (size_t)tl * 256 + 64 * i + 8 * oct) = w;
            }
        }
    }
}

__device__ __forceinline__ void idx_keys(const bf16* ikrow  , const bf16x8 (&iqf)[2], const float (&w)[4], int (&key)[4]) {
#pragma unroll
    for (int blk = 0; blk < 4; ++blk) {
        const bf16x8 b0 = *(const bf16x8*)(ikrow + blk * 16 * 64), b1 = *(const bf16x8*)(ikrow + blk * 16 * 64 + 32);
        f32x4 a = {0.f, 0.f, 0.f, 0.f};
        a = mfma16(iqf[0], b0, a); a = mfma16(iqf[1], b1, a);
        const float r0 = fmaxf(a[0], 0.f), r1 = fmaxf(a[1], 0.f), r2 = fmaxf(a[2], 0.f), r3 = fmaxf(a[3], 0.f);
        float sc = __builtin_fmaf(w[3], r3, __builtin_fmaf(w[2], r2, __builtin_fmaf(w[1], r1, w[0] * r0)));
        sc = fminf(fmaxf(sc, -524288.f), 524287.f);
        key[blk] = (int)sc;
    }
}
constexpr int TSTR = 72, TILE_LDS = 64 * TSTR * 2;
constexpr int TSTRI = 80, TILE_LDSI = 64 * TSTRI * 2;
__device__ __forceinline__ u32x4 tile_ld(const bf16* tile, int pitch, int tid) { return *(const u32x4*)(tile + (size_t)(tid >> 3) * pitch + (tid & 7) * 8); }
__device__ __forceinline__ void tile_st(LAS bf16* buf, int tid, u32x4 v) { *(LAS u32x4*)(buf + (tid >> 3) * TSTR + (tid & 7) * 8) = v; }
__device__ __forceinline__ void tile_sti(LAS bf16* buf, int tid, u32x4 v) { *(LAS u32x4*)(buf + (tid >> 3) * TSTRI + (tid & 7) * 8) = v; }
__device__ __forceinline__ f32x16 qk32_l(const LAS bf16* krow, const bf16x8 (&qf)[4]) {
    f32x16 st = zero16();
#pragma unroll
    for (int ks = 0; ks < 4; ++ks) { const bf16x8 kf = *(const LAS bf16x8*)(krow + 16 * ks); st = mfma32(kf, qf[ks], st); }
    return st;
}
__device__ __forceinline__ void pv32_l(f32x16 (&ot)[2], const LAS bf16* vb, const bf16x8 (&pb)[2]) {
#pragma unroll
    for (int db = 0; db < 2; ++db)
#pragma unroll
        for (int s = 0; s < 2; ++s) { const bf16x8 vf = *(const LAS bf16x8*)(vb + db * 32 * TSTR + 16 * s); ot[db] = mfma32(vf, pb[s], ot[db]); }
}
template <int BIAS, int MASK>
__device__ __forceinline__ void blk32_l(const LAS bf16* krow, const LAS bf16* vb, const bf16x8 (&qf)[4], const LAS float* bt, float bc, unsigned keep, f32x16 (&ot)[2], float& l) {
    bf16x8 kf[4], vf[2][2];
#pragma unroll
    for (int ks = 0; ks < 4; ++ks) kf[ks] = *(const LAS bf16x8*)(krow + 16 * ks);
    f32x16 st = acc_init<BIAS, MASK>(bt, bc, keep);
    __builtin_amdgcn_sched_barrier(0);
#pragma unroll
    for (int ks = 0; ks < 4; ++ks) st = mfma32(kf[ks], qf[ks], st);
#pragma unroll
    for (int db = 0; db < 2; ++db)
#pragma unroll
        for (int s = 0; s < 2; ++s) vf[db][s] = *(const LAS bf16x8*)(vb + db * 32 * TSTR + 16 * s);
    __builtin_amdgcn_sched_barrier(0);
    bf16x8 pb[2];
    exp_pack_sum(st, pb, l);
#pragma unroll
    for (int db = 0; db < 2; ++db)
#pragma unroll
        for (int s = 0; s < 2; ++s) ot[db] = mfma32(vf[db][s], pb[s], ot[db]);
}
template <int BIAS, int MASK>
__device__ __forceinline__ void tile64_l(const LAS bf16* krow, const LAS bf16* vrow, const bf16x8 (&qf)[4], const LAS float* bt, float bc, unsigned keep0, unsigned keep1, f32x16 (&ot)[2], float& l) {
    f32x16 st0 = acc_init<BIAS, MASK>(bt, bc, keep0);
#pragma unroll
    for (int ks = 0; ks < 4; ++ks) { const bf16x8 kf = *(const LAS bf16x8*)(krow + 16 * ks); st0 = mfma32(kf, qf[ks], st0); }
    f32x16 st1 = acc_init<BIAS, MASK>(BIAS == 1 ? bt - 32 : bt, bc, keep1);
#pragma unroll
    for (int ks = 0; ks < 4; ++ks) { const bf16x8 kf = *(const LAS bf16x8*)(krow + 32 * TSTR + 16 * ks); st1 = mfma32(kf, qf[ks], st1); }
    bf16x8 pb0[2], pb1[2];
    exp_pack_sum(st0, pb0, l);
#pragma unroll
    for (int db = 0; db < 2; ++db)
#pragma unroll
        for (int s = 0; s < 2; ++s) { const bf16x8 vf = *(const LAS bf16x8*)(vrow + db * 32 * TSTR + 16 * s); ot[db] = mfma32(vf, pb0[s], ot[db]); }
    exp_pack_sum(st1, pb1, l);
#pragma unroll
    for (int db = 0; db < 2; ++db)
#pragma unroll
        for (int s = 0; s < 2; ++s) { const bf16x8 vf = *(const LAS bf16x8*)(vrow + 32 + db * 32 * TSTR + 16 * s); ot[db] = mfma32(vf, pb1[s], ot[db]); }
}
__device__ __forceinline__ void pvl32_l(f32x16 (&ot)[2], f32x16& lt, const LAS bf16* vb, const bf16x8 (&pb)[2]) {
    pv32_l(ot, vb, pb);
    const bf16x8 one = ones_frag();
#pragma unroll
    for (int s = 0; s < 2; ++s) lt = mfma32(one, pb[s], lt);
}
__device__ __forceinline__ void idx_keys_l(const LAS bf16* ikrow  , const bf16x8 (&iqf)[2], const float (&w)[4], int (&key)[4]) {
#pragma unroll
    for (int blk = 0; blk < 4; ++blk) {
        const bf16x8 b0 = *(const LAS bf16x8*)(ikrow + blk * 16 * TSTRI), b1 = *(const LAS bf16x8*)(ikrow + blk * 16 * TSTRI + 32);
        f32x4 a = {0.f, 0.f, 0.f, 0.f};
        a = mfma16(iqf[0], b0, a); a = mfma16(iqf[1], b1, a);
        const float a0 = a[0], a1 = a[1], a2 = a[2], a3 = a[3];
        const float r0 = __int_as_float(max(__float_as_int(a0), 0)), r1 = __int_as_float(max(__float_as_int(a1), 0)),
                    r2 = __int_as_float(max(__float_as_int(a2), 0)), r3 = __int_as_float(max(__float_as_int(a3), 0));
        float sc = __builtin_fmaf(w[3], r3, __builtin_fmaf(w[2], r2, __builtin_fmaf(w[1], r1, w[0] * r0)));
        sc = __builtin_amdgcn_fmed3f(sc, -524288.f, 524287.f);
        key[blk] = (int)sc;
    }
}
__device__ __forceinline__ void idx_frag_ld(const LAS bf16* ikrow, bf16x8 (&fr)[4][2]) {
#pragma unroll
    for (int blk = 0; blk < 4; ++blk) { fr[blk][0] = *(const LAS bf16x8*)(ikrow + blk * 16 * TSTRI); fr[blk][1] = *(const LAS bf16x8*)(ikrow + blk * 16 * TSTRI + 32); }
}
__device__ __forceinline__ void idx_keys_f(const bf16x8 (&fr)[4][2], const bf16x8 (&iqf)[2], const float (&w)[4], int (&key)[4]) {
    f32x4 a[4];
#pragma unroll
    for (int blk = 0; blk < 4; ++blk) { a[blk] = (f32x4){0.f, 0.f, 0.f, 0.f}; a[blk] = mfma16(iqf[0], fr[blk][0], a[blk]); }
#pragma unroll
    for (int blk = 0; blk < 4; ++blk) a[blk] = mfma16(iqf[1], fr[blk][1], a[blk]);
    __builtin_amdgcn_sched_barrier(0);
#pragma unroll
    for (int blk = 0; blk < 4; ++blk) {
        const float a0 = a[blk][0], a1 = a[blk][1], a2 = a[blk][2], a3 = a[blk][3];
        const float r0 = __int_as_float(max(__float_as_int(a0), 0)), r1 = __int_as_float(max(__float_as_int(a1), 0)),
                    r2 = __int_as_float(max(__float_as_int(a2), 0)), r3 = __int_as_float(max(__float_as_int(a3), 0));
        float sc = __builtin_fmaf(w[3], r3, __builtin_fmaf(w[2], r2, __builtin_fmaf(w[1], r1, __builtin_fmaf(w[0], r0, 32768.f))));
        sc = __builtin_amdgcn_fmed3f(sc, 0.f, 65535.f);
        key[blk] = (int)sc;
    }
}
constexpr int P2C_K = 16384, P2C_V = P2C_K + 384 * TSTR * 2, P2C_END = P2C_V + 384 * TSTR * 2;
__device__ __forceinline__ void mixC_ticket(const Ctx& X, LAS unsigned char* lds, const LAS float* tabC, int j, int tkq, int tid) {
    const int lane = tid & 63, wave = __builtin_amdgcn_readfirstlane(tid >> 6);
    const int g = j >> 2, dil = g == 0 ? 1 : (g == 1 ? 4 : 16), L = SEQ / dil;
    const int p0t = tkq * 256, bl = p0t >> 12, ppt = p0t & (SEQ - 1), ss = ppt & ~(L - 1), n0t = ppt & (L - 1);
    const size_t hb = (size_t)j * X.T;
    const int skip = n0t == 0 ? 128 : 0;
    const long rowb = (long)hb + (long)bl * SEQ + ss + n0t - 128;
    LAS bf16* Kl = (LAS bf16*)(lds + P2C_K); LAS bf16* Vl = (LAS bf16*)(lds + P2C_V);
    const int c = lane & 31, hh = lane >> 5;
    const int p = p0t + 32 * wave + c;
    bf16x8 qf[4];
    { const bf16* qrow = X.cq() + (hb + (size_t)p) * 64 + 8 * hh;
#pragma unroll
      for (int ks = 0; ks < 4; ++ks) qf[ks] = *(const bf16x8*)(qrow + 16 * ks); }
    u32x4 rk[6], rv[6];
#pragma unroll
    for (int i = 0; i < 6; ++i) {
        const int id = tid + 512 * i, row = id >> 3, ch = (id & 7) * 8;
        const int rr = row < skip ? skip : row;
        rk[i] = *(const u32x4*)(X.ck() + (rowb + rr) * 64 + ch);
        rv[i] = *(const u32x4*)(X.cvt() + (rowb + (rr & ~63)) * 64 + (size_t)(rr & 63) * 64 + ch);
    }
#pragma unroll
    for (int i = 0; i < 6; ++i) {
        const int id = tid + 512 * i, row = id >> 3, ch = (id & 7) * 8;
        *(LAS u32x4*)(Kl + row * TSTR + ch) = rk[i]; *(LAS u32x4*)(Vl + row * TSTR + ch) = rv[i];
    }
    __syncthreads();
    f32x16 ot[2] = {zero16(), zero16()}, lt = zero16();
    const int n0 = n0t + 32 * wave;
    const int kbf = n0 >= 128 ? 0 : 4 - (n0 >> 5);
#pragma unroll
    for (int kb = 0; kb < 5; ++kb) {
        if (kb < kbf) continue;
        const int r0 = 32 * (wave + kb);
        const LAS float* bt = tabC + j * TABC + 32 + (128 - 32 * kb + c - 4 * hh) - 27;
        f32x16 st = kb == 0 ? acc_init<1, 1>(bt, 0.f, keep_ge(c - 4 * hh)) : (kb == 4 ? acc_init<1, 1>(bt, 0.f, keep_le(c - 4 * hh)) : acc_init<1, 0>(bt, 0.f, 0u));
        const LAS bf16* krow = Kl + (r0 + c) * TSTR + 8 * hh;
#pragma unroll
        for (int ks = 0; ks < 4; ++ks) { const bf16x8 kf = *(const LAS bf16x8*)(krow + 16 * ks); st = mfma32(kf, qf[ks], st); }
        bf16x8 pb[2];
        exp_pack(st, pb);
        const LAS bf16* vb = Vl + ((r0 >> 6) * 64 + c) * TSTR + (r0 & 32) + 8 * hh;
#pragma unroll
        for (int db = 0; db < 2; ++db)
#pragma unroll
            for (int s2 = 0; s2 < 2; ++s2) { const bf16x8 vf = *(const LAS bf16x8*)(vb + db * 32 * TSTR + 16 * s2); ot[db] = mfma32(vf, pb[s2], ot[db]); }
        { const bf16x8 one = ones_frag(); lt = mfma32(one, pb[0], lt); lt = mfma32(one, pb[1], lt); }
    }
    const float l = lt[0];
    bf16* op = X.cgo() + (hb + (size_t)p) * 64 + 4 * hh;
#pragma unroll
    for (int db = 0; db < 2; ++db)
#pragma unroll
        for (int q4 = 0; q4 < 4; ++q4) { u32x2 w; w.x = cvt_pk_bf16(ot[db][4 * q4], ot[db][4 * q4 + 1]); w.y = cvt_pk_bf16(ot[db][4 * q4 + 2], ot[db][4 * q4 + 3]);
            *(u32x2*)(op + 32 * db + 8 * q4) = w; }
    if (hh == 0) X.cgl()[hb + (size_t)p] = l;
}
constexpr int P2_TABC = 0  , P2_IK1 = 65536, P2_TABA = 109056, P2_END = P2_TABA + 8 * TABS * 4;
static_assert(P2_IK1 + 4 * TILE_LDSI <= P2_TABA, "LDS map (DSA pass 1)");
constexpr int A_UTH = 20;
constexpr int A_WBUF = 2 * 32 * TSTR * 2, A_LIST = 8 * A_WBUF, A_LCAP = 440, A_LSTR = 5 * A_LCAP * 2, A_FILL = 352;
static_assert((A_FILL + 64 + 31) / 32 * 32 <= A_LCAP, "list capacity: a full tile after A_FILL entries, padded to whole blocks");
static_assert(A_LIST + 8 * A_LSTR <= P2_TABA && A_LSTR % 8 == 0, "LDS map (compacted DSA pass)");
__device__ __forceinline__ void mixA_unit(const Ctx& X, LAS unsigned char* lds, unsigned char* kcache  , int bl, int u, int tid) {
    const int lane = tid & 63, wave = __builtin_amdgcn_readfirstlane(tid >> 6);
    const LAS float* tabA = (const LAS float*)(lds + P2_TABA);
    LAS unsigned* hist = (LAS unsigned*)(lds + wave * 8192);
    const int t0 = 32 * u + 4 * wave;
    const size_t tok0 = (size_t)bl * SEQ + t0;
    const int qi = lane >> 4, kk = lane & 15, t = t0 + qi;
    bf16x8 iqf[2];
    { const int row = lane & 15, qa = row >> 2, ih = row & 3, kq = lane >> 4;
      const bf16* p = X.iq() + (tok0 + qa) * 256 + ih * 64 + 8 * kq;
      iqf[0] = *(const bf16x8*)p; iqf[1] = *(const bf16x8*)(p + 32); }
    float w[4];
    { const f32x4 wv = *(const f32x4*)(X.misc() + (tok0 + qi) * 32); w[0] = wv[0] * 512.f; w[1] = wv[1] * 512.f; w[2] = wv[2] * 512.f; w[3] = wv[3] * 512.f; }
    const int ktl = (32 * u + 31) >> 6;
    const bf16* ikg = X.ik() + (size_t)bl * SEQ * 64;
    const int ikoff = (lane & 15) * TSTRI + 8 * (lane >> 4);
    unsigned short* kcw = (unsigned short*)(kcache + wave * 32768) + 4 * kk + qi;
    const u32x2* kc = (const u32x2*)(kcache + wave * 32768) + lane;
    const bf16* kg = X.ak() + (size_t)bl * SEQ * 128;
    const bf16* vg = X.avt() + (size_t)bl * SEQ * 64;
    int lo = 0, need = t + 1 < 256 ? t + 1 : 256, ties = 0;
    u32x4 pf0 = tile_ld(ikg, 64, tid), pf1 = tile_ld(ikg + 4096, 64, tid);
#pragma unroll
    for (int i = 0; i < 4; ++i) *(LAS u32x4*)(hist + 4 * lane + 256 * i) = (u32x4){0u, 0u, 0u, 0u};
    tile_sti((LAS bf16*)(lds + P2_IK1), tid, pf0); tile_sti((LAS bf16*)(lds + P2_IK1 + TILE_LDSI), tid, pf1);
    __syncthreads();
#pragma unroll 1
    for (int rep0 = 0; rep0 < ((DUPA & 1) ? 2 : 1); ++rep0)
    {
        if ((DUPA & 1) && rep0 == 1) {
            pf0 = tile_ld(ikg, 64, tid); pf1 = tile_ld(ikg + 4096, 64, tid);
#pragma unroll
            for (int i = 0; i < 4; ++i) *(LAS u32x4*)(hist + 4 * lane + 256 * i) = (u32x4){0u, 0u, 0u, 0u};
            tile_sti((LAS bf16*)(lds + P2_IK1), tid, pf0); tile_sti((LAS bf16*)(lds + P2_IK1 + TILE_LDSI), tid, pf1);
            __syncthreads();
        }
        const int nst = (ktl >> 1) + 1;
#pragma unroll 1
        for (int st = 0; st < nst; ++st) {
            u32x4 rn0, rn1; const bool more = st + 1 < nst;
            if (more) { rn0 = tile_ld(ikg + (size_t)(2 * st + 2) * 4096, 64, tid); rn1 = tile_ld(ikg + (size_t)(2 * st + 3) * 4096, 64, tid); }
            bf16x8 fr[2][4][2];
            idx_frag_ld((const LAS bf16*)(lds + P2_IK1 + ((st & 1) * 2 + 0) * TILE_LDSI) + ikoff, fr[0]);
            idx_frag_ld((const LAS bf16*)(lds + P2_IK1 + ((st & 1) * 2 + 1) * TILE_LDSI) + ikoff, fr[1]);
            __builtin_amdgcn_sched_barrier(0);
#pragma unroll
            for (int h2 = 0; h2 < 2; ++h2) {
                const int kt = 2 * st + h2;
                int key[4]; idx_keys_f(fr[h2], iqf, w, key);
#pragma unroll
                for (int blk = 0; blk < 4; ++blk) kcw[256 * kt + 64 * blk] = (unsigned short)key[blk];
                if (DUPA & 4) {
#pragma unroll
                    for (int blk = 0; blk < 4; ++blk) { asm volatile("" ::: "memory"); ((volatile unsigned short*)kcw)[256 * kt + 64 * blk] = (unsigned short)key[blk]; } }
                if (kt < ktl) {
#pragma unroll
                    for (int blk = 0; blk < 4; ++blk) __hip_atomic_fetch_add(hist + qi * 256 + ((unsigned)key[blk] >> 8), 1u, __ATOMIC_RELAXED, __HIP_MEMORY_SCOPE_WORKGROUP);
                } else {
#pragma unroll
                    for (int blk = 0; blk < 4; ++blk) { const int sk = kt * 64 + 16 * blk + kk;
                        if (sk <= t) __hip_atomic_fetch_add(hist + qi * 256 + ((unsigned)key[blk] >> 8), 1u, __ATOMIC_RELAXED, __HIP_MEMORY_SCOPE_WORKGROUP); }
                }
            }
            if (more) { tile_sti((LAS bf16*)(lds + P2_IK1 + (((st + 1) & 1) * 2) * TILE_LDSI), tid, rn0); tile_sti((LAS bf16*)(lds + P2_IK1 + (((st + 1) & 1) * 2 + 1) * TILE_LDSI), tid, rn1); }
            __syncthreads();
        }
    }
    const bool compact = u >= A_UTH;
    if (!compact) { pf0 = tile_ld(kg, 128, tid); pf1 = tile_ld(vg, 64, tid); }
    int sv_lo = 0, sv_need = 0, sv_ties = 0, l1rep = 0;
#pragma unroll 1
    for (int lvl = 0; lvl < 2; ++lvl) {
        if ((DUPA & 8) && lvl == 1) { if (l1rep == 0) { sv_lo = lo; sv_need = need; sv_ties = ties; } else { lo = sv_lo; need = sv_need; ties = sv_ties; } }
        const int shift = lvl == 0 ? 8 : 0;
        if (lvl == 1) {
#pragma unroll
            for (int i = 0; i < 4; ++i) *(LAS u32x4*)(hist + 4 * lane + 256 * i) = (u32x4){0u, 0u, 0u, 0u};
            const int lo0 = __shfl(lo, 0), lo1 = __shfl(lo, 16), lo2 = __shfl(lo, 32), lo3 = __shfl(lo, 48);
#pragma unroll 1
            for (int kt0 = 0; kt0 <= ktl; kt0 += 4) {
                u32x2 cw[4];
#pragma unroll
                for (int j = 0; j < 4; ++j) { const int kt = kt0 + j < ktl ? kt0 + j : ktl; cw[j] = kc[64 * kt]; }
#pragma unroll
                for (int j = 0; j < 4; ++j) {
                    const int kt = kt0 + j;
                    if (kt <= ktl) {
                        const int sk = kt * 64 + lane;
#pragma unroll
                        for (int q = 0; q < 4; ++q) {
                            const unsigned k16 = q == 0 ? (cw[j].x & 0xffffu) : (q == 1 ? (cw[j].x >> 16) : (q == 2 ? (cw[j].y & 0xffffu) : (cw[j].y >> 16)));
                            const unsigned d = k16 - (unsigned)(q == 0 ? lo0 : (q == 1 ? lo1 : (q == 2 ? lo2 : lo3)));
                            if (d < 256u && (kt < ktl || sk <= t0 + q)) __hip_atomic_fetch_add(hist + q * 256 + d, 1u, __ATOMIC_RELAXED, __HIP_MEMORY_SCOPE_WORKGROUP);
                        }
                    }
                }
            }
        }
#pragma unroll
        for (int q = 0; q < 4; ++q) {
            const u32x4 w0 = *(const LAS u32x4*)(hist + q * 256 + 4 * lane);
            const unsigned cn[4] = {w0.x, w0.y, w0.z, w0.w};
            const unsigned sum = (cn[0] + cn[1]) + (cn[2] + cn[3]);
            unsigned v = sum;
#pragma unroll
            for (int o = 1; o < 64; o <<= 1) { const unsigned tt = __shfl_down(v, o); if (lane + o < 64) v += tt; }
            const int needq = __shfl(need, 16 * q);
            const unsigned long long ball = __ballot((int)v >= needq);
            const int Ls = 63 - __builtin_clzll(ball | 1ull);
            const int rem = needq - (int)__shfl(v - sum, Ls);
            int c = 0, bsel = 0, abv = 0, cb = 0; bool found = false;
#pragma unroll
            for (int i = 3; i >= 0; --i) { const int ci = (int)cn[i]; const bool hit = !found && (c + ci >= rem); if (hit) { bsel = i; abv = c; cb = ci; } found = found || hit; c += ci; }
            const int bstar = __shfl(4 * lane + bsel, Ls), above = (int)__shfl(v - sum, Ls) + __shfl(abv, Ls), cnt = __shfl(cb, Ls);
            if (qi == q) { lo += bstar << shift; need -= above; ties = cnt; }
        }
        if ((DUPA & 8) && lvl == 1 && l1rep == 0) { l1rep = 1; lvl = 0; }
    }
    int Tq[4], rq[4], tsq[4]; bool slq[4];
#pragma unroll
    for (int q = 0; q < 4; ++q) { Tq[q] = __shfl(lo, 16 * q); rq[q] = __shfl(need, 16 * q); slq[q] = __shfl(ties, 16 * q) != rq[q]; tsq[q] = 0; }
    __syncthreads();
    const int c = lane & 31, hh = lane >> 5, qa = c >> 3, h = c & 7;
    bf16x8 qf[4];
    { const bf16* qrow = X.aq() + (tok0 + qa) * 512 + h * 64 + 8 * hh;
#pragma unroll
      for (int ks = 0; ks < 4; ++ks) qf[ks] = *(const bf16x8*)(qrow + 16 * ks); }
    f32x16 ot[2] = {zero16(), zero16()}; float l = 0.f;
    const LAS float* tabh = tabA + h * TABS + 64;
    const float bfar = tabh[1599];
    const int kvoff = c * TSTR + 8 * hh;
    if (compact) {
        LAS unsigned short* lidx = (LAS unsigned short*)(lds + A_LIST + wave * A_LSTR); LAS unsigned short* loff = lidx + A_LCAP;
        LAS bf16* Kb = (LAS bf16*)(lds + wave * A_WBUF); LAS bf16* Vb = Kb + 32 * TSTR;
        const int grow = lane >> 3, gch = (lane & 7) * 8;
        const int m16 = lane & 15, g16 = lane >> 4;
        const LAS bf16* vtr0 = Vb + (4 * (g16 >> 1) + (m16 >> 2)) * TSTR + 16 * (g16 & 1) + 4 * (m16 & 3);
        const LAS unsigned char* tabq = lds + P2_TABA + (h * TABS + qa) * 4;
        const LAS unsigned short* loq = loff + qa * A_LCAP;
        u32x4 gk[4], gv[4];
#pragma unroll 1
        for (int repm = 0; repm < ((DUPA & 16) ? 2 : 1); ++repm) {
        if ((DUPA & 16) && repm == 1) { ot[0] = zero16(); ot[1] = zero16(); l = 0.f; tsq[0] = tsq[1] = tsq[2] = tsq[3] = 0; }
        int n = 0, kt = 0; bool inflight = false;
        u32x2 cwn = kc[0];
#pragma unroll 1
        for (;;) {
#pragma unroll 1
            while (kt <= ktl && n <= A_FILL) {
                const int s0 = kt * 64; const u32x2 cw = cwn;
                if (kt < ktl) cwn = kc[64 * (kt + 1)];
                const int kq[4] = {(int)(cw.x & 0xffffu), (int)(cw.x >> 16), (int)(cw.y & 0xffffu), (int)(cw.y >> 16)};
                unsigned nib = 0u;
#pragma unroll
                for (int q = 0; q < 4; ++q) {
                    const bool causal = (kt < ktl) || (s0 + lane <= t0 + q);
                    bool sel;
                    if (!slq[q]) sel = causal && kq[q] >= Tq[q];
                    else {
                        const unsigned long long be = __ballot(causal && kq[q] == Tq[q]);
                        const int below = (int)__builtin_amdgcn_mbcnt_hi((unsigned)(be >> 32), __builtin_amdgcn_mbcnt_lo((unsigned)be, 0u));
                        sel = causal && (kq[q] > Tq[q] || (kq[q] == Tq[q] && tsq[q] + below < rq[q]));
                        tsq[q] += __builtin_popcountll(be);
                    }
                    nib |= sel ? (1u << q) : 0u;
                }
                const unsigned long long bu = __ballot(nib != 0u);
                const int pos = n + (int)__builtin_amdgcn_mbcnt_hi((unsigned)(bu >> 32), __builtin_amdgcn_mbcnt_lo((unsigned)bu, 0u));
                if (nib != 0u) {
                    int e = t0 - (s0 + lane); e = e > 1596 ? 1596 : e;
                    const unsigned off = (unsigned)(e + 64) * 4u;
                    lidx[pos] = (unsigned short)(s0 + lane);
#pragma unroll
                    for (int q = 0; q < 4; ++q) loff[q * A_LCAP + pos] = (unsigned short)(((nib >> q) & 1u) ? off : 0u);
                }
                n += __builtin_popcountll(bu);
                ++kt;
            }
            const bool last = kt > ktl;
            int nb;
            if (last) { nb = (n + 31) >> 5; const int p = n + lane;
                if (p < 32 * nb) { lidx[p] = (unsigned short)t0; loff[p] = 0; loff[A_LCAP + p] = 0; loff[2 * A_LCAP + p] = 0; loff[3 * A_LCAP + p] = 0; } }
            else nb = (n >> 5) - 1;
            asm volatile("" ::: "memory");
            if (!inflight) {
#pragma unroll
                for (int i = 0; i < 4; ++i) { const int sk = lidx[grow + 8 * i]; const bf16* rp = kg + (size_t)sk * 128 + gch; gk[i] = *(const u32x4*)rp; gv[i] = *(const u32x4*)(rp + 64); }
            }
#pragma unroll 1
            for (int blkc = 0; blkc < nb; ++blkc) {
#pragma unroll
                for (int i = 0; i < 4; ++i) { *(LAS u32x4*)(Kb + (grow + 8 * i) * TSTR + gch) = gk[i]; *(LAS u32x4*)(Vb + (grow + 8 * i) * TSTR + gch) = gv[i]; }
                asm volatile("" ::: "memory");
                if (blkc + 1 < nb || !last) {
#pragma unroll
                    for (int i = 0; i < 4; ++i) { const int sk = lidx[32 * (blkc + 1) + grow + 8 * i]; const bf16* rp = kg + (size_t)sk * 128 + gch; gk[i] = *(const u32x4*)rp; gv[i] = *(const u32x4*)(rp + 64); }
                }
                bf16x8 kf[4], vf[2][2];
#pragma unroll
                for (int ks = 0; ks < 4; ++ks) kf[ks] = *(const LAS bf16x8*)(Kb + c * TSTR + 8 * hh + 16 * ks);
                u32x2 ow[4];
#pragma unroll
                for (int j = 0; j < 4; ++j) ow[j] = *(const LAS u32x2*)(loq + 32 * blkc + 8 * j + 4 * hh);
#pragma unroll
                for (int db = 0; db < 2; ++db)
#pragma unroll
                    for (int s2 = 0; s2 < 2; ++s2) {
                        const s16x4_t lo4 = __builtin_bit_cast(s16x4_t, __builtin_amdgcn_ds_read_tr16_b64_v4i16((LAS v4i16_t*)(vtr0 + (16 * s2) * TSTR + 32 * db)));
                        const s16x4_t hi4 = __builtin_bit_cast(s16x4_t, __builtin_amdgcn_ds_read_tr16_b64_v4i16((LAS v4i16_t*)(vtr0 + (16 * s2 + 8) * TSTR + 32 * db)));
                        vf[db][s2] = (bf16x8){lo4[0], lo4[1], lo4[2], lo4[3], hi4[0], hi4[1], hi4[2], hi4[3]};
                    }
                f32x16 st;
#pragma unroll
                for (int j = 0; j < 4; ++j)
#pragma unroll
                    for (int i2 = 0; i2 < 4; ++i2) {
                        const unsigned off = ((i2 < 2 ? ow[j].x : ow[j].y) >> (16 * (i2 & 1))) & 0xffffu;
                        st[4 * j + i2] = *(const LAS float*)(tabq + off);
                    }
                __builtin_amdgcn_sched_barrier(0);
#pragma unroll
                for (int ks = 0; ks < 4; ++ks) st = mfma32(kf[ks], qf[ks], st);
                bf16x8 pb[2];
                exp_pack_sum(st, pb, l);
#pragma unroll
                for (int db = 0; db < 2; ++db)
#pragma unroll
                    for (int s2 = 0; s2 < 2; ++s2) ot[db] = mfma32(vf[db][s2], pb[s2], ot[db]);
                asm volatile("" ::: "memory");
            }
            if (last) break;
            { const int src = 32 * nb + lane; const bool mv = src < n;
              unsigned short vi = 0, v0 = 0, v1 = 0, v2 = 0, v3 = 0;
              if (mv) { vi = lidx[src]; v0 = loff[src]; v1 = loff[A_LCAP + src]; v2 = loff[2 * A_LCAP + src]; v3 = loff[3 * A_LCAP + src]; }
              asm volatile("" ::: "memory");
              if (mv) { lidx[lane] = vi; loff[lane] = v0; loff[A_LCAP + lane] = v1; loff[2 * A_LCAP + lane] = v2; loff[3 * A_LCAP + lane] = v3; }
              asm volatile("" ::: "memory"); }
            n -= 32 * nb; inflight = true;
        }
        }
        __syncthreads();
    } else {
    tile_st((LAS bf16*)lds, tid, pf0); tile_st((LAS bf16*)(lds + TILE_LDS), tid, pf1);
        u32x2 cwn = kc[0];
        __syncthreads();
    #pragma unroll 1
        for (int kt = 0; kt <= ktl; ++kt) {
            const int s0 = kt * 64; const bool more = kt < ktl;
            u32x4 rk, rv;
            const u32x2 cw = cwn;
            if (more) { rk = tile_ld(kg + (size_t)(kt + 1) * 8192, 128, tid); rv = tile_ld(vg + (size_t)(kt + 1) * 4096, 64, tid); cwn = kc[64 * (kt + 1)]; }
            const LAS bf16* kb_ = (const LAS bf16*)(lds + (kt & 1) * (2 * TILE_LDS)); const LAS bf16* vb_ = kb_ + 64 * TSTR;
            const int kq[4] = {(int)(cw.x & 0xffffu), (int)(cw.x >> 16), (int)(cw.y & 0xffffu), (int)(cw.y >> 16)};
            unsigned long long bq[4];
    #pragma unroll
            for (int q = 0; q < 4; ++q) {
                const bool causal = (kt < ktl) || (s0 + lane <= t0 + q);
                if (!slq[q]) bq[q] = __ballot(causal && kq[q] >= Tq[q]);
                else {
                    const unsigned long long be = __ballot(causal && kq[q] == Tq[q]);
                    const int below = (int)__builtin_amdgcn_mbcnt_hi((unsigned)(be >> 32), __builtin_amdgcn_mbcnt_lo((unsigned)be, 0u));
                    bq[q] = __ballot(causal && (kq[q] > Tq[q] || (kq[q] == Tq[q] && tsq[q] + below < rq[q])));
                    tsq[q] += __builtin_popcountll(be);
                }
            }
            const unsigned long long mq = qa == 0 ? bq[0] : (qa == 1 ? bq[1] : (qa == 2 ? bq[2] : bq[3]));
            const unsigned mw[2] = {(unsigned)mq >> (4 * hh), (unsigned)(mq >> 32) >> (4 * hh)};
            const bool farT = (s0 + 63 <= t0 - 1512);
    #pragma unroll
            for (int kb = 0; kb < 2; ++kb) {
                bf16x8 pb[2];
                if (farT) qks32_ls<2, 1>(kb_ + kvoff + 32 * kb * TSTR, qf, nullptr, bfar, mw[kb], pb, l);
                else qks32_ls<1, 1>(kb_ + kvoff + 32 * kb * TSTR, qf, tabh + (t0 + qa - s0 - 4 * hh - 32 * kb) - 27, 0.f, mw[kb], pb, l);
                pv32_l(ot, vb_ + kvoff + 32 * kb, pb);
            }
            if (more) { LAS bf16* nb_ = (LAS bf16*)(lds + ((kt + 1) & 1) * (2 * TILE_LDS)); tile_st(nb_, tid, rk); tile_st(nb_ + 64 * TSTR, tid, rv); }
            __syncthreads();
        }
    }
    l += shx(l, 32);
    const float inv = 1.f / fmaxf(l, 1e-30f);
    bf16* op = X.oa() + (tok0 + qa) * 512 + h * 64 + 4 * hh;
#pragma unroll
    for (int db = 0; db < 2; ++db)
#pragma unroll
        for (int q4 = 0; q4 < 4; ++q4) { u32x2 wv; wv.x = cvt_pk_bf16(ot[db][4 * q4] * inv, ot[db][4 * q4 + 1] * inv); wv.y = cvt_pk_bf16(ot[db][4 * q4 + 2] * inv, ot[db][4 * q4 + 3] * inv);
            *(u32x2*)(op + 32 * db + 8 * q4) = wv; }
}

__device__ __forceinline__ void ob_flush(bf16* op, const f32x16 (&acc)[2], float sc, bool add) {
#pragma unroll
    for (int db = 0; db < 2; ++db)
#pragma unroll
        for (int q4 = 0; q4 < 4; ++q4) {
            float v[4];
#pragma unroll
            for (int j = 0; j < 4; ++j) v[j] = sc * acc[db][4 * q4 + j];
            if (add) { const u32x2 o = *(const u32x2*)(op + 32 * db + 8 * q4);
                v[0] += __uint_as_float(o.x << 16); v[1] += __uint_as_float(o.x & 0xffff0000u); v[2] += __uint_as_float(o.y << 16); v[3] += __uint_as_float(o.y & 0xffff0000u); }
            u32x2 wv; wv.x = cvt_pk_bf16(v[0], v[1]); wv.y = cvt_pk_bf16(v[2], v[3]);
            *(u32x2*)(op + 32 * db + 8 * q4) = wv; }
}
constexpr int P3_TABB = 65536, P3_SCR = P3_TABB + 8 * TABS * 4, P3_UM = P3_SCR + 8 * 4096, P3_END = P3_UM + 64;
__device__ __forceinline__ void mixB_unit(const Ctx& X, LAS unsigned char* lds, int bl, int g, int it, int tid) {
    const int lane = tid & 63, wave = __builtin_amdgcn_readfirstlane(tid >> 6);
    const LAS float* tabB = (const LAS float*)(lds + P3_TABB);
    LAS unsigned* scr = (LAS unsigned*)(lds + P3_SCR + wave * 4096);
    LAS unsigned long long* um = (LAS unsigned long long*)(lds + P3_UM);
    const int t0 = 64 * it + 8 * wave;
    const int c = lane & 31, hh = lane >> 5, qa = c >> 2, h = c & 3, head = 4 * g + h, t = t0 + qa;
    const size_t tok = (size_t)bl * SEQ + t;
    const int bg = bl * 2 + g;
    bf16x8 qf[4];
    { const bf16* qrow = X.bq() + tok * 512 + head * 64 + 8 * hh;
#pragma unroll
      for (int ks = 0; ks < 4; ++ks) qf[ks] = *(const bf16x8*)(qrow + 16 * ks); }
    const float g0 = X.misc()[tok * 32 + 4 + head * 3 + 0], g1 = X.misc()[tok * 32 + 4 + head * 3 + 1], g2 = X.misc()[tok * 32 + 4 + head * 3 + 2];
    f32x16 out[2] = {zero16(), zero16()};
    const int kvoff = c * TSTR + 8 * hh;
#define KBUF(b) ((LAS bf16*)(lds + (b) * 2 * TILE_LDS))
#define VBUF(b) ((LAS bf16*)(lds + (b) * 2 * TILE_LDS + TILE_LDS))
    const int nmW = ((64 * it + 63) - 31) >> 4;
    const int nmw = ((t0 + 7) - 31) >> 4, nm = (t - 31) >> 4;
    const int nblw = nmw >> 5;
    LAS float* impb = (LAS float*)scr;
#pragma unroll
    for (int i = 0; i < 8; ++i) impb[lane + 64 * i] = 0.f;
    if (nmW >= 0) {
        const int ntl = nmW >> 6;
        const bf16* kcg = X.kcmp() + (size_t)bg * 256 * 64;
        const bf16* vcg = X.vcmpt() + (size_t)bg * 64 * 256;
        float lc = 0.f; u32x4 pfk, pfv;
        { const u32x4 r0 = tile_ld(kcg, 64, tid); tile_st(KBUF(0), tid, r0); }
        __syncthreads();
#pragma unroll 1
        for (int tl = 0; tl <= ntl; ++tl) {
            u32x4 rk; const bool more = tl < ntl;
            if (more) rk = tile_ld(kcg + (size_t)(tl + 1) * 4096, 64, tid);
            else { pfk = tile_ld(kcg, 64, tid); pfv = tile_ld(vcg, 256, tid); }
#pragma unroll
            for (int kb = 0; kb < 2; ++kb) {
                const int nb = 2 * tl + kb;
                if (nb <= nblw) {
                    const f32x16 st = qk32_l(KBUF(tl & 1) + kvoff + 32 * kb * TSTR, qf);
                    const unsigned keep = keep_le(nm - 32 * nb - 4 * hh);
#pragma unroll
                    for (int r = 0; r < 16; ++r) { const int sel = ((int)(keep << (31 - ROWC(r)))) >> 31; lc += __builtin_bit_cast(float, __builtin_bit_cast(int, __builtin_amdgcn_exp2f(st[r])) & sel); }
                }
            }
            if (more) tile_st(KBUF((tl + 1) & 1), tid, rk);
            __syncthreads();
        }
        lc += shx(lc, 32);
        const float invc = lc > 0.f ? 1.f / lc : 0.f;
        f32x16 oc[2] = {zero16(), zero16()};
        float carry = 0.f;
        tile_st(KBUF(0), tid, pfk); tile_st(VBUF(0), tid, pfv);
        __syncthreads();
#pragma unroll 1
        for (int tl = 0; tl <= ntl; ++tl) {
            u32x4 rk, rv; const bool more = tl < ntl;
            if (more) { rk = tile_ld(kcg + (size_t)(tl + 1) * 4096, 64, tid); rv = tile_ld(vcg + (tl + 1) * 64, 256, tid); }
#pragma unroll
            for (int kb = 0; kb < 2; ++kb) {
                const int nb = 2 * tl + kb;
                if (nb <= nblw) {
                    const f32x16 st = qk32_l(KBUF(tl & 1) + kvoff + 32 * kb * TSTR, qf);
                    const unsigned keep = keep_le(nm - 32 * nb - 4 * hh);
                    float p[16];
#pragma unroll
                    for (int r = 0; r < 16; ++r) { const int sel = ((int)(keep << (31 - ROWC(r)))) >> 31; p[r] = __builtin_bit_cast(float, __builtin_bit_cast(int, __builtin_amdgcn_exp2f(st[r])) & sel) * invc; }
                    bf16x8 pb[2];
#pragma unroll
                    for (int s = 0; s < 2; ++s) { u32x4 wv; wv.x = cvt_pk_bf16(p[8 * s + 0], p[8 * s + 1]); wv.y = cvt_pk_bf16(p[8 * s + 2], p[8 * s + 3]); wv.z = cvt_pk_bf16(p[8 * s + 4], p[8 * s + 5]); wv.w = cvt_pk_bf16(p[8 * s + 6], p[8 * s + 7]);
                        pb[s] = __builtin_bit_cast(bf16x8, wv); }
                    pv32_l(oc, VBUF(tl & 1) + kvoff + 32 * kb, pb);
                    float rc[4];
#pragma unroll
                    for (int qd = 0; qd < 4; ++qd) rc[qd] = shx(p[4 * qd + 3], 32);
#pragma unroll
                    for (int qd = 0; qd < 4; ++qd) {
                        const float ex = hh ? rc[qd] : (qd == 0 ? carry : rc[qd - 1]);
                        float v = (p[4 * qd] + p[4 * qd + 1]) + (p[4 * qd + 2] + p[4 * qd + 3]) + ex;
                        v += shx(v, 1); v += shx(v, 2);
                        if (h == 0) impb[qa * 64 + 8 * nb + 2 * qd + hh] = v;
                    }
                    carry = rc[3];
                }
            }
            if (more) { tile_st(KBUF((tl + 1) & 1), tid, rk); tile_st(VBUF((tl + 1) & 1), tid, rv); }
            __syncthreads();
        }
#pragma unroll
        for (int db = 0; db < 2; ++db)
#pragma unroll
            for (int r = 0; r < 16; ++r) out[db][r] = g0 * oc[db][r];
    }
    const bf16* ksg = X.bks() + (size_t)bg * SEQ * 64; const bf16* vsg = X.bvst() + (size_t)bg * SEQ * 64;
    const u32x4 ps0 = tile_ld(ksg, 64, tid), ps1 = tile_ld(vsg, 64, tid);
    LAS unsigned long long* selm = (LAS unsigned long long*)(scr + 512);
    unsigned long long ormask = 0ull;
#pragma unroll 1
    for (int q0 = 0; q0 < 8; q0 += 4) {
        const int m = lane;
        unsigned key[4], Tq[4];
#pragma unroll
        for (int j = 0; j < 4; ++j) {
            const float iv = impb[(q0 + j) * 64 + m];
            key[j] = 0u; Tq[j] = 0u;
            if (m <= it) { const bool forced = (m == 0) || (m == it) || (m == it - 1);
                key[j] = forced ? (0xffffff00u | (unsigned)(63 - m)) : ((__builtin_bit_cast(unsigned, iv) & ~63u) | (unsigned)(63 - m)); }
        }
#pragma unroll 1
        for (int bit = 31; bit >= 0; --bit) {
#pragma unroll
            for (int j = 0; j < 4; ++j) { const unsigned cand = Tq[j] | (1u << bit); if (__builtin_popcountll(__ballot(key[j] >= cand)) >= 16) Tq[j] = cand; }
        }
#pragma unroll
        for (int j = 0; j < 4; ++j) {
            const unsigned long long mk = __ballot(key[j] >= Tq[j] && key[j] != 0u);
            if (lane == 0) selm[q0 + j] = mk;
            ormask |= mk;
        }
    }
    const unsigned long long mymask = selm[qa];
    if (lane == 0) um[wave] = ormask;
    __syncthreads();
    unsigned long long U = 0ull;
#pragma unroll
    for (int i = 0; i < 8; ++i) U |= um[i];
    const LAS float* tabh = tabB + head * TABS + 64;
    const float bfar = tabh[1599];
    const bf16* kwg = X.bkw() + (size_t)bg * SEQ * 64; const bf16* vwg = X.bvwt() + (size_t)bg * SEQ * 64;
    int m0W = (64 * it - 511) >> 6; if (m0W < 0) m0W = 0;
    u32x4 pw0, pw1;
    {
        f32x16 os[2] = {zero16(), zero16()}; float ls = 0.f;
        const bf16* kg = ksg; const bf16* vg = vsg;
        int m = 0;
        tile_st(KBUF(0), tid, ps0); tile_st(VBUF(0), tid, ps1);
        __syncthreads();
        int b = 0;
#pragma unroll 1
        for (;;) {
            const unsigned long long rest = (m >= 63) ? 0ull : (U >> (m + 1));
            const bool more = rest != 0ull; const int mn = more ? m + 1 + __builtin_ctzll(rest) : m;
            u32x4 rk, rv;
            if (more) { rk = tile_ld(kg + (size_t)mn * 4096, 64, tid); rv = tile_ld(vg + (size_t)mn * 4096, 64, tid); }
            else { pw0 = tile_ld(kwg + (size_t)m0W * 4096, 64, tid); pw1 = tile_ld(vwg + (size_t)m0W * 4096, 64, tid); }
            if ((ormask >> m) & 1ull) {
                const int s0 = m * 64;
                const unsigned lanekeep = ((mymask >> m) & 1ull) ? 0xffffffffu : 0u;
                const bool farT = (s0 + 63 <= t0 - 1512);
                const LAS float* bt = tabh + (t - s0 - 4 * hh) - 27;
                if (m == it) tile64_l<1, 1>(KBUF(b) + kvoff, VBUF(b) + kvoff, qf, bt, 0.f, lanekeep & keep_le(t - s0 - 4 * hh), lanekeep & keep_le(t - s0 - 32 - 4 * hh), os, ls);
                else if (farT) tile64_l<2, 2>(KBUF(b) + kvoff, VBUF(b) + kvoff, qf, nullptr, bfar, lanekeep, lanekeep, os, ls);
                else tile64_l<1, 2>(KBUF(b) + kvoff, VBUF(b) + kvoff, qf, bt, 0.f, lanekeep, lanekeep, os, ls);
            }
            if (more) { tile_st(KBUF(b ^ 1), tid, rk); tile_st(VBUF(b ^ 1), tid, rv); }
            __syncthreads();
            if (!more) break;
            m = mn; b ^= 1;
        }
        ls += shx(ls, 32);
        const float sc = g1 / fmaxf(ls, 1e-30f);
#pragma unroll
        for (int db = 0; db < 2; ++db)
#pragma unroll
            for (int r = 0; r < 16; ++r) out[db][r] += sc * os[db][r];
    }
    {
        f32x16 ow[2] = {zero16(), zero16()}; float lw = 0.f;
        const bf16* kg = kwg; const bf16* vg = vwg;
        int m0 = (t0 - 511) >> 6; if (m0 < 0) m0 = 0;
        tile_st(KBUF(0), tid, pw0); tile_st(VBUF(0), tid, pw1);
        __syncthreads();
#pragma unroll 1
        for (int m = m0W; m <= it; ++m) {
            const int b = (m - m0W) & 1; const bool more = m < it;
            u32x4 rk, rv;
            if (more) { rk = tile_ld(kg + (size_t)(m + 1) * 4096, 64, tid); rv = tile_ld(vg + (size_t)(m + 1) * 4096, 64, tid); }
            if (m >= m0) {
                const int s0 = m * 64;
#pragma unroll
                for (int kb = 0; kb < 2; ++kb) {
                    bf16x8 pb[2];
                    if (s0 + 63 <= t0 && s0 >= t0 + 7 - 511)
                        qks32_ls<1, 0>(KBUF(b) + kvoff + 32 * kb * TSTR, qf, tabh + (t - s0 - 4 * hh - 32 * kb) - 27, 0.f, 0u, pb, lw);
                    else qks32_ls<1, 1>(KBUF(b) + kvoff + 32 * kb * TSTR, qf, tabh + (t - s0 - 4 * hh - 32 * kb) - 27, 0.f, keep_le(t - s0 - 32 * kb - 4 * hh) & keep_ge(t - 511 - s0 - 32 * kb - 4 * hh), pb, lw);
                    pv32_l(ow, VBUF(b) + kvoff + 32 * kb, pb);
                }
            }
            if (more) { tile_st(KBUF(b ^ 1), tid, rk); tile_st(VBUF(b ^ 1), tid, rv); }
            __syncthreads();
        }
        lw += shx(lw, 32);
        const float sc = g2 / fmaxf(lw, 1e-30f);
#pragma unroll
        for (int db = 0; db < 2; ++db)
#pragma unroll
            for (int r = 0; r < 16; ++r) out[db][r] += sc * ow[db][r];
    }
#undef KBUF
#undef VBUF
    bf16* op = X.ob() + tok * 512 + head * 64 + 4 * hh;
#pragma unroll
    for (int db = 0; db < 2; ++db)
#pragma unroll
        for (int q4 = 0; q4 < 4; ++q4) { u32x2 wv; wv.x = cvt_pk_bf16(out[db][4 * q4], out[db][4 * q4 + 1]); wv.y = cvt_pk_bf16(out[db][4 * q4 + 2], out[db][4 * q4 + 3]);
            *(u32x2*)(op + 32 * db + 8 * q4) = wv; }
}

constexpr int NWAVES = 8;
constexpr int LDS_BYTES = 163840, LDSCTL_OFF = 162816, MISC_OFF = LDSCTL_OFF + 320;
static_assert(P2_END <= LDSCTL_OFF && P3_END <= LDSCTL_OFF, "LDS map");
constexpr int CW_BAR = 4096, CW_QUEUE = 16384;
constexpr int PH_PER = 7;

__global__ void __launch_bounds__(NWAVES * 64, 2) mk_fwd(Args args) {
    extern __shared__ __attribute__((aligned(16))) unsigned char lds_raw[];
    LAS unsigned char* lds = (LAS unsigned char*)lds_raw;
    volatile LAS unsigned* MISCW = (volatile LAS unsigned*)(lds + MISC_OFF);
    const int tid = threadIdx.x, lane = tid & 63, wave = __builtin_amdgcn_readfirstlane(tid >> 6);
    constexpr int T = TCH;
    unsigned char* ws = args.ws;
    unsigned* ctl = (unsigned*)(ws + MP.ctl);
    for (int u = tid; u < (LDS_BYTES - LDSCTL_OFF) / 4; u += NWAVES * 64) ((LAS unsigned*)(lds + LDSCTL_OFF))[u] = 0u;
    __syncthreads();
    XcdBarrier bar; bar.bar = ctl + CW_BAR; bar.x = 0; bar.st = nullptr;
    if (MK_SINGLE) bar = xcd_barrier_post(ctl + CW_BAR, MISCW + 8);
    const int lo = args.ph_lo, hi = args.ph_hi;
#define IN(k) (lo <= (k) && (k) < hi)
#define SEAM(k) do { if (IN(k) && IN((k) + 1)) { xcd_barrier(bar); if (DUP & 128) xcd_barrier(bar); } } while (0)
#define GWVARS const int vcu = (G % 8 == 0) ? (bx % 8) * (G / 8) + bx / 8 : bx, gw = vcu * NWAVES + wave, NGW = G * NWAVES; (void)gw; (void)NGW;

#pragma unroll 1
    for (int rep0 = 0; rep0 < ((DUP & 64) ? 2 : 1); ++rep0)
    if (IN(0) && (PHMASK & 1)) {
        const int G = gridDim.x, bx = blockIdx.x; GWVARS
        float* biasA = (float*)(ws + MP.biasA); float* biasB = (float*)(ws + MP.biasB); float* biasC = (float*)(ws + MP.biasC); float* cmpb = (float*)(ws + MP.cmpb);
        bf16* XB = (bf16*)(ws + MP.xb); float* SSQ1 = (float*)(ws + MP.ssq1);
        LAS float* scr = (LAS float*)(lds + wave * 16384);
        {
            constexpr int nitm[10] = {16 * (N_MAIN / 32), 16 * (N_VT / 32), 8 * 32, 8 * 32, 4 * 32, 16 * 32, 16 * (N_FF2 / 32), (DFF / 64) * 32, 32 * 8, 32 * 8};
            constexpr int NL = nitm[0] + nitm[1] + nitm[2] + nitm[3] + nitm[4] + nitm[5] + nitm[6] + nitm[7] + nitm[8] + nitm[9];
            f32x4 v[8]; int cK = 0, ck0 = 0, cn0 = 0; bf16* cdst = nullptr; bool have = false;
#pragma unroll 1
            for (int itg = gw; ; itg += NGW) {
                const bool valid = itg < NLAYER * NL;
                f32x4 vn[8]; int nK = 0, nk0 = 0, nn0 = 0; bf16* ndst = nullptr;
                if (valid) {
                    const int l = itg / NL; int it = itg % NL, mi = 0;
#pragma unroll
                    for (int q = 0; q < 9; ++q) if (mi == q && it >= nitm[q]) { it -= nitm[q]; mi = q + 1; }
                    const float* win = args.in[3] + (size_t)l * DM * IN_TOTAL;
                    const float* src; int K, Nsrc, Nd; const float* gk = nullptr;
                    switch (mi) {
                        case W_IN: src = win; K = DM; Nsrc = IN_TOTAL; Nd = N_MAIN; gk = args.in[1] + l * DM; break;
                        case W_VT: src = win; K = DM; Nsrc = IN_TOTAL; Nd = N_VT; gk = args.in[1] + l * DM; break;
                        case W_BA: src = args.in[7] + (size_t)l * 512 * DM; K = 512; Nsrc = DM; Nd = DM; break;
                        case W_BB: src = args.in[8] + (size_t)l * 512 * DM; K = 512; Nsrc = DM; Nd = DM; break;
                        case W_BC: src = args.in[9] + (size_t)l * 256 * DM; K = 256; Nsrc = DM; Nd = DM; break;
                        case W_OUT: src = args.in[10] + (size_t)l * DM * DM; K = DM; Nsrc = DM; Nd = DM; break;
                        case W_FI: src = args.in[11] + (size_t)l * DM * N_FF2; K = DM; Nsrc = N_FF2; Nd = N_FF2; gk = args.in[2] + l * DM; break;
                        case W_FO: src = args.in[12] + (size_t)l * DFF * DM; K = DFF; Nsrc = DM; Nd = DM; break;
                        case W_CK: src = args.in[6] + (size_t)(l * 2 + 0) * 2048 * 64; K = 2048; Nsrc = 64; Nd = 256; break;
                        default:   src = args.in[6] + (size_t)(l * 2 + 1) * 2048 * 64; K = 2048; Nsrc = 64; Nd = 256; break;
                    }
                    bf16* dst = (bf16*)(ws + MP.w[0][0] + (size_t)l * (MP.w[1][0] - MP.w[0][0])) ;
                    { size_t off = 0;
#pragma unroll
                      for (int q = 0; q < 10; ++q) if (q == mi) off = MP.w[0][q] - MP.w[0][0];
                      dst = (bf16*)((unsigned char*)dst + off); }
                    const int nblk = Nd / 32, kb = it / nblk, nb = it % nblk, row = nb * 32 + 4 * (lane & 7);
                    int sc;
                    if (mi == W_IN) sc = main_src(row); else if (mi == W_VT) sc = vt_src(row); else if (mi == W_FI) sc = ffn_src(row);
                    else if (mi == W_CK) sc = (((row & 127) >> 5) == 0) ? (32 * ((row & 255) >> 7) + (row & 31)) : -1;
                    else if (mi == W_CV) sc = row < 64 ? row : -1; else sc = row;
                    ti_load(src, Nsrc, kb * 64, sc, gk, lane, vn); nK = K; nk0 = kb * 64; nn0 = nb * 32; ndst = dst;
                }
                if (have) ti_finish(v, cK, cdst, scr, ck0, cn0, lane);
                if (!valid) break;
#pragma unroll
                for (int i = 0; i < 8; ++i) v[i] = vn[i];
                cK = nK; ck0 = nk0; cn0 = nn0; cdst = ndst; have = true;
            }
        }
        {
            bf16* XB = (bf16*)(ws + MP.xb); float* SSQ1 = (float*)(ws + MP.ssq1);
            f32x4 v[2][4];
            { const int r = gw < NTOK / 2 ? gw : 0;
#pragma unroll
              for (int h = 0; h < 2; ++h) { const f32x4* xr = (const f32x4*)(args.in[0] + (size_t)(r + h * (NTOK / 2)) * DM) + lane;
#pragma unroll
                  for (int j = 0; j < 4; ++j) v[h][j] = xr[64 * j]; } }
#pragma unroll 1
            for (int r = gw; r < NTOK / 2; r += NGW) {
                f32x4 vn[2][4];
                { const int rn = r + NGW < NTOK / 2 ? r + NGW : r;
#pragma unroll
                  for (int h = 0; h < 2; ++h) { const f32x4* xr = (const f32x4*)(args.in[0] + (size_t)(rn + h * (NTOK / 2)) * DM) + lane;
#pragma unroll
                      for (int j = 0; j < 4; ++j) vn[h][j] = xr[64 * j]; } }
#pragma unroll
                for (int h = 0; h < 2; ++h) { const size_t row = (size_t)(r + h * (NTOK / 2)); float sq = 0.f;
                    unsigned long long* o8 = (unsigned long long*)(XB + row * DM) + lane;
#pragma unroll
                    for (int j = 0; j < 4; ++j) { const f32x4 x = v[h][j]; sq += (x[0] * x[0] + x[1] * x[1]) + (x[2] * x[2] + x[3] * x[3]);
                        o8[64 * j] = (unsigned long long)pk2(x[0], x[1]) | ((unsigned long long)pk2(x[2], x[3]) << 32); }
                    sq = wave_sum(sq);
                    if (lane < 16) SSQ1[row * 16 + lane] = lane == 0 ? sq : 0.f; }
#pragma unroll
                for (int h = 0; h < 2; ++h)
#pragma unroll
                    for (int j = 0; j < 4; ++j) v[h][j] = vn[h][j];
            }
        }
        const float* rel = args.in[13];
        for (int i = bx * 512 + tid; i < 16 * TABS; i += G * 512) {
            const int hd = i / TABS, e = i % TABS, d = e - 64;
            const float v = d < 0 ? -30000.f   : (d >= 1600 ? 0.f : rel[rel_bucket(d) * 28 + hd] * LOG2E);
            if (hd < 8) biasA[hd * TABS + e] = v; else biasB[(hd - 8) * TABS + e] = v;
        }
        for (int i = bx * 512 + tid; i < 12 * TABC; i += G * 512) {
            const int j = i / TABC, e = i % TABC, jj = e - 32, dil = (j >> 2) == 0 ? 1 : ((j >> 2) == 1 ? 4 : 16);
            biasC[i] = (jj < 0 || jj > 128) ? 0.f : rel[rel_bucket(jj * dil) * 28 + 16 + j] * LOG2E;
        }
        for (int o = gw; o < NLAYER * 2 * 64; o += NGW) {
            const int lk = o >> 6, e = o & 63; const float* pos = args.in[5] + (size_t)lk * 2048; const float* wv = args.in[6] + (size_t)lk * 2048 * 64;
            float s = 0.f;
            for (int k = lane; k < 2048; k += 64) s += pos[k] * wv[(size_t)k * 64 + e];
            s = wave_sum(s);
            if (lane == 0) cmpb[o] = s;
        }
    }
    SEAM(0);

    constexpr int PH_LAYER = NCH * 4 + 3;
#pragma unroll 1
    for (int layer = 0; layer < NLAYER; ++layer) {
#pragma unroll 1
    for (int chk = 0; chk < NCH; ++chk) {
        const int lc = layer * NCH + chk;
        const int pb = 1 + layer * PH_LAYER + chk * 4;
#define LCVARS int lcp = lc; asm volatile("" : "+s"(lcp)); const int l = lcp / NCH, ch = lcp % NCH; const size_t row0 = (size_t)ch * T; const size_t lw = (size_t)l * (MP.w[1][0] - MP.w[0][0]); (void)row0; (void)lw; \
        const int G = gridDim.x, bx = blockIdx.x; (void)G; (void)bx; int tid = threadIdx.x; asm volatile("" : "+v"(tid)); const int lane = tid & 63; (void)lane;

        if (IN(pb + 0) && ((PHMASK >> 1) & 1)) { LCVARS
            const bf16* xbc = (const bf16*)(ws + MP.xb) + row0 * DM; const float* ssq1 = (const float*)(ws + MP.ssq1) + row0 * 16;
#pragma unroll 1
            for (int rep = 0; rep < ((DUP & 1) ? 2 : 1); ++rep)
            { pg8::GemmP1 g{xbc, (const bf16*)(ws + MP.w[0][W_IN] + lw), (const bf16*)(ws + MP.w[0][W_VT] + lw), }; pg8::P1Order<T> S; S.init(G, bx);
              EpiP1 E{ssq1, args.in[4] + (size_t)l * 6 * 64, ws};
              pg8::gemm_phase<EpiP1, pg8::GemmP1, pg8::P1Order<T>>(lds, g, S, E); }
        }
        SEAM(pb + 0);

        if (IN(pb + 1) && ((PHMASK >> 2) & 1)) { LCVARS
            const float* cmpb = (const float*)(ws + MP.cmpb); const float* qkg = args.in[4] + (size_t)l * 6 * 64;
            { pg8::Gemm g{(const bf16*)(ws + MP.bkc), (const bf16*)(ws + MP.w[0][W_CK] + lw), NBC * 2 * 256, 256, 2048, 1024, 2048}; pg8::StaticOrder S; S.init(NBC * 2 * 256, 256, G, (bx < 64 && (bx & 7) == 0) ? (bx >> 3) : (1 << 20));
              EpiCmpK E{cmpb + (l * 2 + 0) * 64, qkg + 3 * 64, (bf16*)(ws + MP.kcmp)}; pg8::gemm_phase<EpiCmpK>(lds, g, S, E); }
            { pg8::Gemm g{(const bf16*)(ws + MP.w[0][W_CV] + lw), (const bf16*)(ws + MP.bvc), 256, NBC * 2 * 256, 2048, 2048, 1024}; pg8::StaticOrder S; S.init(256, NBC * 2 * 256, G, (bx < 64 && (bx & 7) == 2) ? (bx >> 3) : (1 << 20));
              EpiCmpV E{cmpb + (l * 2 + 1) * 64, (bf16*)(ws + MP.vcmpt)}; pg8::gemm_phase<EpiCmpV>(lds, g, S, E); }
            LAS float* tabA = (LAS float*)(lds + P2_TABA); LAS float* tabC = (LAS float*)(lds + P2_TABC);
            __syncthreads();
            { const f32x4* biasA = (const f32x4*)(ws + MP.biasA); constexpr int NA4 = 8 * TABS / 4;
              f32x4 va[(NA4 + 511) / 512];
#pragma unroll
              for (int q = 0; q < (NA4 + 511) / 512; ++q) { const int i = tid + 512 * q; va[q] = biasA[i < NA4 ? i : NA4 - 1]; }
#pragma unroll
              for (int q = 0; q < (NA4 + 511) / 512; ++q) { const int i = tid + 512 * q; if (i < NA4) ((LAS f32x4*)tabA)[i] = va[q]; } }
            __syncthreads();
            Ctx X{ws}; GWVARS
            unsigned char* kcache = (bx & 255) < 128 ? ws + MP.mb + (size_t)(NTOK / 2) * 1024 * 2 + (size_t)(bx & 255) * 262144 : ws + MP.end + (size_t)((bx & 255) - 128) * 262144;
#pragma unroll 1
            for (int rep = 0; rep < ((DUP & 2) ? 2 : 1); ++rep) {
            if ((DUP & 4096) && rep == 1) xcd_barrier(bar);
            if (MK_MIXERS & 2) {
                for (int pr0 = bx; pr0 < 64 * NBC; pr0 += G) {
                    int pr = pr0;
                    if (G == 256 && NBC == 4) { const int x = pr0 & 7, r = pr0 >> 3; pr = ((x >> 1) << 6) | ((x & 1) << 5) | r; }
                    const int bl = pr >> 6, i = pr & 63;
                    mixA_unit(X, lds, kcache, bl, i, tid);
                    mixA_unit(X, lds, kcache, bl, 127 - i, tid);
                }
            } }
            __syncthreads();
            { const f32x4* biasC = (const f32x4*)(ws + MP.biasC); constexpr int NC4 = 12 * TABC / 4;
              f32x4 vc[(NC4 + 511) / 512];
#pragma unroll
              for (int q = 0; q < (NC4 + 511) / 512; ++q) { const int i = tid + 512 * q; vc[q] = biasC[i < NC4 ? i : NC4 - 1]; }
#pragma unroll
              for (int q = 0; q < (NC4 + 511) / 512; ++q) { const int i = tid + 512 * q; if (i < NC4) ((LAS f32x4*)tabC)[i] = vc[q]; } }
            __syncthreads();
            if (MK_MIXERS & 1) {
                constexpr int nq = 12 * (T / 256);
#pragma unroll 1
                for (int repc = 0; repc < ((DUP & 4) ? 2 : 1); ++repc) {
                unsigned* qctr = ctl + CW_QUEUE + 64 * lcp + 16 * repc;
                LAS unsigned* tkw = (LAS unsigned*)(lds + MISC_OFF + 64);
                if (tid == 0) *tkw = __hip_atomic_fetch_add(qctr, 1u, __ATOMIC_RELAXED, __HIP_MEMORY_SCOPE_AGENT);
                __syncthreads();
                unsigned cur = *tkw;
#pragma unroll 1
                while (cur < (unsigned)nq) {
                    __syncthreads();
                    unsigned nxt = 0u;
                    if (tid == 0) nxt = __hip_atomic_fetch_add(qctr, 1u, __ATOMIC_RELAXED, __HIP_MEMORY_SCOPE_AGENT);
                    mixC_ticket(X, lds, tabC, (int)cur / (T / 256), (int)cur % (T / 256), tid);
                    if (tid == 0) *tkw = nxt;
                    __syncthreads();
                    cur = *tkw;
                }
                __syncthreads();
                }
            }
            __syncthreads();
        }
        SEAM(pb + 1);

        if (IN(pb + 2) && ((PHMASK >> 3) & 1)) { LCVARS
            LAS float* tabB = (LAS float*)(lds + P3_TABB);
            __syncthreads();
            { const f32x4* biasB = (const f32x4*)(ws + MP.biasB); constexpr int NB4 = 8 * TABS / 4;
              f32x4 vb[(NB4 + 511) / 512];
#pragma unroll
              for (int q = 0; q < (NB4 + 511) / 512; ++q) { const int i = tid + 512 * q; vb[q] = biasB[i < NB4 ? i : NB4 - 1]; }
#pragma unroll
              for (int q = 0; q < (NB4 + 511) / 512; ++q) { const int i = tid + 512 * q; if (i < NB4) ((LAS f32x4*)tabB)[i] = vb[q]; } }
            __syncthreads();
            Ctx X{ws}; GWVARS
#pragma unroll 1
            for (int rep = 0; rep < ((DUP & 8) ? 2 : 1); ++rep)
            if (MK_MIXERS & 4) {
                for (int pr0 = bx; pr0 < 64 * NBC; pr0 += G) {
                    int pr = pr0;
                    if (G == 256 && NBC == 4) pr = ((pr0 & 7) << 5) | (pr0 >> 3);
                    const int bgp = pr >> 5, i = pr & 31, bl = bgp >> 1, g = bgp & 1;
                    mixB_unit(X, lds, bl, g, i, tid);
                    mixB_unit(X, lds, bl, g, 63 - i, tid);
                }
            }
            if (MK_MIXERS & 1) mixC_combine(X, gw, NGW, lane);
            __syncthreads();
        }
        SEAM(pb + 2);

        if (IN(pb + 3) && ((PHMASK >> 4) & 1)) { LCVARS
#pragma unroll 1
            for (int jj = 0; jj < ((DUP & 16) ? 6 : 3); ++jj) {
                const int j = jj % 3;
                const int Kb = j == 2 ? 256 : 512;
                const bf16* Ao = (const bf16*)(ws + (j == 0 ? MP.oa : (j == 1 ? MP.ob : MP.oc)));
                pg8::Gemm g{Ao, (const bf16*)(ws + MP.w[0][W_BA] + lw + (size_t)j * (MP.w[0][W_BB] - MP.w[0][W_BA])), T, DM, Kb, Kb, Kb}; pg8::StaticOrder S; S.init(T, DM, G, bx);
                EpiBranch E{(const unsigned char*)(ws + MP.mixg) + j * 1024, (bf16*)(ws + MP.mb) + row0 * DM, j == 0 ? 1 : 0};
                pg8::gemm_phase<EpiBranch>(lds, g, S, E);
            }
        }
        SEAM(pb + 3);
    }

        const int pf = 1 + layer * PH_LAYER + NCH * 4;
#define LVARS int lp = layer; asm volatile("" : "+s"(lp)); const int l = lp; const size_t lw = (size_t)l * (MP.w[1][0] - MP.w[0][0]); (void)lw; \
        const int G = gridDim.x, bx = blockIdx.x; (void)G; (void)bx; int tid = threadIdx.x; asm volatile("" : "+v"(tid)); (void)tid;
        if (IN(pf + 0) && ((PHMASK >> 5) & 1)) { LVARS
            pg8::Gemm g{(const bf16*)(ws + MP.mb), (const bf16*)(ws + MP.w[0][W_OUT] + lw), NTOK, DM, DM, DM, DM}; pg8::StaticOrder S; S.init(NTOK, DM, G, bx);
#pragma unroll 1
            for (int rep = ((DUP & 1024) ? 0 : 1); rep < 2; ++rep) {
            EpiRes E{(bf16*)(ws + MP.xb), nullptr, (float*)(ws + MP.ssq2), rep == 0 ? 1 : 0};
            pg8::gemm_phase<EpiRes>(lds, g, S, E); }
        }
        SEAM(pf + 0);

        if (IN(pf + 1) && ((PHMASK >> 6) & 1)) { LVARS
            pg8::Gemm g{(const bf16*)(ws + MP.xb), (const bf16*)(ws + MP.w[0][W_FI] + lw), NTOK, N_FF2, DM, DM, DM}; pg8::StaticOrder S; S.init(NTOK, N_FF2, G, bx);
            EpiSwiGLU E{(const float*)(ws + MP.ssq2), (bf16*)(ws + MP.hid)};
#pragma unroll 1
            for (int rep = 0; rep < ((DUP & 32) ? 2 : 1); ++rep)
            pg8::gemm_phase<EpiSwiGLU>(lds, g, S, E);
        }
        SEAM(pf + 1);

        if (IN(pf + 2) && ((PHMASK >> 7) & 1)) { LVARS
            pg8::Gemm g{(const bf16*)(ws + MP.hid), (const bf16*)(ws + MP.w[0][W_FO] + lw), NTOK, DM, DFF, DFF, DFF}; pg8::StaticOrder S; S.init(NTOK, DM, G, bx);
#pragma unroll 1
            for (int rep = ((DUP & 2048) ? 0 : 1); rep < 2; ++rep) {
            EpiRes E{(bf16*)(ws + MP.xb), l == NLAYER - 1 ? args.out : nullptr, (float*)(ws + MP.ssq1), rep == 0 ? 1 : 0};
            pg8::gemm_phase<EpiRes>(lds, g, S, E); }
        }
        SEAM(pf + 2);
    }
#undef IN
#undef SEAM
#undef LCVARS
#undef LVARS
#undef GWVARS
}

extern "C" void kernel_launch(void* const* d_in, const int* in_sizes, int n_in, void* d_out, int out_size, void* d_ws, size_t ws_size, hipStream_t stream) {
    static int grid = 0;
    if (grid == 0) {
        int dev = 0, cus = 0;
        if (hipGetDevice(&dev) != hipSuccess || hipDeviceGetAttribute(&cus, hipDeviceAttributeMultiprocessorCount, dev) != hipSuccess) { fprintf(stderr, "kernel_launch: device query failed\n"); grid = -1; return; }
        if (hipFuncSetAttribute((const void*)mk_fwd, hipFuncAttributeMaxDynamicSharedMemorySize, LDS_BYTES) != hipSuccess) { fprintf(stderr, "kernel_launch: hipFuncSetAttribute failed\n"); grid = -1; return; }
        (void)hipGetLastError();
        if (n_in != 14 || out_size != NTOK * DM || MP.end + (size_t)128 * 262144 > ws_size) { fprintf(stderr, "kernel_launch: unexpected problem (n_in %d, out %d, ws %zu, need %zu)\n", n_in, out_size, ws_size, (size_t)MP.end); grid = -1; return; }
        grid = cus < 256 ? cus : 256;
    }
    if (grid < 0) return;
    (void)hipMemsetAsync((char*)d_ws, 0, MiB, stream);
    Args a{};
    for (int i = 0; i < 14; ++i) a.in[i] = (const float*)d_in[i];
    a.out = (float*)d_out; a.ws = (unsigned char*)d_ws; a.nbc = NBC; a.li = 0;
    constexpr int nph = 1 + NLAYER * (NCH * 4 + 3);
#if MK_SINGLE
    a.ph_lo = 0; a.ph_hi = nph;
    hipLaunchKernelGGL(mk_fwd, dim3(grid), dim3(NWAVES * 64), LDS_BYTES, stream, a);
#else
    for (int p = 0; p < nph; ++p) { a.ph_lo = p; a.ph_hi = p + 1; hipLaunchKernelGGL(mk_fwd, dim3(grid), dim3(NWAVES * 64), LDS_BYTES, stream, a); }
#endif
    const hipError_t le = hipPeekAtLastError();
    if (le != hipSuccess) fprintf(stderr, "kernel_launch: launch failed: %s\n", hipGetErrorName(le));
}
```

```cpp
#include <hip/hip_runtime.h>
#include <cstdio>
#include <cstdint>

#ifndef MK_SINGLE
#define MK_SINGLE 1
#endif
#ifndef DUP
#define DUP 0
#endif
#ifndef PHMASK
#define PHMASK 0xff
#define DUPA 0
#endif
#ifndef MK_MIXERS
#define MK_MIXERS 7
#endif

#define GAS __attribute__((address_space(1)))
#define LAS __attribute__((address_space(3)))
typedef unsigned short bf16;
typedef short bf16x8 __attribute__((ext_vector_type(8)));
typedef float f32x4 __attribute__((ext_vector_type(4)));
typedef float f32x2 __attribute__((ext_vector_type(2)));
typedef float f32x16 __attribute__((ext_vector_type(16)));
typedef unsigned u32x4 __attribute__((ext_vector_type(4)));
typedef unsigned u32x2 __attribute__((ext_vector_type(2)));
typedef short s16x4_t __attribute__((ext_vector_type(4)));
typedef short v4i16_t __attribute__((ext_vector_type(4)));

constexpr int BATCH = 8, SEQ = 4096, DM = 1024, NTOK = BATCH * SEQ, DFF = 2816, NLAYER = 2, IN_TOTAL = 7644;
constexpr int N_MAIN = 6656, N_VT = 1280, N_FF2 = 5632;
constexpr float NEPS = 1e-6f, LOG2E = 1.4426950408889634f, QSCALE = 0.125f * LOG2E;
constexpr int TABS = 1668;
constexpr int TABC = 192;

typedef __bf16 bf16x2_t __attribute__((ext_vector_type(2)));
__device__ __forceinline__ unsigned cvt_pk_bf16(float lo, float hi) { const f32x2 v = {lo, hi}; return __builtin_bit_cast(unsigned, __builtin_convertvector(v, bf16x2_t)); }
__device__ __forceinline__ unsigned f2bf(float f) { unsigned u = __builtin_bit_cast(unsigned, f); return (u + 0x7fffu + ((u >> 16) & 1u)) >> 16; }
__device__ __forceinline__ unsigned pk2(float lo, float hi) { return f2bf(lo) | (f2bf(hi) << 16); }
__device__ __forceinline__ float bflo(unsigned w) { return __builtin_bit_cast(float, w << 16); }
__device__ __forceinline__ float bfhi(unsigned w) { return __builtin_bit_cast(float, w & 0xffff0000u); }
__device__ __forceinline__ float fsigmoid(float v) { return __builtin_amdgcn_rcpf(1.f + __builtin_amdgcn_exp2f(-v * LOG2E)); }
__device__ __forceinline__ float shx(float v, int m) { return __shfl_xor(v, m); }
__device__ __forceinline__ float xsum16(float v) { const auto r = __builtin_amdgcn_permlane16_swap(__float_as_uint(v), __float_as_uint(v), false, false); return __uint_as_float(r[0]) + __uint_as_float(r[1]); }
__device__ __forceinline__ float xsum32(float v) { const auto r = __builtin_amdgcn_permlane32_swap(__float_as_uint(v), __float_as_uint(v), false, false); return __uint_as_float(r[0]) + __uint_as_float(r[1]); }

namespace pg8 {
constexpr int BM = 256, BK = 64, HALF = 128, HTB = HALF * BK * 2, STAGE_BYTES = 8 * HTB, NXCD = 8, WGM = 8;
__host__ __device__ __forceinline__ int lds_byte(int r, int c) { const int st = (r >> 4) * 2 + (c >> 5), rr = r & 15, cc = c & 31, ob = rr * 64 + cc * 2; return st * 1024 + (ob ^ (((ob >> 9) & 1) << 5)); }
__host__ __device__ __forceinline__ void stage_rc(int b, int& R, int& C) { const int st = b / 1024, sb = b % 1024, swz = sb ^ (((sb >> 9) & 1) << 5); R = (st >> 1) * 16 + swz / 64; C = (st & 1) * 32 + (swz % 64) / 2; }
__host__ __device__ __forceinline__ int perm32(int rho) { const int n = rho >> 4, i = rho & 15; return 8 * (i >> 2) + 4 * n + (i & 3); }

struct Unit { int pm, pn, w; };
struct Gemm { const bf16* A; const bf16* Bt; int M, N, K, lda, ldb_;
    __device__ __forceinline__ const char* aptr(const Unit& u) const { return (const char*)A + (size_t)u.pm * BM * lda * 2; }
    __device__ __forceinline__ const char* bptr(const Unit& u) const { return (const char*)Bt + (size_t)u.pn * BM * ldb_ * 2; }
    __device__ __forceinline__ int ldb(const Unit&) const { return ldb_; }
};
struct GemmP1 { const bf16* xb; const bf16* win; const bf16* wvt; static constexpr int K = 1024, lda = 1024;
    __device__ __forceinline__ const char* aptr(const Unit& u) const {
        if (u.w == 0) return (const char*)xb + (size_t)u.pm * BM * 1024 * 2;
        const int rb = u.w == 1 ? 0 : (u.w == 2 ? 768 : 1024);
        return (const char*)wvt + ((size_t)rb + (size_t)u.pm * BM) * 1024 * 2; }
    __device__ __forceinline__ const char* bptr(const Unit& u) const {
        if (u.w == 0) return (const char*)win + (size_t)u.pn * BM * 1024 * 2;
        const int dil = u.w == 1 ? 1 : (u.w == 2 ? 4 : 16);
        const int p0 = (u.pn & 15) * 256, bl = u.pn >> 4, L = SEQ / dil, r = p0 / L, n0 = p0 % L;
        return (const char*)xb + ((size_t)bl * SEQ + r + (size_t)dil * n0) * 1024 * 2; }
    __device__ __forceinline__ int ldb(const Unit& u) const { return u.w <= 1 ? 1024 : (u.w == 2 ? 4096 : 16384); }
};
struct StaticOrder {
    int nM, nN, nwg, G, c;
    __host__ __device__ void init(int M, int N, int G_, int c_) { nM = M / BM; nN = N / BM; nwg = nM * nN; G = G_; c = c_; }
    __host__ __device__ void map(int L, Unit& u) const {
        int wgid = L; { const int q = nwg / NXCD, r = nwg % NXCD, xcd = wgid % NXCD, off = wgid / NXCD; wgid = (xcd < r ? xcd * (q + 1) : r * (q + 1) + (xcd - r) * q) + off; }
        const int nig = WGM * nN, gid = wgid / nig, fm = gid * WGM, gsz = (nM - fm) < WGM ? (nM - fm) : WGM;
        u.pm = fm + ((wgid % nig) % gsz); u.pn = (wgid % nig) / gsz; u.w = 0; }
    __host__ __device__ bool next(int i, Unit& u) const { const long L = (long)i * G + c; if (L >= nwg) return false; map((int)L, u); return true; }
};
template <int T>
struct P1Order {
    static constexpr int ntn = T / BM, nwg0 = ntn * (N_MAIN / BM);
    int G, c;
    __host__ __device__ void init(int G_, int c_) { G = G_; c = c_; }
    __host__ __device__ bool next(int i, Unit& u) const {
        const int L = i * G + c;
        if (L < nwg0) { StaticOrder so; so.nM = ntn; so.nN = N_MAIN / BM; so.nwg = nwg0; so.G = G; so.c = c; so.map(L, u); return true; }
        const int q = L - nwg0;
        if (q < 3 * ntn) { u.w = 1; u.pm = q % 3; u.pn = q / 3; return true; }
        if (q < 5 * ntn) { const int q2 = q - 3 * ntn; u.w = 2 + q2 / ntn; u.pm = 0; u.pn = q2 % ntn; return true; }
        return false; }
};

template <class Epi, class GD = Gemm, class Sched = StaticOrder>
__device__ __forceinline__ void gemm_phase(LAS unsigned char* lds, const GD g, const Sched& S, const Epi& E) {
    int tid = threadIdx.x; asm volatile("" : "+v"(tid));
    const int wid = __builtin_amdgcn_readfirstlane(tid >> 6), lane = tid & 63, wr = wid >> 2, wc = wid & 3, fr = lane & 15, fq = lane >> 4;
    const int K = g.K, nt = K / BK;
    unsigned voffA[2], voffB[2];
#pragma unroll
    for (int i = 0; i < 2; ++i) { int R, C; stage_rc(tid * 16 + i * 8192, R, C); voffA[i] = (unsigned)(R * g.lda + C) * 2u; }
#define PG8_VOFFB(ldb_) do { int _t = tid; asm volatile("" : "+v"(_t)); _Pragma("unroll") for (int _i = 0; _i < 2; ++_i) { int R, C; stage_rc(_t * 16 + _i * 8192, R, C); \
        const int Rb = (R & ~31) + perm32(R & 31); voffB[_i] = (unsigned)(Rb * (ldb_) + C) * 2u; } } while (0)
    const size_t kstep = (size_t)(BK * 2);
    const size_t hsA = (size_t)HALF * g.lda * 2;
    const unsigned ldsw = (unsigned)wid * 1024u;
    const int aoff = lds_byte(wr * 64 + fr, fq * 8), boff = lds_byte(wc * 32 + fr, fq * 8);
#define PG8_SA(b, h) (((b) * 2 + (h)) * HTB)
#define PG8_SB(b, h) ((4 + (b) * 2 + (h)) * HTB)
#define PG8_STAGE(bufoff, gbase, voff) do { _Pragma("unroll") for (int _i = 0; _i < 2; ++_i) \
        __builtin_amdgcn_global_load_lds((const unsigned*)((const char*)(gbase) + (voff)[_i]), (LAS unsigned*)(lds + (bufoff) + ldsw + _i * 8192), 16, 0, 0); } while (0)
#define PG8_LDA(dst, b, h) do { _Pragma("unroll") for (int m = 0; m < 4; ++m) _Pragma("unroll") for (int k = 0; k < 2; ++k) dst[m][k] = *(const LAS bf16x8*)(lds + PG8_SA(b, h) + aoff + m * 2048 + k * 1024); } while (0)
#define PG8_LDB(dst, b, h) do { _Pragma("unroll") for (int n = 0; n < 2; ++n) _Pragma("unroll") for (int k = 0; k < 2; ++k) dst[n][k] = *(const LAS bf16x8*)(lds + PG8_SB(b, h) + boff + n * 2048 + k * 1024); } while (0)
#define PG8_MMA(ai, bj, At, Bt) do { __builtin_amdgcn_s_setprio(1); _Pragma("unroll") for (int m = 0; m < 4; ++m) _Pragma("unroll") for (int n = 0; n < 2; ++n) _Pragma("unroll") for (int k = 0; k < 2; ++k) \
        acc[ai][bj][m][n] = __builtin_amdgcn_mfma_f32_16x16x32_bf16(Bt[n][k], At[m][k], acc[ai][bj][m][n], 0, 0, 0); __builtin_amdgcn_s_setprio(0); } while (0)
#define PG8_WAIT_V(n) asm volatile("s_waitcnt vmcnt(" #n ")" ::: "memory")
#define PG8_WAIT_L(n) asm volatile("s_waitcnt lgkmcnt(" #n ")" ::: "memory")
#define PG8_BAR __builtin_amdgcn_s_barrier()
#define PG8_SCHED __builtin_amdgcn_sched_barrier(0)
    Unit cur, nxt; int ui = 0;
    if (!S.next(0, cur)) return;
    f32x4 acc[2][2][4][2];
#pragma unroll
    for (int a = 0; a < 2; ++a)
#pragma unroll
        for (int b = 0; b < 2; ++b)
#pragma unroll
            for (int m = 0; m < 4; ++m)
#pragma unroll
                for (int n = 0; n < 2; ++n) acc[a][b][m][n] = (f32x4){0.f, 0.f, 0.f, 0.f};
    bf16x8 At[4][2], B0[2][2], B1[2][2];
    const char* cA = g.aptr(cur); const char* cB = g.bptr(cur);
    int ldbc = g.ldb(cur); size_t hsB = (size_t)HALF * ldbc * 2;
    PG8_VOFFB(ldbc);
    PG8_STAGE(PG8_SB(0, 0), cB, voffB); PG8_STAGE(PG8_SB(0, 1), cB + hsB, voffB); PG8_STAGE(PG8_SA(0, 0), cA, voffA); PG8_STAGE(PG8_SA(0, 1), cA + hsA, voffA);
    if (wr == 1) PG8_BAR;
    PG8_WAIT_V(2); PG8_BAR;
    PG8_STAGE(PG8_SB(1, 0), cB + kstep, voffB); PG8_STAGE(PG8_SA(1, 0), cA + kstep, voffA); PG8_STAGE(PG8_SB(1, 1), cB + hsB + kstep, voffB);
    PG8_WAIT_V(6); PG8_BAR;
    for (;;) {
        const bool has_next = S.next(ui + 1, nxt);
        const char* nA = has_next ? g.aptr(nxt) : cA; const char* nB = has_next ? g.bptr(nxt) : cB;
        const int ldbn = has_next ? g.ldb(nxt) : ldbc;
        for (int t = 0; t < nt; t += 2) {
            const bool last = (t == nt - 2);
            if (last && ldbn != ldbc) { ldbc = ldbn; hsB = (size_t)HALF * ldbc * 2; PG8_VOFFB(ldbc); }
            const char* a1 = cA + (size_t)(t + 1) * kstep;
            const char* a2 = last ? nA : cA + (size_t)(t + 2) * kstep; const char* b2 = last ? nB : cB + (size_t)(t + 2) * kstep;
            const char* a3 = a2 + kstep; const char* b3 = b2 + kstep;
            PG8_LDB(B0, 0, 0); PG8_LDB(B1, 0, 1); PG8_SCHED; PG8_LDA(At, 0, 0); PG8_STAGE(PG8_SA(1, 1), a1 + hsA, voffA);
            PG8_WAIT_V(8); PG8_WAIT_L(0); PG8_BAR; PG8_MMA(0, 0, At, B0); PG8_MMA(0, 1, At, B1); PG8_BAR; PG8_SCHED;
            PG8_LDA(At, 0, 1); PG8_STAGE(PG8_SB(0, 0), b2, voffB); PG8_STAGE(PG8_SB(0, 1), b2 + hsB, voffB); PG8_STAGE(PG8_SA(0, 0), a2, voffA);
            PG8_WAIT_V(8); PG8_WAIT_L(0); PG8_BAR; PG8_MMA(1, 0, At, B0); PG8_MMA(1, 1, At, B1); PG8_BAR; PG8_SCHED;
            PG8_LDB(B0, 1, 0); PG8_LDB(B1, 1, 1); PG8_SCHED; PG8_LDA(At, 1, 0); PG8_STAGE(PG8_SA(0, 1), a2 + hsA, voffA);
            PG8_WAIT_V(8); PG8_WAIT_L(0); PG8_BAR; PG8_MMA(0, 0, At, B0); PG8_MMA(0, 1, At, B1); PG8_BAR; PG8_SCHED;
            PG8_LDA(At, 1, 1); PG8_STAGE(PG8_SB(1, 0), b3, voffB); PG8_STAGE(PG8_SB(1, 1), b3 + hsB, voffB); PG8_STAGE(PG8_SA(1, 0), a3, voffA);
            PG8_WAIT_V(8); PG8_WAIT_L(0); PG8_BAR; PG8_MMA(1, 0, At, B0); PG8_MMA(1, 1, At, B1); PG8_BAR; PG8_SCHED;
        }
        if (wr == 0) PG8_BAR;
        E(acc, cur, wr, wc, fr, fq);
        if (!has_next) break;
#pragma unroll
        for (int a = 0; a < 2; ++a)
#pragma unroll
            for (int b = 0; b < 2; ++b)
#pragma unroll
                for (int m = 0; m < 4; ++m)
#pragma unroll
                    for (int n = 0; n < 2; ++n) acc[a][b][m][n] = (f32x4){0.f, 0.f, 0.f, 0.f};
        cur = nxt; cA = nA; cB = nB; ++ui;
        if (wr == 1) PG8_BAR;
    }
    PG8_WAIT_V(0);
    PG8_BAR;
#undef PG8_VOFFB
#undef PG8_SA
#undef PG8_SB
#undef PG8_STAGE
#undef PG8_LDA
#undef PG8_LDB
#undef PG8_MMA
#undef PG8_WAIT_V
#undef PG8_WAIT_L
#undef PG8_BAR
#undef PG8_SCHED
}
}
typedef f32x4 AccT[2][2][4][2];

constexpr size_t MiB = 1u << 20;
struct WSMap {
    size_t ctl, biasA, biasB, biasC, cmpb, w[NLAYER][10], xb, ssq1, ssq2;
    size_t aq, ak, av, iq, ik, misc, bq, bkc, bvc, bks, bkw, cq, ck, mixg, avt, bvst, bvwt, cvt, kcmp, vcmpt, oa, ob, oc, cgo, cgl, mb, hid, end;
};
enum { W_IN = 0, W_VT, W_BA, W_BB, W_BC, W_OUT, W_FI, W_FO, W_CK, W_CV };
__host__ __device__ constexpr WSMap make_map(int nbc) {
    WSMap m{}; size_t o = 0;
    m.ctl = o; o += MiB;
    m.biasA = o; o += 64 * 1024; m.biasB = o; o += 64 * 1024; m.biasC = o; o += 16 * 1024; m.cmpb = o; o += 16 * 1024;
    o = 2 * MiB;
    const size_t wsz[10] = {(size_t)N_MAIN * 1024 * 2, (size_t)N_VT * 1024 * 2, 1024 * 512 * 2, 1024 * 512 * 2, 1024 * 256 * 2, 1024 * 1024 * 2, (size_t)N_FF2 * 1024 * 2, (size_t)1024 * DFF * 2, 256 * 2048 * 2, 256 * 2048 * 2};
    for (int l = 0; l < NLAYER; ++l) for (int i = 0; i < 10; ++i) { m.w[l][i] = o; o += wsz[i]; }
    o = (o + MiB - 1) / MiB * MiB;
    m.xb = o; o += (size_t)NTOK * DM * 2;
    m.ssq1 = o; o += (size_t)NTOK * 16 * 4; m.ssq2 = o; o += (size_t)NTOK * 16 * 4;
    m.mb = o; o += (size_t)NTOK * 1024 * 2;
    const size_t chunk0 = o;
    const size_t T = (size_t)nbc * SEQ;
    m.aq = o; o += T * 512 * 2; m.ak = o; m.av = o + 128; o += T * 128 * 2;        m.iq = o; o += T * 256 * 2; m.ik = o; o += T * 64 * 2; m.misc = o; o += T * 32 * 4;
    m.bq = o; o += T * 512 * 2; m.bkc = o; o += T * 128 * 2 + 4096; m.bvc = o; o += T * 128 * 2 + 4096; m.bks = o; o += T * 128 * 2; m.bkw = o; o += T * 128 * 2;
    m.cq = o; o += T * 768 * 2; m.ck = o; o += T * 768 * 2; m.mixg = o; o += T * 3072;
    m.avt = o; o += T * 64 * 2; m.bvst = o; o += T * 128 * 2; m.bvwt = o; o += T * 128 * 2; m.cvt = o; o += T * 768 * 2;
    m.kcmp = o; o += (size_t)nbc * 2 * 256 * 64 * 2; m.vcmpt = o; o += (size_t)nbc * 2 * 256 * 64 * 2;
    m.oa = o; o += T * 512 * 2; m.ob = o; o += T * 512 * 2; m.oc = o; o += T * 256 * 2;
    m.cgo = o; o += T * 768 * 2; m.cgl = o; o += T * 12 * 4;
    m.hid = chunk0;
    if (o < chunk0 + (size_t)NTOK * DFF * 2) o = chunk0 + (size_t)NTOK * DFF * 2;
    m.end = o;
    return m;
}

constexpr int NBC = 4, NCH = BATCH / NBC, TCH = NBC * SEQ;
constexpr WSMap MP = make_map(NBC);

#define XB_TMO      128
#define XB_XCNT(j)  (256  + 64 * (j))
#define XB_XSUB(j)  (1280 + 64 * (j))
#define XB_XGEN(j)  (2304 + 64 * (j))
#define XB_TOP      3328
#define XB_TOPGEN   3392
#define XCD_BAR_WORDS 3456
#define XB_SPIN_CAP (1u << 21)
__device__ __forceinline__ unsigned xb_ld(unsigned* p)              { return __hip_atomic_load(p, __ATOMIC_RELAXED, __HIP_MEMORY_SCOPE_AGENT); }
__device__ __forceinline__ unsigned xb_add(unsigned* p, unsigned v) { return __hip_atomic_fetch_add(p, v, __ATOMIC_RELAXED, __HIP_MEMORY_SCOPE_AGENT); }
__device__ __forceinline__ unsigned xb_xcc_id() { return (unsigned)__builtin_amdgcn_s_getreg((3 << 11) | 20) & 0xFu; }
#define XB_SPIN(cond, bar) do { unsigned _sp = 0; while (cond) { __builtin_amdgcn_s_sleep(1); \
    if ((++_sp & 255u) == 0u) { if (xb_ld(&(bar)[XB_TMO])) break; if (_sp > XB_SPIN_CAP) { atomicAdd(&(bar)[XB_TMO], 1u); break; } } } } while (0)
struct XcdBarrier { unsigned* bar; unsigned x; volatile LAS unsigned* st; };
__device__ __forceinline__ XcdBarrier xcd_barrier_post(unsigned* bar, volatile LAS unsigned* st) {
    XcdBarrier b; b.bar = bar; b.x = xb_xcc_id(); b.st = st;
    if (threadIdx.x == 0) (void)xb_add(&bar[XB_XCNT(b.x)], 1u);
    return b;
}
__device__ __forceinline__ void xcd_barrier_complete(unsigned* bar, unsigned x, unsigned& nloc, unsigned& nx) {
    const unsigned G = gridDim.x * gridDim.y * gridDim.z;
    unsigned sum, cnt, mine, sp = 0u;
    for (;;) {
        sum = 0u; cnt = 0u; mine = 0u;
#pragma unroll
        for (unsigned j = 0; j < 16; ++j) { const unsigned c = xb_ld(&bar[XB_XCNT(j)]); sum += c; cnt += (c > 0u) ? 1u : 0u; mine = (j == x) ? c : mine; }
        if (sum == G) break;
        __builtin_amdgcn_s_sleep(1);
        if ((++sp & 255u) == 0u) { if (xb_ld(&bar[XB_TMO])) break; if (sp > XB_SPIN_CAP) { atomicAdd(&bar[XB_TMO], 1u); break; } }
    }
    nloc = mine > 0u ? mine : 1u; nx = cnt > 0u ? cnt : 1u;
}
__device__ __forceinline__ void xcd_barrier(const XcdBarrier& b) {
    asm volatile("s_waitcnt vmcnt(0)" ::: "memory");
    __syncthreads();
    if (threadIdx.x == 0) {
        unsigned* bar = b.bar;
        __builtin_amdgcn_s_waitcnt(0);
        unsigned nloc = b.st[0], nx = b.st[1];
        if (nloc == 0u) { xcd_barrier_complete(bar, b.x, nloc, nx); b.st[0] = nloc; b.st[1] = nx; }
        const unsigned old = xb_add(&bar[XB_XSUB(b.x)], 1u);
        const unsigned gen = old / nloc;
        if (old + 1u == (gen + 1u) * nloc) {
            __builtin_amdgcn_fence(__ATOMIC_RELEASE, "agent");
            asm volatile("s_waitcnt vmcnt(0)" ::: "memory");
            const unsigned og = xb_add(&bar[XB_TOP], 1u);
            const unsigned tg = og / nx;
            if (og + 1u == (tg + 1u) * nx) xb_add(&bar[XB_TOPGEN], 1u);
            else XB_SPIN(xb_ld(&bar[XB_TOPGEN]) == tg, bar);
            __builtin_amdgcn_fence(__ATOMIC_ACQUIRE, "agent");
            xb_add(&bar[XB_XGEN(b.x)], 1u);
            asm volatile("s_waitcnt vmcnt(0)" ::: "memory");
        } else {
            XB_SPIN(xb_ld(&bar[XB_XGEN(b.x)]) == gen, bar);
            __builtin_amdgcn_fence(__ATOMIC_ACQUIRE, "agent");
            asm volatile("s_waitcnt vmcnt(0)" ::: "memory");
        }
    }
    __syncthreads();
}

struct Args {
    const float* in[14];
    float* out; unsigned char* ws; int ph_lo, ph_hi, nbc, li;
};

__device__ __forceinline__ float row_rstd(const float* ssq, int row, int fq) {
    const f32x4 p = *(const f32x4*)(ssq + (size_t)row * 16 + 4 * fq);
    float s = (p[0] + p[1]) + (p[2] + p[3]); s = xsum16(s); s = xsum32(s);
    return __builtin_amdgcn_rsqf(s * (1.f / DM) + NEPS);
}
__device__ __forceinline__ int rowmap_p(int t, int rm) { return rm == 0 ? t : (rm == 1 ? (((t & 3) << 10) | (t >> 2)) : (((t & 15) << 8) | (t >> 4))); }

struct EpiIn {
    const float* ssq; const float* qkg; unsigned char* ws;
    __device__ __forceinline__ void operator()(const AccT& acc, const pg8::Unit& u, int wr, int wc, int fr, int fq) const {
        constexpr int T = TCH;
        bf16 *aq = (bf16*)(ws + MP.aq), *ak = (bf16*)(ws + MP.ak), *iq = (bf16*)(ws + MP.iq), *ik = (bf16*)(ws + MP.ik), *bq = (bf16*)(ws + MP.bq), *bkc = (bf16*)(ws + MP.bkc), *bvc = (bf16*)(ws + MP.bvc),
             *bks = (bf16*)(ws + MP.bks), *bkw = (bf16*)(ws + MP.bkw), *cq = (bf16*)(ws + MP.cq), *ck = (bf16*)(ws + MP.ck), *mixg = (bf16*)(ws + MP.mixg); float* misc = (float*)(ws + MP.misc);
        const int s = 4 * u.pn + wc;
        int gain = -1, sig = 0, rm = 0, pitch = 64; float scale = 1.f; bf16* base; size_t bstr = (size_t)SEQ * 64;
        if (s < 8) { base = aq + 64 * s; pitch = 512; bstr = (size_t)SEQ * 512; gain = 0; scale = QSCALE; }
        else if (s == 8) { base = ak; gain = 1; pitch = 128; bstr = (size_t)SEQ * 128; }
        else if (s < 13) { base = iq + 64 * (s - 9); pitch = 256; bstr = (size_t)SEQ * 256; }
        else if (s == 13) { base = ik; }
        else if (s == 14) { base = nullptr; }
        else if (s < 23) { base = bq + 64 * (s - 15); pitch = 512; bstr = (size_t)SEQ * 512; gain = 2; scale = QSCALE; }
        else if (s < 25) { base = bkc + (size_t)(s - 23) * SEQ * 64; bstr = (size_t)2 * SEQ * 64; }
        else if (s < 27) { base = bvc + (size_t)(s - 25) * SEQ * 64; bstr = (size_t)2 * SEQ * 64; }
        else if (s < 29) { base = bks + (size_t)(s - 27) * SEQ * 64; bstr = (size_t)2 * SEQ * 64; gain = 3; }
        else if (s < 31) { base = bkw + (size_t)(s - 29) * SEQ * 64; bstr = (size_t)2 * SEQ * 64; gain = 3; }
        else if (s < 43) { base = cq + (size_t)(s - 31) * T * 64; gain = 4; scale = QSCALE; rm = (s - 31) >> 2; }
        else if (s < 55) { base = ck + (size_t)(s - 43) * T * 64; gain = 5; rm = (s - 43) >> 2; }
        else if (s < 103) { base = mixg; sig = 1; }
        else { base = (bf16*)(ws + MP.av); pitch = 128; bstr = (size_t)SEQ * 128; }
        f32x4 gv[2][2];
        if (gain >= 0) {
#pragma unroll
            for (int bj = 0; bj < 2; ++bj)
#pragma unroll
                for (int n = 0; n < 2; ++n) gv[bj][n] = *(const f32x4*)(qkg + gain * 64 + 32 * bj + 8 * fq + 4 * n) * scale;
        }
        float rsv[2][4];
        { f32x4 pq[2][4];
#pragma unroll
          for (int ai = 0; ai < 2; ++ai)
#pragma unroll
              for (int m = 0; m < 4; ++m) pq[ai][m] = *(const f32x4*)(ssq + (size_t)(u.pm * 256 + 128 * ai + 64 * wr + 16 * m + fr) * 16 + 4 * fq);
          __builtin_amdgcn_sched_barrier(0);
#pragma unroll
          for (int ai = 0; ai < 2; ++ai)
#pragma unroll
              for (int m = 0; m < 4; ++m) { const f32x4 p = pq[ai][m]; float sm = (p[0] + p[1]) + (p[2] + p[3]); sm = xsum16(sm); sm = xsum32(sm); rsv[ai][m] = __builtin_amdgcn_rsqf(sm * (1.f / DM) + NEPS); } }
        if (sig) rows<0>(acc, u, wr, fr, fq, rsv, s, base, pitch, bstr, rm, gv, misc, mixg);
        else if (s == 14) rows<1>(acc, u, wr, fr, fq, rsv, s, base, pitch, bstr, rm, gv, misc, mixg);
        else if (gain >= 0) rows<2>(acc, u, wr, fr, fq, rsv, s, base, pitch, bstr, rm, gv, misc, mixg);
        else rows<3>(acc, u, wr, fr, fq, rsv, s, base, pitch, bstr, rm, gv, misc, mixg);
    }
    template <int MODE>
    __device__ __forceinline__ void rows(const AccT& acc, const pg8::Unit& u, int wr, int fr, int fq, const float (&rsv)[2][4], int s, bf16* base, int pitch, size_t bstr, int rm,
                                         const f32x4 (&gv)[2][2], float* misc, bf16* mixg) const {
#pragma unroll
        for (int ai = 0; ai < 2; ++ai)
#pragma unroll
            for (int m = 0; m < 4; ++m) {
                const int tl = u.pm * 256 + 128 * ai + 64 * wr + 16 * m + fr;
                const float rs = rsv[ai][m];
                f32x4 v[2][2];
#pragma unroll
                for (int bj = 0; bj < 2; ++bj)
#pragma unroll
                    for (int n = 0; n < 2; ++n) v[bj][n] = acc[ai][bj][m][n] * rs;
                if (MODE == 1) {
#pragma unroll
                    for (int n = 0; n < 2; ++n) { f32x4 o = v[0][n];
#pragma unroll
                        for (int j = 0; j < 4; ++j) { const int col = 8 * fq + 4 * n + j; if (col >= 4) o[j] = fsigmoid(o[j]); }
                        *(f32x4*)(misc + (size_t)tl * 32 + 8 * fq + 4 * n) = o; }
                    continue;
                }
                if (MODE == 2) {
                    float ss = 0.f;
#pragma unroll
                    for (int bj = 0; bj < 2; ++bj)
#pragma unroll
                        for (int n = 0; n < 2; ++n) ss += (v[bj][n][0] * v[bj][n][0] + v[bj][n][1] * v[bj][n][1]) + (v[bj][n][2] * v[bj][n][2] + v[bj][n][3] * v[bj][n][3]);
                    ss = xsum16(ss); ss = xsum32(ss);
                    const float inv = __builtin_amdgcn_rsqf(ss * (1.f / 64.f) + NEPS);
#pragma unroll
                    for (int bj = 0; bj < 2; ++bj)
#pragma unroll
                        for (int n = 0; n < 2; ++n) v[bj][n] = v[bj][n] * inv * gv[bj][n];
                }
                if (MODE == 0) {
                    unsigned char* gp = (unsigned char*)mixg + (size_t)tl * 3072 + 64 * (s - 55) + 8 * fq;
#pragma unroll
                    for (int bj = 0; bj < 2; ++bj) { unsigned q[2];
#pragma unroll
                        for (int n = 0; n < 2; ++n) { unsigned b[4];
#pragma unroll
                            for (int j = 0; j < 4; ++j) b[j] = (unsigned)(fsigmoid(v[bj][n][j]) * 255.f + 0.5f);
                            q[n] = b[0] | (b[1] << 8) | (b[2] << 16) | (b[3] << 24); }
                        u32x2 w; w.x = q[0]; w.y = q[1]; *(u32x2*)(gp + 32 * bj) = w; }
                    continue;
                }
                const int bl = tl >> 12, t = tl & (SEQ - 1), p = rowmap_p(t, rm);
                bf16* rowp = base + (size_t)bl * bstr + (size_t)p * pitch + 8 * fq;
#pragma unroll
                for (int bj = 0; bj < 2; ++bj) { u32x4 w; w.x = cvt_pk_bf16(v[bj][0][0], v[bj][0][1]); w.y = cvt_pk_bf16(v[bj][0][2], v[bj][0][3]); w.z = cvt_pk_bf16(v[bj][1][0], v[bj][1][1]); w.w = cvt_pk_bf16(v[bj][1][2], v[bj][1][3]);
                    *(u32x4*)(rowp + 32 * bj) = w; }
            }
    }
};

struct EpiVT {
    const float* ssq; unsigned char* ws; int call, dil;
    __device__ __forceinline__ void operator()(const AccT& acc, const pg8::Unit& u, int wr, int wc, int fr, int fq) const {
        constexpr int T = TCH;
        bf16 *avt = (bf16*)(ws + MP.avt), *bvst = (bf16*)(ws + MP.bvst), *bvwt = (bf16*)(ws + MP.bvwt), *cvt = (bf16*)(ws + MP.cvt);
        float rs;
        {
            const int bj = fr >> 3, n = (fr >> 2) & 1, j = fr & 3;
            const int pc = u.pn * 256 + 128 * bj + 32 * wc + 8 * fq + 4 * n + j;
            const int bl = pc >> 12, p = pc & (SEQ - 1), L = SEQ / dil, t = dil * (p & (L - 1)) + p / L;
            const float* q = ssq + ((size_t)bl * SEQ + t) * 16;
            const f32x4 a = *(const f32x4*)q, b = *(const f32x4*)(q + 4), c = *(const f32x4*)(q + 8), d = *(const f32x4*)(q + 12);
            const float s = ((a[0] + a[1]) + (a[2] + a[3])) + ((b[0] + b[1]) + (b[2] + b[3])) + ((c[0] + c[1]) + (c[2] + c[3])) + ((d[0] + d[1]) + (d[2] + d[3]));
            rs = __builtin_amdgcn_rsqf(s * (1.f / DM) + NEPS);
        }
        const int lane = fq * 16 + fr;
#pragma unroll
        for (int bj = 0; bj < 2; ++bj) {
            const int pc0 = u.pn * 256 + 128 * bj + 32 * wc;
            const int bl = pc0 >> 12, pp = pc0 & (SEQ - 1);
            float r4[2][4];
#pragma unroll
            for (int n = 0; n < 2; ++n)
#pragma unroll
                for (int j = 0; j < 4; ++j) r4[n][j] = __shfl(rs, (lane & 48) | (bj * 8 + n * 4 + j));
#pragma unroll
            for (int ai = 0; ai < 2; ++ai) {
                const int hb = (u.pm * 256 + 128 * ai + 64 * wr) >> 6;
                bf16* base; bool perkv = false;
                if (call == 0) {
                    if (hb == 0) base = avt;
                    else if (hb < 3) { base = bvst + (size_t)(hb - 1) * SEQ * 64; perkv = true; }
                    else if (hb < 5) { base = bvwt + (size_t)(hb - 3) * SEQ * 64; perkv = true; }
                    else if (hb < 9) base = cvt + (size_t)(hb - 5) * T * 64;
                    else continue;
                } else base = cvt + (size_t)(4 * call + hb) * T * 64;
                const size_t off = perkv ? ((size_t)bl * 2 * SEQ * 64 + (size_t)(pp >> 6) * 4096) : ((size_t)(pc0 >> 6) * 4096);
                bf16* tp = base + off + (pp & 32) + 16 * (fq >> 1) + 8 * (fq & 1) + fr * 64;
#pragma unroll
                for (int m = 0; m < 4; ++m) { const f32x4 a0 = acc[ai][bj][m][0], a1 = acc[ai][bj][m][1];
                    const unsigned w0x = cvt_pk_bf16(a0[0] * r4[0][0], a0[1] * r4[0][1]), w0y = cvt_pk_bf16(a0[2] * r4[0][2], a0[3] * r4[0][3]);
                    const unsigned w1x = cvt_pk_bf16(a1[0] * r4[1][0], a1[1] * r4[1][1]), w1y = cvt_pk_bf16(a1[2] * r4[1][2], a1[3] * r4[1][3]);
                    const auto rx = __builtin_amdgcn_permlane16_swap(w0x, w1x, false, false), ry = __builtin_amdgcn_permlane16_swap(w0y, w1y, false, false);
                    u32x4 w; w.x = rx[0]; w.y = ry[0]; w.z = rx[1]; w.w = ry[1];
                    *(u32x4*)(tp + m * 16 * 64) = w; }
            }
        }
    }
};
struct EpiP1 {
    const float* ssq; const float* qkg; unsigned char* ws;
    __device__ __forceinline__ void operator()(const AccT& acc, const pg8::Unit& u, int wr, int wc, int fr, int fq) const {
        if (u.w == 0) { const EpiIn E{ssq, qkg, ws}; E(acc, u, wr, wc, fr, fq); }
        else { const EpiVT E{ssq, ws, u.w - 1, u.w == 1 ? 1 : (u.w == 2 ? 4 : 16)}; E(acc, u, wr, wc, fr, fq); }
    }
};
struct EpiCmpK {
    const float* cb; const float* gain; bf16* kcmp;
    __device__ __forceinline__ void operator()(const AccT& acc, const pg8::Unit& u, int wr, int wc, int fr, int fq) const {
        if (wc != 0) return;
        f32x4 cbv[2][2], gv[2][2];
#pragma unroll
        for (int bj = 0; bj < 2; ++bj)
#pragma unroll
            for (int n = 0; n < 2; ++n) { cbv[bj][n] = *(const f32x4*)(cb + 32 * bj + 8 * fq + 4 * n); gv[bj][n] = *(const f32x4*)(gain + 32 * bj + 8 * fq + 4 * n); }
#pragma unroll
        for (int ai = 0; ai < 2; ++ai)
#pragma unroll
            for (int m = 0; m < 4; ++m) {
                const int row = u.pm * 256 + 128 * ai + 64 * wr + 16 * m + fr;
                f32x4 v[2][2]; float ss = 0.f;
#pragma unroll
                for (int bj = 0; bj < 2; ++bj)
#pragma unroll
                    for (int n = 0; n < 2; ++n) { v[bj][n] = acc[ai][bj][m][n] + cbv[bj][n]; ss += (v[bj][n][0] * v[bj][n][0] + v[bj][n][1] * v[bj][n][1]) + (v[bj][n][2] * v[bj][n][2] + v[bj][n][3] * v[bj][n][3]); }
                ss = xsum16(ss); ss = xsum32(ss);
                const float inv = __builtin_amdgcn_rsqf(ss * (1.f / 64.f) + NEPS);
#pragma unroll
                for (int bj = 0; bj < 2; ++bj) { const f32x4 a = v[bj][0] * inv * gv[bj][0], b = v[bj][1] * inv * gv[bj][1];
                    u32x4 w; w.x = cvt_pk_bf16(a[0], a[1]); w.y = cvt_pk_bf16(a[2], a[3]); w.z = cvt_pk_bf16(b[0], b[1]); w.w = cvt_pk_bf16(b[2], b[3]);
                    *(u32x4*)(kcmp + (size_t)row * 64 + 32 * bj + 8 * fq) = w; }
            }
    }
};
struct EpiCmpV {
    const float* cb; bf16* vcmpt;
    __device__ __forceinline__ void operator()(const AccT& acc, const pg8::Unit& u, int wr, int wc, int fr, int fq) const {
        if (wr != 0) return;
#pragma unroll
        for (int m = 0; m < 4; ++m) {
            const int e = 16 * m + fr; const float c = cb[e];
#pragma unroll
            for (int bj = 0; bj < 2; ++bj) {
                bf16* tp = vcmpt + (size_t)u.pn * 64 * 256 + e * 256 + 128 * bj + 32 * wc + 16 * (fq >> 1) + 4 * (fq & 1);
#pragma unroll
                for (int n = 0; n < 2; ++n) { const f32x4 a = acc[0][bj][m][n];
                    u32x2 w; w.x = cvt_pk_bf16(a[0] + c, a[1] + c); w.y = cvt_pk_bf16(a[2] + c, a[3] + c);
                    *(u32x2*)(tp + 8 * n) = w; }
            }
        }
    }
};
struct EpiBranch {
    const unsigned char* gate; bf16* mb; int first;
    __device__ __forceinline__ void operator()(const AccT& acc, const pg8::Unit& u, int wr, int wc, int fr, int fq) const {
#pragma unroll
        for (int ai = 0; ai < 2; ++ai) {
            u32x2 gr[4][2]; u32x4 orr[4][2];
#pragma unroll
            for (int m = 0; m < 4; ++m)
#pragma unroll
                for (int bj = 0; bj < 2; ++bj) {
                    const int row = u.pm * 256 + 128 * ai + 64 * wr + 16 * m + fr, col = u.pn * 256 + 128 * bj + 32 * wc + 8 * fq;
                    gr[m][bj] = *(const u32x2*)(gate + (size_t)row * 3072 + col);
                    if (!first) orr[m][bj] = *(const u32x4*)(mb + (size_t)row * 1024 + col);
                }
            __builtin_amdgcn_sched_barrier(0);
#pragma unroll
            for (int m = 0; m < 4; ++m) {
                const int row = u.pm * 256 + 128 * ai + 64 * wr + 16 * m + fr;
#pragma unroll
                for (int bj = 0; bj < 2; ++bj) {
                    const int col = u.pn * 256 + 128 * bj + 32 * wc + 8 * fq;
                    const u32x2 g = gr[m][bj];
                    bf16* mp = mb + (size_t)row * 1024 + col;
                    constexpr float k = 1.f / 255.f;
                    f32x4 a = acc[ai][bj][m][0], b = acc[ai][bj][m][1];
                    a[0] *= (float)(g.x & 0xff) * k; a[1] *= (float)((g.x >> 8) & 0xff) * k; a[2] *= (float)((g.x >> 16) & 0xff) * k; a[3] *= (float)(g.x >> 24) * k;
                    b[0] *= (float)(g.y & 0xff) * k; b[1] *= (float)((g.y >> 8) & 0xff) * k; b[2] *= (float)((g.y >> 16) & 0xff) * k; b[3] *= (float)(g.y >> 24) * k;
                    if (!first) { const u32x4 o = orr[m][bj];
                        a[0] += bflo(o.x); a[1] += bfhi(o.x); a[2] += bflo(o.y); a[3] += bfhi(o.y);
                        b[0] += bflo(o.z); b[1] += bfhi(o.z); b[2] += bflo(o.w); b[3] += bfhi(o.w); }
                    u32x4 w; w.x = cvt_pk_bf16(a[0], a[1]); w.y = cvt_pk_bf16(a[2], a[3]); w.z = cvt_pk_bf16(b[0], b[1]); w.w = cvt_pk_bf16(b[2], b[3]);
                    *(u32x4*)mp = w;
                }
            }
        }
    }
};
struct EpiRes {
    bf16* xb; float* xout; float* ssq; int dry;
    __device__ __forceinline__ void operator()(const AccT& acc, const pg8::Unit& u, int wr, int wc, int fr, int fq) const {
#pragma unroll
        for (int ai = 0; ai < 2; ++ai) {
            u32x4 xr[4][2];
#pragma unroll
            for (int m = 0; m < 4; ++m)
#pragma unroll
                for (int bj = 0; bj < 2; ++bj) xr[m][bj] = *(const u32x4*)(xb + (size_t)(u.pm * 256 + 128 * ai + 64 * wr + 16 * m + fr) * DM + u.pn * 256 + 128 * bj + 32 * wc + 8 * fq);
            __builtin_amdgcn_sched_barrier(0);
#pragma unroll
            for (int m = 0; m < 4; ++m) {
                const int row = u.pm * 256 + 128 * ai + 64 * wr + 16 * m + fr; float ss = 0.f;
#pragma unroll
                for (int bj = 0; bj < 2; ++bj) {
                    const size_t o = (size_t)row * DM + u.pn * 256 + 128 * bj + 32 * wc + 8 * fq;
                    const u32x4 xo = xr[m][bj];
                    f32x4 a = acc[ai][bj][m][0], b = acc[ai][bj][m][1];
                    a[0] += bflo(xo.x); a[1] += bfhi(xo.x); a[2] += bflo(xo.y); a[3] += bfhi(xo.y);
                    b[0] += bflo(xo.z); b[1] += bfhi(xo.z); b[2] += bflo(xo.w); b[3] += bfhi(xo.w);
                    ss += (a[0] * a[0] + a[1] * a[1]) + (a[2] * a[2] + a[3] * a[3]) + (b[0] * b[0] + b[1] * b[1]) + (b[2] * b[2] + b[3] * b[3]);
                    if (!dry) {
                        if (xout) { *(f32x4*)(xout + o) = a; *(f32x4*)(xout + o + 4) = b; }
                        else { u32x4 w; w.x = cvt_pk_bf16(a[0], a[1]); w.y = cvt_pk_bf16(a[2], a[3]); w.z = cvt_pk_bf16(b[0], b[1]); w.w = cvt_pk_bf16(b[2], b[3]); *(u32x4*)(xb + o) = w; }
                    }
                }
                ss = xsum16(ss); ss = xsum32(ss);
                if (fq == 0 && !dry) ssq[(size_t)row * 16 + 4 * u.pn + wc] = ss;
            }
        }
    }
};
struct EpiSwiGLU {
    const float* ssq; bf16* hid;
    __device__ __forceinline__ void operator()(const AccT& acc, const pg8::Unit& u, int wr, int wc, int fr, int fq) const {
        float rsv[2][4];
        { f32x4 pq[2][4];
#pragma unroll
          for (int ai = 0; ai < 2; ++ai)
#pragma unroll
              for (int m = 0; m < 4; ++m) pq[ai][m] = *(const f32x4*)(ssq + (size_t)(u.pm * 256 + 128 * ai + 64 * wr + 16 * m + fr) * 16 + 4 * fq);
          __builtin_amdgcn_sched_barrier(0);
#pragma unroll
          for (int ai = 0; ai < 2; ++ai)
#pragma unroll
              for (int m = 0; m < 4; ++m) { const f32x4 p = pq[ai][m]; float sm = (p[0] + p[1]) + (p[2] + p[3]); sm = xsum16(sm); sm = xsum32(sm); rsv[ai][m] = __builtin_amdgcn_rsqf(sm * (1.f / DM) + NEPS); } }
#pragma unroll
        for (int ai = 0; ai < 2; ++ai)
#pragma unroll
            for (int m = 0; m < 4; ++m) {
                const int row = u.pm * 256 + 128 * ai + 64 * wr + 16 * m + fr;
                const float rs = rsv[ai][m];
                float h[8];
#pragma unroll
                for (int n = 0; n < 2; ++n)
#pragma unroll
                    for (int j = 0; j < 4; ++j) { const float g = acc[ai][0][m][n][j] * rs, up = acc[ai][1][m][n][j] * rs; h[4 * n + j] = g * fsigmoid(g) * up; }
                u32x4 w; w.x = cvt_pk_bf16(h[0], h[1]); w.y = cvt_pk_bf16(h[2], h[3]); w.z = cvt_pk_bf16(h[4], h[5]); w.w = cvt_pk_bf16(h[6], h[7]);
                *(u32x4*)(hid + (size_t)row * DFF + u.pn * 128 + 32 * wc + 8 * fq) = w;
            }
    }
};

__device__ __forceinline__ int main_src(int row) {
    const int s = 4 * (row >> 8) + ((row & 127) >> 5), col = 32 * ((row & 255) >> 7) + (row & 31);
    if (s < 8) return 64 * s + col;
    if (s == 8) return 512 + col;
    if (s < 13) return 640 + 64 * (s - 9) + col;
    if (s == 13) return 896 + col;
    if (s == 14) return col < 4 ? 960 + col : (col < 28 ? 2244 + col - 4 : -1);
    if (s < 23) return 964 + 64 * (s - 15) + col;
    if (s < 25) return 1476 + 64 * (s - 23) + col;
    if (s < 27) return 1476 + 128 + 64 * (s - 25) + col;
    if (s < 29) return 1476 + 256 + 64 * (s - 27) + col;
    if (s < 31) return 1476 + 512 + 64 * (s - 29) + col;
    if (s < 43) return 2268 + 64 * (s - 31) + col;
    if (s < 55) return 3036 + 64 * (s - 43) + col;
    if (s < 103) return 4572 + 64 * (s - 55) + col;
    return 576 + col;
}
__device__ __forceinline__ int vt_src(int r) {
    if (r < 64) return 576 + r;
    if (r < 192) return 1860 + (r - 64);
    if (r < 320) return 2116 + (r - 192);
    if (r < 576) return 3804 + (r - 320);
    if (r < 768) return -1;
    return 3804 + 256 + (r - 768);
}
__device__ __forceinline__ int ffn_src(int row) { return ((row & 128) ? DFF : 0) + 128 * (row >> 8) + (row & 127 & ~31) + (row & 31); }
__device__ __forceinline__ void ti_load(const float* W, int Nsrc, int k0, int sc4, const float* gk, int lane, f32x4 (&v)[8]) {
    const int kq = lane >> 3;
#pragma unroll
    for (int i = 0; i < 8; ++i) { const int kk = kq + 8 * i; v[i] = (f32x4){0.f, 0.f, 0.f, 0.f};
        if (sc4 >= 0) { v[i] = *(const f32x4*)(W + (size_t)(k0 + kk) * Nsrc + sc4); if (gk) v[i] = v[i] * gk[k0 + kk]; } }
}
__device__ __forceinline__ void ti_finish(const f32x4 (&v)[8], int K, bf16* WT, LAS float* scr, int k0, int n0, int lane) {
    const int kq = lane >> 3, n4 = lane & 7;
#pragma unroll
    for (int i = 0; i < 8; ++i) { const int kk = kq + 8 * i;
#pragma unroll
        for (int j = 0; j < 4; ++j) scr[kk * 33 + 4 * n4 + j] = v[i][j]; }
    asm volatile("s_waitcnt lgkmcnt(0)" ::: "memory");
    const int c = lane & 7;
#pragma unroll
    for (int j = 0; j < 4; ++j) { const int n = (lane >> 3) + 8 * j; const LAS float* s = scr + (8 * c) * 33 + n;
        u32x4 o; o.x = pk2(s[0 * 33], s[1 * 33]); o.y = pk2(s[2 * 33], s[3 * 33]); o.z = pk2(s[4 * 33], s[5 * 33]); o.w = pk2(s[6 * 33], s[7 * 33]);
        *(u32x4*)(WT + (size_t)(n0 + n) * K + k0 + 8 * c) = o; }
    asm volatile("s_waitcnt lgkmcnt(0)" ::: "memory");
}
__device__ __forceinline__ int rel_bucket(int n) {
    if (n < 16) return n < 0 ? 0 : n;
    const int lg = 16 + (int)(logf((float)n / 16.0f) / 4.852030263919617f * 16.0f);
    return lg < 31 ? lg : 31;
}
__device__ __forceinline__ float wave_sum(float v) {
#pragma unroll
    for (int o = 1; o < 64; o <<= 1) v += __shfl_xor(v, o);
    return v;
}

__device__ __forceinline__ f32x16 mfma32(bf16x8 a, bf16x8 b, f32x16 c) { return __builtin_amdgcn_mfma_f32_32x32x16_bf16(a, b, c, 0, 0, 0); }
__device__ __forceinline__ f32x4 mfma16(bf16x8 a, bf16x8 b, f32x4 c) { return __builtin_amdgcn_mfma_f32_16x16x32_bf16(a, b, c, 0, 0, 0); }
__device__ __forceinline__ f32x16 zero16() { f32x16 z;
#pragma unroll
    for (int i = 0; i < 16; ++i) z[i] = 0.f; return z; }
#define ROWC(reg) (((reg) & 3) + 8 * ((reg) >> 2))
__device__ __forceinline__ f32x16 qk32(const bf16* krow, const bf16x8 (&qf)[4]) {
    f32x16 st = zero16();
#pragma unroll
    for (int ks = 0; ks < 4; ++ks) { const bf16x8 kf = *(const bf16x8*)(krow + 16 * ks); st = mfma32(kf, qf[ks], st); }
    return st;
}
template <int BIAS, bool MASK>
__device__ __forceinline__ void soft32(const f32x16& st, const LAS float* bt, float bc, unsigned keep, float& l, bf16x8 (&pb)[2]) {
    float e[16];
#pragma unroll
    for (int r = 0; r < 16; ++r) {
        float x = st[r];
        if (BIAS == 1) x += bt[27 - ROWC(r)];
        if (BIAS == 2) x += bc;
        float ev = __builtin_amdgcn_exp2f(x);
        if (MASK) { const int sel = ((int)(keep << (31 - ROWC(r)))) >> 31; ev = __builtin_bit_cast(float, __builtin_bit_cast(int, ev) & sel); }
        l += ev; e[r] = ev;
    }
#pragma unroll
    for (int s = 0; s < 2; ++s) { u32x4 w; w.x = cvt_pk_bf16(e[8 * s + 0], e[8 * s + 1]); w.y = cvt_pk_bf16(e[8 * s + 2], e[8 * s + 3]); w.z = cvt_pk_bf16(e[8 * s + 4], e[8 * s + 5]); w.w = cvt_pk_bf16(e[8 * s + 6], e[8 * s + 7]);
        pb[s] = __builtin_bit_cast(bf16x8, w); }
}
__device__ __forceinline__ void pv32(f32x16 (&ot)[2], const bf16* vb, int pitch, const bf16x8 (&pb)[2]) {
#pragma unroll
    for (int db = 0; db < 2; ++db)
#pragma unroll
        for (int s = 0; s < 2; ++s) { const bf16x8 vf = *(const bf16x8*)(vb + (size_t)db * 32 * pitch + 16 * s); ot[db] = mfma32(vf, pb[s], ot[db]); }
}
__device__ __forceinline__ unsigned keep_le(int lim) { return lim < 0 ? 0u : (lim >= 31 ? 0xffffffffu : ((2u << lim) - 1u)); }
__device__ __forceinline__ unsigned keep_ge(int lo) { return lo <= 0 ? 0xffffffffu : (lo > 31 ? 0u : ~((1u << lo) - 1u)); }

template <int BIAS, int MASK>
__device__ __forceinline__ f32x16 acc_init(const LAS float* bt, float bc, unsigned keep) {
    f32x16 st;
#pragma unroll
    for (int r = 0; r < 16; ++r) {
        float b = BIAS == 1 ? bt[27 - ROWC(r)] : (BIAS == 2 ? bc : 0.f);
        if (MASK) { const int sel = MASK == 2 ? (int)keep : __builtin_amdgcn_sbfe((int)keep, ROWC(r), 1); b = __int_as_float(__builtin_amdgcn_bitop3_b32(__float_as_int(b), (int)0xc6ea6000, sel, 0xe4)); }
        st[r] = b;
    }
    return st;
}
__device__ __forceinline__ void exp_pack(const f32x16& st, bf16x8 (&pb)[2]) {
    float e[16];
#pragma unroll
    for (int r = 0; r < 16; ++r) e[r] = __builtin_amdgcn_exp2f(st[r]);
#pragma unroll
    for (int s = 0; s < 2; ++s) { u32x4 w; w.x = cvt_pk_bf16(e[8 * s + 0], e[8 * s + 1]); w.y = cvt_pk_bf16(e[8 * s + 2], e[8 * s + 3]); w.z = cvt_pk_bf16(e[8 * s + 4], e[8 * s + 5]); w.w = cvt_pk_bf16(e[8 * s + 6], e[8 * s + 7]);
        pb[s] = __builtin_bit_cast(bf16x8, w); }
}
template <int BIAS, int MASK>
__device__ __forceinline__ void qks32_l(const LAS bf16* krow, const bf16x8 (&qf)[4], const LAS float* bt, float bc, unsigned keep, bf16x8 (&pb)[2]) {
    f32x16 st = acc_init<BIAS, MASK>(bt, bc, keep);
#pragma unroll
    for (int ks = 0; ks < 4; ++ks) { const bf16x8 kf = *(const LAS bf16x8*)(krow + 16 * ks); st = mfma32(kf, qf[ks], st); }
    exp_pack(st, pb);
}
__device__ __forceinline__ void exp_pack_sum(const f32x16& st, bf16x8 (&pb)[2], float& l) {
    float e[16];
#pragma unroll
    for (int r = 0; r < 16; ++r) { e[r] = __builtin_amdgcn_exp2f(st[r]); l += e[r]; }
#pragma unroll
    for (int s = 0; s < 2; ++s) { u32x4 w; w.x = cvt_pk_bf16(e[8 * s + 0], e[8 * s + 1]); w.y = cvt_pk_bf16(e[8 * s + 2], e[8 * s + 3]); w.z = cvt_pk_bf16(e[8 * s + 4], e[8 * s + 5]); w.w = cvt_pk_bf16(e[8 * s + 6], e[8 * s + 7]);
        pb[s] = __builtin_bit_cast(bf16x8, w); }
}
template <int BIAS, int MASK>
__device__ __forceinline__ void qks32_ls(const LAS bf16* krow, const bf16x8 (&qf)[4], const LAS float* bt, float bc, unsigned keep, bf16x8 (&pb)[2], float& l) {
    f32x16 st = acc_init<BIAS, MASK>(bt, bc, keep);
#pragma unroll
    for (int ks = 0; ks < 4; ++ks) { const bf16x8 kf = *(const LAS bf16x8*)(krow + 16 * ks); st = mfma32(kf, qf[ks], st); }
    exp_pack_sum(st, pb, l);
}
template <int BIAS, int MASK>
__device__ __forceinline__ void qks32_g(const bf16* krow, const bf16x8 (&qf)[4], const LAS float* bt, float bc, unsigned keep, bf16x8 (&pb)[2]) {
    f32x16 st = acc_init<BIAS, MASK>(bt, bc, keep);
#pragma unroll
    for (int ks = 0; ks < 4; ++ks) { const bf16x8 kf = *(const bf16x8*)(krow + 16 * ks); st = mfma32(kf, qf[ks], st); }
    exp_pack(st, pb);
}
__device__ __forceinline__ bf16x8 ones_frag() { const u32x4 w = {0x3f803f80u, 0x3f803f80u, 0x3f803f80u, 0x3f803f80u}; return __builtin_bit_cast(bf16x8, w); }
struct Ctx {
    unsigned char* ws; static constexpr int T = TCH;
    __device__ __forceinline__ bf16* aq() const { return (bf16*)(ws + MP.aq); }
    __device__ __forceinline__ bf16* ak() const { return (bf16*)(ws + MP.ak); }
    __device__ __forceinline__ bf16* av() const { return (bf16*)(ws + MP.av); }
    __device__ __forceinline__ bf16* iq() const { return (bf16*)(ws + MP.iq); }
    __device__ __forceinline__ bf16* ik() const { return (bf16*)(ws + MP.ik); }
    __device__ __forceinline__ bf16* bq() const { return (bf16*)(ws + MP.bq); }
    __device__ __forceinline__ bf16* bks() const { return (bf16*)(ws + MP.bks); }
    __device__ __forceinline__ bf16* bkw() const { return (bf16*)(ws + MP.bkw); }
    __device__ __forceinline__ bf16* cq() const { return (bf16*)(ws + MP.cq); }
    __device__ __forceinline__ bf16* ck() const { return (bf16*)(ws + MP.ck); }
    __device__ __forceinline__ bf16* avt() const { return (bf16*)(ws + MP.avt); }
    __device__ __forceinline__ bf16* bvst() const { return (bf16*)(ws + MP.bvst); }
    __device__ __forceinline__ bf16* bvwt() const { return (bf16*)(ws + MP.bvwt); }
    __device__ __forceinline__ bf16* cvt() const { return (bf16*)(ws + MP.cvt); }
    __device__ __forceinline__ bf16* kcmp() const { return (bf16*)(ws + MP.kcmp); }
    __device__ __forceinline__ bf16* vcmpt() const { return (bf16*)(ws + MP.vcmpt); }
    __device__ __forceinline__ bf16* oa() const { return (bf16*)(ws + MP.oa); }
    __device__ __forceinline__ bf16* ob() const { return (bf16*)(ws + MP.ob); }
    __device__ __forceinline__ bf16* oc() const { return (bf16*)(ws + MP.oc); }
    __device__ __forceinline__ bf16* cgo() const { return (bf16*)(ws + MP.cgo); }
    __device__ __forceinline__ float* misc() const { return (float*)(ws + MP.misc); }
    __device__ __forceinline__ float* cgl() const { return (float*)(ws + MP.cgl); }
};

__device__ __forceinline__ void mixC_combine(const Ctx& X, int gw, int ngw, int lane) {
    const int nitem = X.T * 32;
#pragma unroll 1
    for (int idx0 = gw * 64 + lane; idx0 < nitem; idx0 += 4 * ngw * 64) {
        u32x4 a[4], b[4], c[4]; float l0[4], l1[4], l2[4];
#pragma unroll
        for (int k = 0; k < 4; ++k) {
            int idx = idx0 + k * ngw * 64; if (idx >= nitem) idx = nitem - 1;
            const int tl = idx >> 5, i = (idx >> 3) & 3, oct = idx & 7;
            const int bl = tl >> 12, t = tl & (SEQ - 1);
            const size_t r0 = (size_t)bl * SEQ + t, r1 = (size_t)bl * SEQ + rowmap_p(t, 1), r2 = (size_t)bl * SEQ + rowmap_p(t, 2);
            const size_t h0 = (size_t)i * X.T + r0, h1 = (size_t)(4 + i) * X.T + r1, h2 = (size_t)(8 + i) * X.T + r2;
            a[k] = *(const u32x4*)(X.cgo() + h0 * 64 + 8 * oct); b[k] = *(const u32x4*)(X.cgo() + h1 * 64 + 8 * oct); c[k] = *(const u32x4*)(X.cgo() + h2 * 64 + 8 * oct);
            l0[k] = X.cgl()[h0]; l1[k] = X.cgl()[h1]; l2[k] = X.cgl()[h2];
        }
#pragma unroll
        for (int k = 0; k < 4; ++k) {
            const int idx = idx0 + k * ngw * 64;
            if (idx < nitem) {
                const int tl = idx >> 5, i = (idx >> 3) & 3, oct = idx & 7;
                const float inv = 1.f / (l0[k] + l1[k] + l2[k]);
                u32x4 w;
                w.x = cvt_pk_bf16((bflo(a[k].x) + bflo(b[k].x) + bflo(c[k].x)) * inv, (bfhi(a[k].x) + bfhi(b[k].x) + bfhi(c[k].x)) * inv);
                w.y = cvt_pk_bf16((bflo(a[k].y) + bflo(b[k].y) + bflo(c[k].y)) * inv, (bfhi(a[k].y) + bfhi(b[k].y) + bfhi(c[k].y)) * inv);
                w.z = cvt_pk_bf16((bflo(a[k].z) + bflo(b[k].z) + bflo(c[k].z)) * inv, (bfhi(a[k].z) + bfhi(b[k].z) + bfhi(c[k].z)) * inv);
                w.w = cvt_pk_bf16((bflo(a[k].w) + bflo(b[k].w) + bflo(c[k].w)) * inv, (bfhi(a[k].w) + bfhi(b[k].w) + bfhi(c[k].w)) * inv);
                *(u32x4*)(X.oc() + (size_t)tl * 256 + 64 * i + 8 * oct) = w;
            }
        }
    }
}

__device__ __forceinline__ void idx_keys(const bf16* ikrow  , const bf16x8 (&iqf)[2], const float (&w)[4], int (&key)[4]) {
#pragma unroll
    for (int blk = 0; blk < 4; ++blk) {
        const bf16x8 b0 = *(const bf16x8*)(ikrow + blk * 16 * 64), b1 = *(const bf16x8*)(ikrow + blk * 16 * 64 + 32);
        f32x4 a = {0.f, 0.f, 0.f, 0.f};
        a = mfma16(iqf[0], b0, a); a = mfma16(iqf[1], b1, a);
        const float r0 = fmaxf(a[0], 0.f), r1 = fmaxf(a[1], 0.f), r2 = fmaxf(a[2], 0.f), r3 = fmaxf(a[3], 0.f);
        float sc = __builtin_fmaf(w[3], r3, __builtin_fmaf(w[2], r2, __builtin_fmaf(w[1], r1, w[0] * r0)));
        sc = fminf(fmaxf(sc, -524288.f), 524287.f);
        key[blk] = (int)sc;
    }
}
constexpr int TSTR = 72, TILE_LDS = 64 * TSTR * 2;
constexpr int TSTRI = 80, TILE_LDSI = 64 * TSTRI * 2;
__device__ __forceinline__ u32x4 tile_ld(const bf16* tile, int pitch, int tid) { return *(const u32x4*)(tile + (size_t)(tid >> 3) * pitch + (tid & 7) * 8); }
__device__ __forceinline__ void tile_st(LAS bf16* buf, int tid, u32x4 v) { *(LAS u32x4*)(buf + (tid >> 3) * TSTR + (tid & 7) * 8) = v; }
__device__ __forceinline__ void tile_sti(LAS bf16* buf, int tid, u32x4 v) { *(LAS u32x4*)(buf + (tid >> 3) * TSTRI + (tid & 7) * 8) = v; }
__device__ __forceinline__ f32x16 qk32_l(const LAS bf16* krow, const bf16x8 (&qf)[4]) {
    f32x16 st = zero16();
#pragma unroll
    for (int ks = 0; ks < 4; ++ks) { const bf16x8 kf = *(const LAS bf16x8*)(krow + 16 * ks); st = mfma32(kf, qf[ks], st); }
    return st;
}
__device__ __forceinline__ void pv32_l(f32x16 (&ot)[2], const LAS bf16* vb, const bf16x8 (&pb)[2]) {
#pragma unroll
    for (int db = 0; db < 2; ++db)
#pragma unroll
        for (int s = 0; s < 2; ++s) { const bf16x8 vf = *(const LAS bf16x8*)(vb + db * 32 * TSTR + 16 * s); ot[db] = mfma32(vf, pb[s], ot[db]); }
}
template <int BIAS, int MASK>
__device__ __forceinline__ void blk32_l(const LAS bf16* krow, const LAS bf16* vb, const bf16x8 (&qf)[4], const LAS float* bt, float bc, unsigned keep, f32x16 (&ot)[2], float& l) {
    bf16x8 kf[4], vf[2][2];
#pragma unroll
    for (int ks = 0; ks < 4; ++ks) kf[ks] = *(const LAS bf16x8*)(krow + 16 * ks);
    f32x16 st = acc_init<BIAS, MASK>(bt, bc, keep);
    __builtin_amdgcn_sched_barrier(0);
#pragma unroll
    for (int ks = 0; ks < 4; ++ks) st = mfma32(kf[ks], qf[ks], st);
#pragma unroll
    for (int db = 0; db < 2; ++db)
#pragma unroll
        for (int s = 0; s < 2; ++s) vf[db][s] = *(const LAS bf16x8*)(vb + db * 32 * TSTR + 16 * s);
    __builtin_amdgcn_sched_barrier(0);
    bf16x8 pb[2];
    exp_pack_sum(st, pb, l);
#pragma unroll
    for (int db = 0; db < 2; ++db)
#pragma unroll
        for (int s = 0; s < 2; ++s) ot[db] = mfma32(vf[db][s], pb[s], ot[db]);
}
template <int BIAS, int MASK>
__device__ __forceinline__ void tile64_l(const LAS bf16* krow, const LAS bf16* vrow, const bf16x8 (&qf)[4], const LAS float* bt, float bc, unsigned keep0, unsigned keep1, f32x16 (&ot)[2], float& l) {
    f32x16 st0 = acc_init<BIAS, MASK>(bt, bc, keep0);
#pragma unroll
    for (int ks = 0; ks < 4; ++ks) { const bf16x8 kf = *(const LAS bf16x8*)(krow + 16 * ks); st0 = mfma32(kf, qf[ks], st0); }
    f32x16 st1 = acc_init<BIAS, MASK>(BIAS == 1 ? bt - 32 : bt, bc, keep1);
#pragma unroll
    for (int ks = 0; ks < 4; ++ks) { const bf16x8 kf = *(const LAS bf16x8*)(krow + 32 * TSTR + 16 * ks); st1 = mfma32(kf, qf[ks], st1); }
    bf16x8 pb0[2], pb1[2];
    exp_pack_sum(st0, pb0, l);
#pragma unroll
    for (int db = 0; db < 2; ++db)
#pragma unroll
        for (int s = 0; s < 2; ++s) { const bf16x8 vf = *(const LAS bf16x8*)(vrow + db * 32 * TSTR + 16 * s); ot[db] = mfma32(vf, pb0[s], ot[db]); }
    exp_pack_sum(st1, pb1, l);
#pragma unroll
    for (int db = 0; db < 2; ++db)
#pragma unroll
        for (int s = 0; s < 2; ++s) { const bf16x8 vf = *(const LAS bf16x8*)(vrow + 32 + db * 32 * TSTR + 16 * s); ot[db] = mfma32(vf, pb1[s], ot[db]); }
}
__device__ __forceinline__ void pvl32_l(f32x16 (&ot)[2], f32x16& lt, const LAS bf16* vb, const bf16x8 (&pb)[2]) {
    pv32_l(ot, vb, pb);
    const bf16x8 one = ones_frag();
#pragma unroll
    for (int s = 0; s < 2; ++s) lt = mfma32(one, pb[s], lt);
}
__device__ __forceinline__ void idx_keys_l(const LAS bf16* ikrow  , const bf16x8 (&iqf)[2], const float (&w)[4], int (&key)[4]) {
#pragma unroll
    for (int blk = 0; blk < 4; ++blk) {
        const bf16x8 b0 = *(const LAS bf16x8*)(ikrow + blk * 16 * TSTRI), b1 = *(const LAS bf16x8*)(ikrow + blk * 16 * TSTRI + 32);
        f32x4 a = {0.f, 0.f, 0.f, 0.f};
        a = mfma16(iqf[0], b0, a); a = mfma16(iqf[1], b1, a);
        const float a0 = a[0], a1 = a[1], a2 = a[2], a3 = a[3];
        const float r0 = __int_as_float(max(__float_as_int(a0), 0)), r1 = __int_as_float(max(__float_as_int(a1), 0)),
                    r2 = __int_as_float(max(__float_as_int(a2), 0)), r3 = __int_as_float(max(__float_as_int(a3), 0));
        float sc = __builtin_fmaf(w[3], r3, __builtin_fmaf(w[2], r2, __builtin_fmaf(w[1], r1, w[0] * r0)));
        sc = __builtin_amdgcn_fmed3f(sc, -524288.f, 524287.f);
        key[blk] = (int)sc;
    }
}
__device__ __forceinline__ void idx_frag_ld(const LAS bf16* ikrow, bf16x8 (&fr)[4][2]) {
#pragma unroll
    for (int blk = 0; blk < 4; ++blk) { fr[blk][0] = *(const LAS bf16x8*)(ikrow + blk * 16 * TSTRI); fr[blk][1] = *(const LAS bf16x8*)(ikrow + blk * 16 * TSTRI + 32); }
}
__device__ __forceinline__ void idx_keys_f(const bf16x8 (&fr)[4][2], const bf16x8 (&iqf)[2], const float (&w)[4], int (&key)[4]) {
    f32x4 a[4];
#pragma unroll
    for (int blk = 0; blk < 4; ++blk) { a[blk] = (f32x4){0.f, 0.f, 0.f, 0.f}; a[blk] = mfma16(iqf[0], fr[blk][0], a[blk]); }
#pragma unroll
    for (int blk = 0; blk < 4; ++blk) a[blk] = mfma16(iqf[1], fr[blk][1], a[blk]);
    __builtin_amdgcn_sched_barrier(0);
#pragma unroll
    for (int blk = 0; blk < 4; ++blk) {
        const float a0 = a[blk][0], a1 = a[blk][1], a2 = a[blk][2], a3 = a[blk][3];
        const float r0 = __int_as_float(max(__float_as_int(a0), 0)), r1 = __int_as_float(max(__float_as_int(a1), 0)),
                    r2 = __int_as_float(max(__float_as_int(a2), 0)), r3 = __int_as_float(max(__float_as_int(a3), 0));
        float sc = __builtin_fmaf(w[3], r3, __builtin_fmaf(w[2], r2, __builtin_fmaf(w[1], r1, __builtin_fmaf(w[0], r0, 32768.f))));
        sc = __builtin_amdgcn_fmed3f(sc, 0.f, 65535.f);
        key[blk] = (int)sc;
    }
}
constexpr int P2C_K = 16384, P2C_V = P2C_K + 384 * TSTR * 2, P2C_END = P2C_V + 384 * TSTR * 2;
__device__ __forceinline__ void mixC_ticket(const Ctx& X, LAS unsigned char* lds, const LAS float* tabC, int j, int tkq, int tid) {
    const int lane = tid & 63, wave = __builtin_amdgcn_readfirstlane(tid >> 6);
    const int g = j >> 2, dil = g == 0 ? 1 : (g == 1 ? 4 : 16), L = SEQ / dil;
    const int p0t = tkq * 256, bl = p0t >> 12, ppt = p0t & (SEQ - 1), ss = ppt & ~(L - 1), n0t = ppt & (L - 1);
    const size_t hb = (size_t)j * X.T;
    const int skip = n0t == 0 ? 128 : 0;
    const long rowb = (long)hb + (long)bl * SEQ + ss + n0t - 128;
    LAS bf16* Kl = (LAS bf16*)(lds + P2C_K); LAS bf16* Vl = (LAS bf16*)(lds + P2C_V);
    const int c = lane & 31, hh = lane >> 5;
    const int p = p0t + 32 * wave + c;
    bf16x8 qf[4];
    { const bf16* qrow = X.cq() + (hb + (size_t)p) * 64 + 8 * hh;
#pragma unroll
      for (int ks = 0; ks < 4; ++ks) qf[ks] = *(const bf16x8*)(qrow + 16 * ks); }
    u32x4 rk[6], rv[6];
#pragma unroll
    for (int i = 0; i < 6; ++i) {
        const int id = tid + 512 * i, row = id >> 3, ch = (id & 7) * 8;
        const int rr = row < skip ? skip : row;
        rk[i] = *(const u32x4*)(X.ck() + (rowb + rr) * 64 + ch);
        rv[i] = *(const u32x4*)(X.cvt() + (rowb + (rr & ~63)) * 64 + (size_t)(rr & 63) * 64 + ch);
    }
#pragma unroll
    for (int i = 0; i < 6; ++i) {
        const int id = tid + 512 * i, row = id >> 3, ch = (id & 7) * 8;
        *(LAS u32x4*)(Kl + row * TSTR + ch) = rk[i]; *(LAS u32x4*)(Vl + row * TSTR + ch) = rv[i];
    }
    __syncthreads();
    f32x16 ot[2] = {zero16(), zero16()}, lt = zero16();
    const int n0 = n0t + 32 * wave;
    const int kbf = n0 >= 128 ? 0 : 4 - (n0 >> 5);
#pragma unroll
    for (int kb = 0; kb < 5; ++kb) {
        if (kb < kbf) continue;
        const int r0 = 32 * (wave + kb);
        const LAS float* bt = tabC + j * TABC + 32 + (128 - 32 * kb + c - 4 * hh) - 27;
        f32x16 st = kb == 0 ? acc_init<1, 1>(bt, 0.f, keep_ge(c - 4 * hh)) : (kb == 4 ? acc_init<1, 1>(bt, 0.f, keep_le(c - 4 * hh)) : acc_init<1, 0>(bt, 0.f, 0u));
        const LAS bf16* krow = Kl + (r0 + c) * TSTR + 8 * hh;
#pragma unroll
        for (int ks = 0; ks < 4; ++ks) { const bf16x8 kf = *(const LAS bf16x8*)(krow + 16 * ks); st = mfma32(kf, qf[ks], st); }
        bf16x8 pb[2];
        exp_pack(st, pb);
        const LAS bf16* vb = Vl + ((r0 >> 6) * 64 + c) * TSTR + (r0 & 32) + 8 * hh;
#pragma unroll
        for (int db = 0; db < 2; ++db)
#pragma unroll
            for (int s2 = 0; s2 < 2; ++s2) { const bf16x8 vf = *(const LAS bf16x8*)(vb + db * 32 * TSTR + 16 * s2); ot[db] = mfma32(vf, pb[s2], ot[db]); }
        { const bf16x8 one = ones_frag(); lt = mfma32(one, pb[0], lt); lt = mfma32(one, pb[1], lt); }
    }
    const float l = lt[0];
    bf16* op = X.cgo() + (hb + (size_t)p) * 64 + 4 * hh;
#pragma unroll
    for (int db = 0; db < 2; ++db)
#pragma unroll
        for (int q4 = 0; q4 < 4; ++q4) { u32x2 w; w.x = cvt_pk_bf16(ot[db][4 * q4], ot[db][4 * q4 + 1]); w.y = cvt_pk_bf16(ot[db][4 * q4 + 2], ot[db][4 * q4 + 3]);
            *(u32x2*)(op + 32 * db + 8 * q4) = w; }
    if (hh == 0) X.cgl()[hb + (size_t)p] = l;
}
constexpr int P2_TABC = 0  , P2_IK1 = 65536, P2_TABA = 109056, P2_END = P2_TABA + 8 * TABS * 4;
static_assert(P2_IK1 + 4 * TILE_LDSI <= P2_TABA, "LDS map (DSA pass 1)");
constexpr int A_UTH = 20;
constexpr int A_WBUF = 2 * 32 * TSTR * 2, A_LIST = 8 * A_WBUF, A_LCAP = 440, A_LSTR = 5 * A_LCAP * 2, A_FILL = 352;
static_assert((A_FILL + 64 + 31) / 32 * 32 <= A_LCAP, "list capacity: a full tile after A_FILL entries, padded to whole blocks");
static_assert(A_LIST + 8 * A_LSTR <= P2_TABA && A_LSTR % 8 == 0, "LDS map (compacted DSA pass)");
__device__ __forceinline__ void mixA_unit(const Ctx& X, LAS unsigned char* lds, unsigned char* kcache  , int bl, int u, int tid) {
    const int lane = tid & 63, wave = __builtin_amdgcn_readfirstlane(tid >> 6);
    const LAS float* tabA = (const LAS float*)(lds + P2_TABA);
    LAS unsigned* hist = (LAS unsigned*)(lds + wave * 8192);
    const int t0 = 32 * u + 4 * wave;
    const size_t tok0 = (size_t)bl * SEQ + t0;
    const int qi = lane >> 4, kk = lane & 15, t = t0 + qi;
    bf16x8 iqf[2];
    { const int row = lane & 15, qa = row >> 2, ih = row & 3, kq = lane >> 4;
      const bf16* p = X.iq() + (tok0 + qa) * 256 + ih * 64 + 8 * kq;
      iqf[0] = *(const bf16x8*)p; iqf[1] = *(const bf16x8*)(p + 32); }
    float w[4];
    { const f32x4 wv = *(const f32x4*)(X.misc() + (tok0 + qi) * 32); w[0] = wv[0] * 512.f; w[1] = wv[1] * 512.f; w[2] = wv[2] * 512.f; w[3] = wv[3] * 512.f; }
    const int ktl = (32 * u + 31) >> 6;
    const bf16* ikg = X.ik() + (size_t)bl * SEQ * 64;
    const int ikoff = (lane & 15) * TSTRI + 8 * (lane >> 4);
    unsigned short* kcw8 = (unsigned short*)(kcache + wave * 32768) + 64 * qi + 4 * kk;
    const u32x2* kc = (const u32x2*)(kcache + wave * 32768) + lane;
    const bf16* kg = X.ak() + (size_t)bl * SEQ * 128;
    const bf16* vg = X.avt() + (size_t)bl * SEQ * 64;
    int lo = 0, need = t + 1 < 256 ? t + 1 : 256, ties = 0;
    u32x4 pf0 = tile_ld(ikg, 64, tid), pf1 = tile_ld(ikg + 4096, 64, tid);
#pragma unroll
    for (int i = 0; i < 4; ++i) *(LAS u32x4*)(hist + 4 * lane + 256 * i) = (u32x4){0u, 0u, 0u, 0u};
    tile_sti((LAS bf16*)(lds + P2_IK1), tid, pf0); tile_sti((LAS bf16*)(lds + P2_IK1 + TILE_LDSI), tid, pf1);
    __syncthreads();
#pragma unroll 1
    for (int rep0 = 0; rep0 < ((DUPA & 1) ? 2 : 1); ++rep0)
    {
        if ((DUPA & 1) && rep0 == 1) {
            pf0 = tile_ld(ikg, 64, tid); pf1 = tile_ld(ikg + 4096, 64, tid);
#pragma unroll
            for (int i = 0; i < 4; ++i) *(LAS u32x4*)(hist + 4 * lane + 256 * i) = (u32x4){0u, 0u, 0u, 0u};
            tile_sti((LAS bf16*)(lds + P2_IK1), tid, pf0); tile_sti((LAS bf16*)(lds + P2_IK1 + TILE_LDSI), tid, pf1);
            __syncthreads();
        }
        const int nst = (ktl >> 1) + 1;
#pragma unroll 1
        for (int st = 0; st < nst; ++st) {
            u32x4 rn0, rn1; const bool more = st + 1 < nst;
            if (more) { rn0 = tile_ld(ikg + (size_t)(2 * st + 2) * 4096, 64, tid); rn1 = tile_ld(ikg + (size_t)(2 * st + 3) * 4096, 64, tid); }
            bf16x8 fr[2][4][2];
            idx_frag_ld((const LAS bf16*)(lds + P2_IK1 + ((st & 1) * 2 + 0) * TILE_LDSI) + ikoff, fr[0]);
            idx_frag_ld((const LAS bf16*)(lds + P2_IK1 + ((st & 1) * 2 + 1) * TILE_LDSI) + ikoff, fr[1]);
            __builtin_amdgcn_sched_barrier(0);
#pragma unroll
            for (int h2 = 0; h2 < 2; ++h2) {
                const int kt = 2 * st + h2;
                int key[4]; idx_keys_f(fr[h2], iqf, w, key);
                {
                  const auto s0 = __builtin_amdgcn_permlane16_swap((unsigned)key[0], (unsigned)key[1], false, false), s1 = __builtin_amdgcn_permlane16_swap((unsigned)key[2], (unsigned)key[3], false, false);
                  const auto tA = __builtin_amdgcn_permlane32_swap(s0[0], s1[0], false, false), tB = __builtin_amdgcn_permlane32_swap(s0[1], s1[1], false, false);
                  u32x2 kw; kw.x = tA[0] | (tB[0] << 16); kw.y = tA[1] | (tB[1] << 16);
                  *(u32x2*)(kcw8 + 256 * kt) = kw; }
                if (kt < ktl) {
#pragma unroll
                    for (int blk = 0; blk < 4; ++blk) __hip_atomic_fetch_add(hist + qi * 256 + ((unsigned)key[blk] >> 8), 1u, __ATOMIC_RELAXED, __HIP_MEMORY_SCOPE_WORKGROUP);
                } else {
#pragma unroll
                    for (int blk = 0; blk < 4; ++blk) { const int sk = kt * 64 + 16 * blk + kk;
                        if (sk <= t) __hip_atomic_fetch_add(hist + qi * 256 + ((unsigned)key[blk] >> 8), 1u, __ATOMIC_RELAXED, __HIP_MEMORY_SCOPE_WORKGROUP); }
                }
            }
            if (more) { tile_sti((LAS bf16*)(lds + P2_IK1 + (((st + 1) & 1) * 2) * TILE_LDSI), tid, rn0); tile_sti((LAS bf16*)(lds + P2_IK1 + (((st + 1) & 1) * 2 + 1) * TILE_LDSI), tid, rn1); }
            __syncthreads();
        }
    }
    const bool compact = u >= A_UTH;
    if (!compact) { pf0 = tile_ld(kg, 128, tid); pf1 = tile_ld(vg, 64, tid); }
    int sv_lo = 0, sv_need = 0, sv_ties = 0, l1rep = 0;
#pragma unroll 1
    for (int lvl = 0; lvl < 2; ++lvl) {
        if ((DUPA & 8) && lvl == 1) { if (l1rep == 0) { sv_lo = lo; sv_need = need; sv_ties = ties; } else { lo = sv_lo; need = sv_need; ties = sv_ties; } }
        const int shift = lvl == 0 ? 8 : 0;
        if (lvl == 1) {
#pragma unroll
            for (int i = 0; i < 4; ++i) *(LAS u32x4*)(hist + 4 * lane + 256 * i) = (u32x4){0u, 0u, 0u, 0u};
            const int lo0 = __shfl(lo, 0), lo1 = __shfl(lo, 16), lo2 = __shfl(lo, 32), lo3 = __shfl(lo, 48);
#pragma unroll 1
            for (int kt0 = 0; kt0 <= ktl; kt0 += 4) {
                u32x2 cw[4];
#pragma unroll
                for (int j = 0; j < 4; ++j) { const int kt = kt0 + j < ktl ? kt0 + j : ktl; cw[j] = kc[64 * kt]; }
#pragma unroll
                for (int j = 0; j < 4; ++j) {
                    const int kt = kt0 + j;
                    if (kt <= ktl) {
                        const int sk = kt * 64 + lane;
#pragma unroll
                        for (int q = 0; q < 4; ++q) {
                            const unsigned k16 = q == 0 ? (cw[j].x & 0xffffu) : (q == 1 ? (cw[j].x >> 16) : (q == 2 ? (cw[j].y & 0xffffu) : (cw[j].y >> 16)));
                            const unsigned d = k16 - (unsigned)(q == 0 ? lo0 : (q == 1 ? lo1 : (q == 2 ? lo2 : lo3)));
                            if (d < 256u && (kt < ktl || sk <= t0 + q)) __hip_atomic_fetch_add(hist + q * 256 + d, 1u, __ATOMIC_RELAXED, __HIP_MEMORY_SCOPE_WORKGROUP);
                        }
                    }
                }
            }
        }
#pragma unroll
        for (int q = 0; q < 4; ++q) {
            const u32x4 w0 = *(const LAS u32x4*)(hist + q * 256 + 4 * lane);
            const unsigned cn[4] = {w0.x, w0.y, w0.z, w0.w};
            const unsigned sum = (cn[0] + cn[1]) + (cn[2] + cn[3]);
            unsigned v = sum;
#pragma unroll
            for (int o = 1; o < 64; o <<= 1) { const unsigned tt = __shfl_down(v, o); if (lane + o < 64) v += tt; }
            const int needq = __shfl(need, 16 * q);
            const unsigned long long ball = __ballot((int)v >= needq);
            const int Ls = 63 - __builtin_clzll(ball | 1ull);
            const int rem = needq - (int)__shfl(v - sum, Ls);
            int c = 0, bsel = 0, abv = 0, cb = 0; bool found = false;
#pragma unroll
            for (int i = 3; i >= 0; --i) { const int ci = (int)cn[i]; const bool hit = !found && (c + ci >= rem); if (hit) { bsel = i; abv = c; cb = ci; } found = found || hit; c += ci; }
            const int bstar = __shfl(4 * lane + bsel, Ls), above = (int)__shfl(v - sum, Ls) + __shfl(abv, Ls), cnt = __shfl(cb, Ls);
            if (qi == q) { lo += bstar << shift; need -= above; ties = cnt; }
        }
        if ((DUPA & 8) && lvl == 1 && l1rep == 0) { l1rep = 1; lvl = 0; }
    }
    int Tq[4], rq[4], tsq[4]; bool slq[4];
#pragma unroll
    for (int q = 0; q < 4; ++q) { Tq[q] = __shfl(lo, 16 * q); rq[q] = __shfl(need, 16 * q); slq[q] = __shfl(ties, 16 * q) != rq[q]; tsq[q] = 0; }
    __syncthreads();
    const int c = lane & 31, hh = lane >> 5, qa = c >> 3, h = c & 7;
    bf16x8 qf[4];
    { const bf16* qrow = X.aq() + (tok0 + qa) * 512 + h * 64 + 8 * hh;
#pragma unroll
      for (int ks = 0; ks < 4; ++ks) qf[ks] = *(const bf16x8*)(qrow + 16 * ks); }
    f32x16 ot[2] = {zero16(), zero16()}; float l = 0.f;
    const LAS float* tabh = tabA + h * TABS + 64;
    const float bfar = tabh[1599];
    const int kvoff = c * TSTR + 8 * hh;
    if (compact) {
        LAS unsigned short* lidx = (LAS unsigned short*)(lds + A_LIST + wave * A_LSTR); LAS unsigned short* loff = lidx + A_LCAP;
        LAS bf16* Kb = (LAS bf16*)(lds + wave * A_WBUF); LAS bf16* Vb = Kb + 32 * TSTR;
        const int grow = lane >> 3, gch = (lane & 7) * 8;
        const int m16 = lane & 15, g16 = lane >> 4;
        const LAS bf16* vtr0 = Vb + (4 * (g16 >> 1) + (m16 >> 2)) * TSTR + 16 * (g16 & 1) + 4 * (m16 & 3);
        const LAS unsigned char* tabq = lds + P2_TABA + (h * TABS + qa) * 4;
        const LAS unsigned short* loq = loff + qa * A_LCAP;
        u32x4 gk[4], gv[4];
#pragma unroll 1
        for (int repm = 0; repm < ((DUPA & 16) ? 2 : 1); ++repm) {
        if ((DUPA & 16) && repm == 1) { ot[0] = zero16(); ot[1] = zero16(); l = 0.f; tsq[0] = tsq[1] = tsq[2] = tsq[3] = 0; }
        int n = 0, kt = 0; bool inflight = false;
        u32x2 cwn = kc[0];
#pragma unroll 1
        for (;;) {
#pragma unroll 1
            while (kt <= ktl && n <= A_FILL) {
                const int s0 = kt * 64; const u32x2 cw = cwn;
                if (kt < ktl) cwn = kc[64 * (kt + 1)];
                const int kq[4] = {(int)(cw.x & 0xffffu), (int)(cw.x >> 16), (int)(cw.y & 0xffffu), (int)(cw.y >> 16)};
                unsigned nib = 0u;
#pragma unroll
                for (int q = 0; q < 4; ++q) {
                    const bool causal = (kt < ktl) || (s0 + lane <= t0 + q);
                    bool sel;
                    if (!slq[q]) sel = causal && kq[q] >= Tq[q];
                    else {
                        const unsigned long long be = __ballot(causal && kq[q] == Tq[q]);
                        const int below = (int)__builtin_amdgcn_mbcnt_hi((unsigned)(be >> 32), __builtin_amdgcn_mbcnt_lo((unsigned)be, 0u));
                        sel = causal && (kq[q] > Tq[q] || (kq[q] == Tq[q] && tsq[q] + below < rq[q]));
                        tsq[q] += __builtin_popcountll(be);
                    }
                    nib |= sel ? (1u << q) : 0u;
                }
                const unsigned long long bu = __ballot(nib != 0u);
                const int pos = n + (int)__builtin_amdgcn_mbcnt_hi((unsigned)(bu >> 32), __builtin_amdgcn_mbcnt_lo((unsigned)bu, 0u));
                if (nib != 0u) {
                    int e = t0 - (s0 + lane); e = e > 1596 ? 1596 : e;
                    const unsigned off = (unsigned)(e + 64) * 4u;
                    lidx[pos] = (unsigned short)(s0 + lane);
#pragma unroll
                    for (int q = 0; q < 4; ++q) loff[q * A_LCAP + pos] = (unsigned short)(((nib >> q) & 1u) ? off : 0u);
                }
                n += __builtin_popcountll(bu);
                ++kt;
            }
            const bool last = kt > ktl;
            int nb;
            if (last) { nb = (n + 31) >> 5; const int p = n + lane;
                if (p < 32 * nb) { lidx[p] = (unsigned short)t0; loff[p] = 0; loff[A_LCAP + p] = 0; loff[2 * A_LCAP + p] = 0; loff[3 * A_LCAP + p] = 0; } }
            else nb = (n >> 5) - 1;
            asm volatile("" ::: "memory");
            if (!inflight) {
#pragma unroll
                for (int i = 0; i < 4; ++i) { const int sk = lidx[grow + 8 * i]; const bf16* rp = kg + (size_t)sk * 128 + gch; gk[i] = *(const u32x4*)rp; gv[i] = *(const u32x4*)(rp + 64); }
            }
#pragma unroll 1
            for (int blkc = 0; blkc < nb; ++blkc) {
#pragma unroll
                for (int i = 0; i < 4; ++i) { *(LAS u32x4*)(Kb + (grow + 8 * i) * TSTR + gch) = gk[i]; *(LAS u32x4*)(Vb + (grow + 8 * i) * TSTR + gch) = gv[i]; }
                asm volatile("" ::: "memory");
                if (blkc + 1 < nb || !last) {
#pragma unroll
                    for (int i = 0; i < 4; ++i) { const int sk = lidx[32 * (blkc + 1) + grow + 8 * i]; const bf16* rp = kg + (size_t)sk * 128 + gch; gk[i] = *(const u32x4*)rp; gv[i] = *(const u32x4*)(rp + 64); }
                }
                bf16x8 kf[4], vf[2][2];
#pragma unroll
                for (int ks = 0; ks < 4; ++ks) kf[ks] = *(const LAS bf16x8*)(Kb + c * TSTR + 8 * hh + 16 * ks);
                u32x2 ow[4];
#pragma unroll
                for (int j = 0; j < 4; ++j) ow[j] = *(const LAS u32x2*)(loq + 32 * blkc + 8 * j + 4 * hh);
#pragma unroll
                for (int db = 0; db < 2; ++db)
#pragma unroll
                    for (int s2 = 0; s2 < 2; ++s2) {
                        const s16x4_t lo4 = __builtin_bit_cast(s16x4_t, __builtin_amdgcn_ds_read_tr16_b64_v4i16((LAS v4i16_t*)(vtr0 + (16 * s2) * TSTR + 32 * db)));
                        const s16x4_t hi4 = __builtin_bit_cast(s16x4_t, __builtin_amdgcn_ds_read_tr16_b64_v4i16((LAS v4i16_t*)(vtr0 + (16 * s2 + 8) * TSTR + 32 * db)));
                        vf[db][s2] = (bf16x8){lo4[0], lo4[1], lo4[2], lo4[3], hi4[0], hi4[1], hi4[2], hi4[3]};
                    }
                f32x16 st;
#pragma unroll
                for (int j = 0; j < 4; ++j)
#pragma unroll
                    for (int i2 = 0; i2 < 4; ++i2) {
                        const unsigned off = ((i2 < 2 ? ow[j].x : ow[j].y) >> (16 * (i2 & 1))) & 0xffffu;
                        st[4 * j + i2] = *(const LAS float*)(tabq + off);
                    }
                __builtin_amdgcn_sched_barrier(0);
#pragma unroll
                for (int ks = 0; ks < 4; ++ks) st = mfma32(kf[ks], qf[ks], st);
                bf16x8 pb[2];
                exp_pack_sum(st, pb, l);
#pragma unroll
                for (int db = 0; db < 2; ++db)
#pragma unroll
                    for (int s2 = 0; s2 < 2; ++s2) ot[db] = mfma32(vf[db][s2], pb[s2], ot[db]);
                asm volatile("" ::: "memory");
            }
            if (last) break;
            { const int src = 32 * nb + lane; const bool mv = src < n;
              unsigned short vi = 0, v0 = 0, v1 = 0, v2 = 0, v3 = 0;
              if (mv) { vi = lidx[src]; v0 = loff[src]; v1 = loff[A_LCAP + src]; v2 = loff[2 * A_LCAP + src]; v3 = loff[3 * A_LCAP + src]; }
              asm volatile("" ::: "memory");
              if (mv) { lidx[lane] = vi; loff[lane] = v0; loff[A_LCAP + lane] = v1; loff[2 * A_LCAP + lane] = v2; loff[3 * A_LCAP + lane] = v3; }
              asm volatile("" ::: "memory"); }
            n -= 32 * nb; inflight = true;
        }
        }
        __syncthreads();
    } else {
    tile_st((LAS bf16*)lds, tid, pf0); tile_st((LAS bf16*)(lds + TILE_LDS), tid, pf1);
        u32x2 cwn = kc[0];
        __syncthreads();
    #pragma unroll 1
        for (int kt = 0; kt <= ktl; ++kt) {
            const int s0 = kt * 64; const bool more = kt < ktl;
            u32x4 rk, rv;
            const u32x2 cw = cwn;
            if (more) { rk = tile_ld(kg + (size_t)(kt + 1) * 8192, 128, tid); rv = tile_ld(vg + (size_t)(kt + 1) * 4096, 64, tid); cwn = kc[64 * (kt + 1)]; }
            const LAS bf16* kb_ = (const LAS bf16*)(lds + (kt & 1) * (2 * TILE_LDS)); const LAS bf16* vb_ = kb_ + 64 * TSTR;
            const int kq[4] = {(int)(cw.x & 0xffffu), (int)(cw.x >> 16), (int)(cw.y & 0xffffu), (int)(cw.y >> 16)};
            unsigned long long bq[4];
    #pragma unroll
            for (int q = 0; q < 4; ++q) {
                const bool causal = (kt < ktl) || (s0 + lane <= t0 + q);
                if (!slq[q]) bq[q] = __ballot(causal && kq[q] >= Tq[q]);
                else {
                    const unsigned long long be = __ballot(causal && kq[q] == Tq[q]);
                    const int below = (int)__builtin_amdgcn_mbcnt_hi((unsigned)(be >> 32), __builtin_amdgcn_mbcnt_lo((unsigned)be, 0u));
                    bq[q] = __ballot(causal && (kq[q] > Tq[q] || (kq[q] == Tq[q] && tsq[q] + below < rq[q])));
                    tsq[q] += __builtin_popcountll(be);
                }
            }
            const unsigned long long mq = qa == 0 ? bq[0] : (qa == 1 ? bq[1] : (qa == 2 ? bq[2] : bq[3]));
            const unsigned mw[2] = {(unsigned)mq >> (4 * hh), (unsigned)(mq >> 32) >> (4 * hh)};
            const bool farT = (s0 + 63 <= t0 - 1512);
    #pragma unroll
            for (int kb = 0; kb < 2; ++kb) {
                bf16x8 pb[2];
                if (farT) qks32_ls<2, 1>(kb_ + kvoff + 32 * kb * TSTR, qf, nullptr, bfar, mw[kb], pb, l);
                else qks32_ls<1, 1>(kb_ + kvoff + 32 * kb * TSTR, qf, tabh + (t0 + qa - s0 - 4 * hh - 32 * kb) - 27, 0.f, mw[kb], pb, l);
                pv32_l(ot, vb_ + kvoff + 32 * kb, pb);
            }
            if (more) { LAS bf16* nb_ = (LAS bf16*)(lds + ((kt + 1) & 1) * (2 * TILE_LDS)); tile_st(nb_, tid, rk); tile_st(nb_ + 64 * TSTR, tid, rv); }
            __syncthreads();
        }
    }
    l += shx(l, 32);
    const float inv = 1.f / fmaxf(l, 1e-30f);
    bf16* op = X.oa() + (tok0 + qa) * 512 + h * 64 + 4 * hh;
#pragma unroll
    for (int db = 0; db < 2; ++db)
#pragma unroll
        for (int q4 = 0; q4 < 4; ++q4) { u32x2 wv; wv.x = cvt_pk_bf16(ot[db][4 * q4] * inv, ot[db][4 * q4 + 1] * inv); wv.y = cvt_pk_bf16(ot[db][4 * q4 + 2] * inv, ot[db][4 * q4 + 3] * inv);
            *(u32x2*)(op + 32 * db + 8 * q4) = wv; }
}

__device__ __forceinline__ void ob_flush(bf16* op, const f32x16 (&acc)[2], float sc, bool add) {
#pragma unroll
    for (int db = 0; db < 2; ++db)
#pragma unroll
        for (int q4 = 0; q4 < 4; ++q4) {
            float v[4];
#pragma unroll
            for (int j = 0; j < 4; ++j) v[j] = sc * acc[db][4 * q4 + j];
            if (add) { const u32x2 o = *(const u32x2*)(op + 32 * db + 8 * q4);
                v[0] += __uint_as_float(o.x << 16); v[1] += __uint_as_float(o.x & 0xffff0000u); v[2] += __uint_as_float(o.y << 16); v[3] += __uint_as_float(o.y & 0xffff0000u); }
            u32x2 wv; wv.x = cvt_pk_bf16(v[0], v[1]); wv.y = cvt_pk_bf16(v[2], v[3]);
            *(u32x2*)(op + 32 * db + 8 * q4) = wv; }
}
constexpr int P3_TABB = 65536, P3_SCR = P3_TABB + 8 * TABS * 4, P3_UM = P3_SCR + 8 * 4096, P3_END = P3_UM + 64;
__device__ __forceinline__ void mixB_unit(const Ctx& X, LAS unsigned char* lds, int bl, int g, int it, int tid) {
    const int lane = tid & 63, wave = __builtin_amdgcn_readfirstlane(tid >> 6);
    const LAS float* tabB = (const LAS float*)(lds + P3_TABB);
    LAS unsigned* scr = (LAS unsigned*)(lds + P3_SCR + wave * 4096);
    LAS unsigned long long* um = (LAS unsigned long long*)(lds + P3_UM);
    const int t0 = 64 * it + 8 * wave;
    const int c = lane & 31, hh = lane >> 5, qa = c >> 2, h = c & 3, head = 4 * g + h, t = t0 + qa;
    const size_t tok = (size_t)bl * SEQ + t;
    const int bg = bl * 2 + g;
    bf16x8 qf[4];
    { const bf16* qrow = X.bq() + tok * 512 + head * 64 + 8 * hh;
#pragma unroll
      for (int ks = 0; ks < 4; ++ks) qf[ks] = *(const bf16x8*)(qrow + 16 * ks); }
    const float g0 = X.misc()[tok * 32 + 4 + head * 3 + 0], g1 = X.misc()[tok * 32 + 4 + head * 3 + 1], g2 = X.misc()[tok * 32 + 4 + head * 3 + 2];
    f32x16 out[2] = {zero16(), zero16()};
    const int kvoff = c * TSTR + 8 * hh;
#define KBUF(b) ((LAS bf16*)(lds + (b) * 2 * TILE_LDS))
#define VBUF(b) ((LAS bf16*)(lds + (b) * 2 * TILE_LDS + TILE_LDS))
    const int nmW = ((64 * it + 63) - 31) >> 4;
    const int nmw = ((t0 + 7) - 31) >> 4, nm = (t - 31) >> 4;
    const int nblw = nmw >> 5;
    LAS float* impb = (LAS float*)scr;
#pragma unroll
    for (int i = 0; i < 8; ++i) impb[lane + 64 * i] = 0.f;
    if (nmW >= 0) {
        const int ntl = nmW >> 6;
        const bf16* kcg = X.kcmp() + (size_t)bg * 256 * 64;
        const bf16* vcg = X.vcmpt() + (size_t)bg * 64 * 256;
        float lc = 0.f; u32x4 pfk, pfv;
        { const u32x4 r0 = tile_ld(kcg, 64, tid); tile_st(KBUF(0), tid, r0); }
        __syncthreads();
#pragma unroll 1
        for (int tl = 0; tl <= ntl; ++tl) {
            u32x4 rk; const bool more = tl < ntl;
            if (more) rk = tile_ld(kcg + (size_t)(tl + 1) * 4096, 64, tid);
            else { pfk = tile_ld(kcg, 64, tid); pfv = tile_ld(vcg, 256, tid); }
#pragma unroll
            for (int kb = 0; kb < 2; ++kb) {
                const int nb = 2 * tl + kb;
                if (nb <= nblw) {
                    const f32x16 st = qk32_l(KBUF(tl & 1) + kvoff + 32 * kb * TSTR, qf);
                    const unsigned keep = keep_le(nm - 32 * nb - 4 * hh);
#pragma unroll
                    for (int r = 0; r < 16; ++r) { const int sel = ((int)(keep << (31 - ROWC(r)))) >> 31; lc += __builtin_bit_cast(float, __builtin_bit_cast(int, __builtin_amdgcn_exp2f(st[r])) & sel); }
                }
            }
            if (more) tile_st(KBUF((tl + 1) & 1), tid, rk);
            __syncthreads();
        }
        lc += shx(lc, 32);
        const float invc = lc > 0.f ? 1.f / lc : 0.f;
        f32x16 oc[2] = {zero16(), zero16()};
        float carry = 0.f;
        tile_st(KBUF(0), tid, pfk); tile_st(VBUF(0), tid, pfv);
        __syncthreads();
#pragma unroll 1
        for (int tl = 0; tl <= ntl; ++tl) {
            u32x4 rk, rv; const bool more = tl < ntl;
            if (more) { rk = tile_ld(kcg + (size_t)(tl + 1) * 4096, 64, tid); rv = tile_ld(vcg + (tl + 1) * 64, 256, tid); }
#pragma unroll
            for (int kb = 0; kb < 2; ++kb) {
                const int nb = 2 * tl + kb;
                if (nb <= nblw) {
                    const f32x16 st = qk32_l(KBUF(tl & 1) + kvoff + 32 * kb * TSTR, qf);
                    const unsigned keep = keep_le(nm - 32 * nb - 4 * hh);
                    float p[16];
#pragma unroll
                    for (int r = 0; r < 16; ++r) { const int sel = ((int)(keep << (31 - ROWC(r)))) >> 31; p[r] = __builtin_bit_cast(float, __builtin_bit_cast(int, __builtin_amdgcn_exp2f(st[r])) & sel) * invc; }
                    bf16x8 pb[2];
#pragma unroll
                    for (int s = 0; s < 2; ++s) { u32x4 wv; wv.x = cvt_pk_bf16(p[8 * s + 0], p[8 * s + 1]); wv.y = cvt_pk_bf16(p[8 * s + 2], p[8 * s + 3]); wv.z = cvt_pk_bf16(p[8 * s + 4], p[8 * s + 5]); wv.w = cvt_pk_bf16(p[8 * s + 6], p[8 * s + 7]);
                        pb[s] = __builtin_bit_cast(bf16x8, wv); }
                    pv32_l(oc, VBUF(tl & 1) + kvoff + 32 * kb, pb);
                    float rc[4];
#pragma unroll
                    for (int qd = 0; qd < 4; ++qd) rc[qd] = shx(p[4 * qd + 3], 32);
#pragma unroll
                    for (int qd = 0; qd < 4; ++qd) {
                        const float ex = hh ? rc[qd] : (qd == 0 ? carry : rc[qd - 1]);
                        float v = (p[4 * qd] + p[4 * qd + 1]) + (p[4 * qd + 2] + p[4 * qd + 3]) + ex;
                        v += shx(v, 1); v += shx(v, 2);
                        if (h == 0) impb[qa * 64 + 8 * nb + 2 * qd + hh] = v;
                    }
                    carry = rc[3];
                }
            }
            if (more) { tile_st(KBUF((tl + 1) & 1), tid, rk); tile_st(VBUF((tl + 1) & 1), tid, rv); }
            __syncthreads();
        }
#pragma unroll
        for (int db = 0; db < 2; ++db)
#pragma unroll
            for (int r = 0; r < 16; ++r) out[db][r] = g0 * oc[db][r];
    }
    const bf16* ksg = X.bks() + (size_t)bg * SEQ * 64; const bf16* vsg = X.bvst() + (size_t)bg * SEQ * 64;
    const u32x4 ps0 = tile_ld(ksg, 64, tid), ps1 = tile_ld(vsg, 64, tid);
    LAS unsigned long long* selm = (LAS unsigned long long*)(scr + 512);
    unsigned long long ormask = 0ull;
#pragma unroll 1
    for (int q0 = 0; q0 < 8; q0 += 4) {
        const int m = lane;
        unsigned key[4], Tq[4];
#pragma unroll
        for (int j = 0; j < 4; ++j) {
            const float iv = impb[(q0 + j) * 64 + m];
            key[j] = 0u; Tq[j] = 0u;
            if (m <= it) { const bool forced = (m == 0) || (m == it) || (m == it - 1);
                key[j] = forced ? (0xffffff00u | (unsigned)(63 - m)) : ((__builtin_bit_cast(unsigned, iv) & ~63u) | (unsigned)(63 - m)); }
        }
#pragma unroll 1
        for (int bit = 31; bit >= 0; --bit) {
#pragma unroll
            for (int j = 0; j < 4; ++j) { const unsigned cand = Tq[j] | (1u << bit); if (__builtin_popcountll(__ballot(key[j] >= cand)) >= 16) Tq[j] = cand; }
        }
#pragma unroll
        for (int j = 0; j < 4; ++j) {
            const unsigned long long mk = __ballot(key[j] >= Tq[j] && key[j] != 0u);
            if (lane == 0) selm[q0 + j] = mk;
            ormask |= mk;
        }
    }
    const unsigned long long mymask = selm[qa];
    if (lane == 0) um[wave] = ormask;
    __syncthreads();
    unsigned long long U = 0ull;
#pragma unroll
    for (int i = 0; i < 8; ++i) U |= um[i];
    const LAS float* tabh = tabB + head * TABS + 64;
    const float bfar = tabh[1599];
    const bf16* kwg = X.bkw() + (size_t)bg * SEQ * 64; const bf16* vwg = X.bvwt() + (size_t)bg * SEQ * 64;
    int m0W = (64 * it - 511) >> 6; if (m0W < 0) m0W = 0;
    u32x4 pw0, pw1;
    {
        f32x16 os[2] = {zero16(), zero16()}; float ls = 0.f;
        const bf16* kg = ksg; const bf16* vg = vsg;
        int m = 0;
        tile_st(KBUF(0), tid, ps0); tile_st(VBUF(0), tid, ps1);
        __syncthreads();
        int b = 0;
#pragma unroll 1
        for (;;) {
            const unsigned long long rest = (m >= 63) ? 0ull : (U >> (m + 1));
            const bool more = rest != 0ull; const int mn = more ? m + 1 + __builtin_ctzll(rest) : m;
            u32x4 rk, rv;
            if (more) { rk = tile_ld(kg + (size_t)mn * 4096, 64, tid); rv = tile_ld(vg + (size_t)mn * 4096, 64, tid); }
            else { pw0 = tile_ld(kwg + (size_t)m0W * 4096, 64, tid); pw1 = tile_ld(vwg + (size_t)m0W * 4096, 64, tid); }
            if ((ormask >> m) & 1ull) {
                const int s0 = m * 64;
                const unsigned lanekeep = ((mymask >> m) & 1ull) ? 0xffffffffu : 0u;
                const bool farT = (s0 + 63 <= t0 - 1512);
                const LAS float* bt = tabh + (t - s0 - 4 * hh) - 27;
                if (m == it) tile64_l<1, 1>(KBUF(b) + kvoff, VBUF(b) + kvoff, qf, bt, 0.f, lanekeep & keep_le(t - s0 - 4 * hh), lanekeep & keep_le(t - s0 - 32 - 4 * hh), os, ls);
                else if (farT) tile64_l<2, 2>(KBUF(b) + kvoff, VBUF(b) + kvoff, qf, nullptr, bfar, lanekeep, lanekeep, os, ls);
                else tile64_l<1, 2>(KBUF(b) + kvoff, VBUF(b) + kvoff, qf, bt, 0.f, lanekeep, lanekeep, os, ls);
            }
            if (more) { tile_st(KBUF(b ^ 1), tid, rk); tile_st(VBUF(b ^ 1), tid, rv); }
            __syncthreads();
            if (!more) break;
            m = mn; b ^= 1;
        }
        ls += shx(ls, 32);
        const float sc = g1 / fmaxf(ls, 1e-30f);
#pragma unroll
        for (int db = 0; db < 2; ++db)
#pragma unroll
            for (int r = 0; r < 16; ++r) out[db][r] += sc * os[db][r];
    }
    {
        f32x16 ow[2] = {zero16(), zero16()}; float lw = 0.f;
        const bf16* kg = kwg; const bf16* vg = vwg;
        int m0 = (t0 - 511) >> 6; if (m0 < 0) m0 = 0;
        tile_st(KBUF(0), tid, pw0); tile_st(VBUF(0), tid, pw1);
        __syncthreads();
#pragma unroll 1
        for (int m = m0W; m <= it; ++m) {
            const int b = (m - m0W) & 1; const bool more = m < it;
            u32x4 rk, rv;
            if (more) { rk = tile_ld(kg + (size_t)(m + 1) * 4096, 64, tid); rv = tile_ld(vg + (size_t)(m + 1) * 4096, 64, tid); }
            if (m >= m0) {
                const int s0 = m * 64;
#pragma unroll
                for (int kb = 0; kb < 2; ++kb) {
                    bf16x8 pb[2];
                    if (s0 + 63 <= t0 && s0 >= t0 + 7 - 511)
                        qks32_ls<1, 0>(KBUF(b) + kvoff + 32 * kb * TSTR, qf, tabh + (t - s0 - 4 * hh - 32 * kb) - 27, 0.f, 0u, pb, lw);
                    else qks32_ls<1, 1>(KBUF(b) + kvoff + 32 * kb * TSTR, qf, tabh + (t - s0 - 4 * hh - 32 * kb) - 27, 0.f, keep_le(t - s0 - 32 * kb - 4 * hh) & keep_ge(t - 511 - s0 - 32 * kb - 4 * hh), pb, lw);
                    pv32_l(ow, VBUF(b) + kvoff + 32 * kb, pb);
                }
            }
            if (more) { tile_st(KBUF(b ^ 1), tid, rk); tile_st(VBUF(b ^ 1), tid, rv); }
            __syncthreads();
        }
        lw += shx(lw, 32);
        const float sc = g2 / fmaxf(lw, 1e-30f);
#pragma unroll
        for (int db = 0; db < 2; ++db)
#pragma unroll
            for (int r = 0; r < 16; ++r) out[db][r] += sc * ow[db][r];
    }
#undef KBUF
#undef VBUF
    bf16* op = X.ob() + tok * 512 + head * 64 + 4 * hh;
#pragma unroll
    for (int db = 0; db < 2; ++db)
#pragma unroll
        for (int q4 = 0; q4 < 4; ++q4) { u32x2 wv; wv.x = cvt_pk_bf16(out[db][4 * q4], out[db][4 * q4 + 1]); wv.y = cvt_pk_bf16(out[db][4 * q4 + 2], out[db][4 * q4 + 3]);
            *(u32x2*)(op + 32 * db + 8 * q4) = wv; }
}

constexpr int NWAVES = 8;
constexpr int LDS_BYTES = 163840, LDSCTL_OFF = 162816, MISC_OFF = LDSCTL_OFF + 320;
static_assert(P2_END <= LDSCTL_OFF && P3_END <= LDSCTL_OFF, "LDS map");
constexpr int CW_BAR = 4096, CW_QUEUE = 16384;
constexpr int PH_PER = 7;

__global__ void __launch_bounds__(NWAVES * 64, 2) mk_fwd(Args args) {
    extern __shared__ __attribute__((aligned(16))) unsigned char lds_raw[];
    LAS unsigned char* lds = (LAS unsigned char*)lds_raw;
    volatile LAS unsigned* MISCW = (volatile LAS unsigned*)(lds + MISC_OFF);
    const int tid = threadIdx.x, lane = tid & 63, wave = __builtin_amdgcn_readfirstlane(tid >> 6);
    constexpr int T = TCH;
    unsigned char* ws = args.ws;
    unsigned* ctl = (unsigned*)(ws + MP.ctl);
    for (int u = tid; u < (LDS_BYTES - LDSCTL_OFF) / 4; u += NWAVES * 64) ((LAS unsigned*)(lds + LDSCTL_OFF))[u] = 0u;
    __syncthreads();
    XcdBarrier bar; bar.bar = ctl + CW_BAR; bar.x = 0; bar.st = nullptr;
    if (MK_SINGLE) bar = xcd_barrier_post(ctl + CW_BAR, MISCW + 8);
    const int lo = args.ph_lo, hi = args.ph_hi;
#define IN(k) (lo <= (k) && (k) < hi)
#define SEAM(k) do { if (IN(k) && IN((k) + 1)) { xcd_barrier(bar); if (DUP & 128) xcd_barrier(bar); } } while (0)
#define GWVARS const int vcu = (G % 8 == 0) ? (bx % 8) * (G / 8) + bx / 8 : bx, gw = vcu * NWAVES + wave, NGW = G * NWAVES; (void)gw; (void)NGW;

#pragma unroll 1
    for (int rep0 = 0; rep0 < ((DUP & 64) ? 2 : 1); ++rep0)
    if (IN(0) && (PHMASK & 1)) {
        const int G = gridDim.x, bx = blockIdx.x; GWVARS
        float* biasA = (float*)(ws + MP.biasA); float* biasB = (float*)(ws + MP.biasB); float* biasC = (float*)(ws + MP.biasC); float* cmpb = (float*)(ws + MP.cmpb);
        bf16* XB = (bf16*)(ws + MP.xb); float* SSQ1 = (float*)(ws + MP.ssq1);
        LAS float* scr = (LAS float*)(lds + wave * 16384);
        {
            constexpr int nitm[10] = {16 * (N_MAIN / 32), 16 * (N_VT / 32), 8 * 32, 8 * 32, 4 * 32, 16 * 32, 16 * (N_FF2 / 32), (DFF / 64) * 32, 32 * 8, 32 * 8};
            constexpr int NL = nitm[0] + nitm[1] + nitm[2] + nitm[3] + nitm[4] + nitm[5] + nitm[6] + nitm[7] + nitm[8] + nitm[9];
            f32x4 v[8]; int cK = 0, ck0 = 0, cn0 = 0; bf16* cdst = nullptr; bool have = false;
#pragma unroll 1
            for (int itg = gw; ; itg += NGW) {
                const bool valid = itg < NLAYER * NL;
                f32x4 vn[8]; int nK = 0, nk0 = 0, nn0 = 0; bf16* ndst = nullptr;
                if (valid) {
                    const int l = itg / NL; int it = itg % NL, mi = 0;
#pragma unroll
                    for (int q = 0; q < 9; ++q) if (mi == q && it >= nitm[q]) { it -= nitm[q]; mi = q + 1; }
                    const float* win = args.in[3] + (size_t)l * DM * IN_TOTAL;
                    const float* src; int K, Nsrc, Nd; const float* gk = nullptr;
                    switch (mi) {
                        case W_IN: src = win; K = DM; Nsrc = IN_TOTAL; Nd = N_MAIN; gk = args.in[1] + l * DM; break;
                        case W_VT: src = win; K = DM; Nsrc = IN_TOTAL; Nd = N_VT; gk = args.in[1] + l * DM; break;
                        case W_BA: src = args.in[7] + (size_t)l * 512 * DM; K = 512; Nsrc = DM; Nd = DM; break;
                        case W_BB: src = args.in[8] + (size_t)l * 512 * DM; K = 512; Nsrc = DM; Nd = DM; break;
                        case W_BC: src = args.in[9] + (size_t)l * 256 * DM; K = 256; Nsrc = DM; Nd = DM; break;
                        case W_OUT: src = args.in[10] + (size_t)l * DM * DM; K = DM; Nsrc = DM; Nd = DM; break;
                        case W_FI: src = args.in[11] + (size_t)l * DM * N_FF2; K = DM; Nsrc = N_FF2; Nd = N_FF2; gk = args.in[2] + l * DM; break;
                        case W_FO: src = args.in[12] + (size_t)l * DFF * DM; K = DFF; Nsrc = DM; Nd = DM; break;
                        case W_CK: src = args.in[6] + (size_t)(l * 2 + 0) * 2048 * 64; K = 2048; Nsrc = 64; Nd = 256; break;
                        default:   src = args.in[6] + (size_t)(l * 2 + 1) * 2048 * 64; K = 2048; Nsrc = 64; Nd = 256; break;
                    }
                    bf16* dst = (bf16*)(ws + MP.w[0][0] + (size_t)l * (MP.w[1][0] - MP.w[0][0])) ;
                    { size_t off = 0;
#pragma unroll
                      for (int q = 0; q < 10; ++q) if (q == mi) off = MP.w[0][q] - MP.w[0][0];
                      dst = (bf16*)((unsigned char*)dst + off); }
                    const int nblk = Nd / 32, kb = it / nblk, nb = it % nblk, row = nb * 32 + 4 * (lane & 7);
                    int sc;
                    if (mi == W_IN) sc = main_src(row); else if (mi == W_VT) sc = vt_src(row); else if (mi == W_FI) sc = ffn_src(row);
                    else if (mi == W_CK) sc = (((row & 127) >> 5) == 0) ? (32 * ((row & 255) >> 7) + (row & 31)) : -1;
                    else if (mi == W_CV) sc = row < 64 ? row : -1; else sc = row;
                    ti_load(src, Nsrc, kb * 64, sc, gk, lane, vn); nK = K; nk0 = kb * 64; nn0 = nb * 32; ndst = dst;
                }
                if (have) ti_finish(v, cK, cdst, scr, ck0, cn0, lane);
                if (!valid) break;
#pragma unroll
                for (int i = 0; i < 8; ++i) v[i] = vn[i];
                cK = nK; ck0 = nk0; cn0 = nn0; cdst = ndst; have = true;
            }
        }
        {
            bf16* XB = (bf16*)(ws + MP.xb); float* SSQ1 = (float*)(ws + MP.ssq1);
            f32x4 v[2][4];
            { const int r = gw < NTOK / 2 ? gw : 0;
#pragma unroll
              for (int h = 0; h < 2; ++h) { const f32x4* xr = (const f32x4*)(args.in[0] + (size_t)(r + h * (NTOK / 2)) * DM) + 2 * lane;
#pragma unroll
                  for (int j = 0; j < 4; ++j) v[h][j] = xr[128 * (j >> 1) + (j & 1)]; } }
#pragma unroll 1
            for (int r = gw; r < NTOK / 2; r += NGW) {
                f32x4 vn[2][4];
                { const int rn = r + NGW < NTOK / 2 ? r + NGW : r;
#pragma unroll
                  for (int h = 0; h < 2; ++h) { const f32x4* xr = (const f32x4*)(args.in[0] + (size_t)(rn + h * (NTOK / 2)) * DM) + 2 * lane;
#pragma unroll
                      for (int j = 0; j < 4; ++j) vn[h][j] = xr[128 * (j >> 1) + (j & 1)]; } }
#pragma unroll
                for (int h = 0; h < 2; ++h) { const size_t row = (size_t)(r + h * (NTOK / 2)); float sq = 0.f;
                    u32x4* o16 = (u32x4*)(XB + row * DM) + lane;
#pragma unroll
                    for (int jj = 0; jj < 2; ++jj) { const f32x4 x = v[h][2 * jj], y = v[h][2 * jj + 1];
                        sq += ((x[0] * x[0] + x[1] * x[1]) + (x[2] * x[2] + x[3] * x[3])) + ((y[0] * y[0] + y[1] * y[1]) + (y[2] * y[2] + y[3] * y[3]));
                        u32x4 o; o.x = pk2(x[0], x[1]); o.y = pk2(x[2], x[3]); o.z = pk2(y[0], y[1]); o.w = pk2(y[2], y[3]);
                        o16[64 * jj] = o; }
                    sq = wave_sum(sq);
                    if (lane < 16) SSQ1[row * 16 + lane] = lane == 0 ? sq : 0.f; }
#pragma unroll
                for (int h = 0; h < 2; ++h)
#pragma unroll
                    for (int j = 0; j < 4; ++j) v[h][j] = vn[h][j];
            }
        }
        const float* rel = args.in[13];
        for (int i = bx * 512 + tid; i < 16 * TABS; i += G * 512) {
            const int hd = i / TABS, e = i % TABS, d = e - 64;
            const float v = d < 0 ? -30000.f   : (d >= 1600 ? 0.f : rel[rel_bucket(d) * 28 + hd] * LOG2E);
            if (hd < 8) biasA[hd * TABS + e] = v; else biasB[(hd - 8) * TABS + e] = v;
        }
        for (int i = bx * 512 + tid; i < 12 * TABC; i += G * 512) {
            const int j = i / TABC, e = i % TABC, jj = e - 32, dil = (j >> 2) == 0 ? 1 : ((j >> 2) == 1 ? 4 : 16);
            biasC[i] = (jj < 0 || jj > 128) ? 0.f : rel[rel_bucket(jj * dil) * 28 + 16 + j] * LOG2E;
        }
        for (int o = gw; o < NLAYER * 2 * 64; o += NGW) {
            const int lk = o >> 6, e = o & 63; const float* pos = args.in[5] + (size_t)lk * 2048; const float* wv = args.in[6] + (size_t)lk * 2048 * 64;
            float s = 0.f;
            for (int k = lane; k < 2048; k += 64) s += pos[k] * wv[(size_t)k * 64 + e];
            s = wave_sum(s);
            if (lane == 0) cmpb[o] = s;
        }
    }
    SEAM(0);

    constexpr int PH_LAYER = NCH * 4 + 3;
#pragma unroll 1
    for (int layer = 0; layer < NLAYER; ++layer) {
#pragma unroll 1
    for (int chk = 0; chk < NCH; ++chk) {
        const int lc = layer * NCH + chk;
        const int pb = 1 + layer * PH_LAYER + chk * 4;
#define LCVARS int lcp = lc; asm volatile("" : "+s"(lcp)); const int l = lcp / NCH, ch = lcp % NCH; const size_t row0 = (size_t)ch * T; const size_t lw = (size_t)l * (MP.w[1][0] - MP.w[0][0]); (void)row0; (void)lw; \
        const int G = gridDim.x, bx = blockIdx.x; (void)G; (void)bx; int tid = threadIdx.x; asm volatile("" : "+v"(tid)); const int lane = tid & 63; (void)lane;

        if (IN(pb + 0) && ((PHMASK >> 1) & 1)) { LCVARS
            const bf16* xbc = (const bf16*)(ws + MP.xb) + row0 * DM; const float* ssq1 = (const float*)(ws + MP.ssq1) + row0 * 16;
#pragma unroll 1
            for (int rep = 0; rep < ((DUP & 1) ? 2 : 1); ++rep)
            { pg8::GemmP1 g{xbc, (const bf16*)(ws + MP.w[0][W_IN] + lw), (const bf16*)(ws + MP.w[0][W_VT] + lw), }; pg8::P1Order<T> S; S.init(G, bx);
              EpiP1 E{ssq1, args.in[4] + (size_t)l * 6 * 64, ws};
              pg8::gemm_phase<EpiP1, pg8::GemmP1, pg8::P1Order<T>>(lds, g, S, E); }
        }
        SEAM(pb + 0);

        if (IN(pb + 1) && ((PHMASK >> 2) & 1)) { LCVARS
            const float* cmpb = (const float*)(ws + MP.cmpb); const float* qkg = args.in[4] + (size_t)l * 6 * 64;
            { pg8::Gemm g{(const bf16*)(ws + MP.bkc), (const bf16*)(ws + MP.w[0][W_CK] + lw), NBC * 2 * 256, 256, 2048, 1024, 2048}; pg8::StaticOrder S; S.init(NBC * 2 * 256, 256, G, (bx < 64 && (bx & 7) == 0) ? (bx >> 3) : (1 << 20));
              EpiCmpK E{cmpb + (l * 2 + 0) * 64, qkg + 3 * 64, (bf16*)(ws + MP.kcmp)}; pg8::gemm_phase<EpiCmpK>(lds, g, S, E); }
            { pg8::Gemm g{(const bf16*)(ws + MP.w[0][W_CV] + lw), (const bf16*)(ws + MP.bvc), 256, NBC * 2 * 256, 2048, 2048, 1024}; pg8::StaticOrder S; S.init(256, NBC * 2 * 256, G, (bx < 64 && (bx & 7) == 2) ? (bx >> 3) : (1 << 20));
              EpiCmpV E{cmpb + (l * 2 + 1) * 64, (bf16*)(ws + MP.vcmpt)}; pg8::gemm_phase<EpiCmpV>(lds, g, S, E); }
            LAS float* tabA = (LAS float*)(lds + P2_TABA); LAS float* tabC = (LAS float*)(lds + P2_TABC);
            __syncthreads();
            { const f32x4* biasA = (const f32x4*)(ws + MP.biasA); constexpr int NA4 = 8 * TABS / 4;
              f32x4 va[(NA4 + 511) / 512];
#pragma unroll
              for (int q = 0; q < (NA4 + 511) / 512; ++q) { const int i = tid + 512 * q; va[q] = biasA[i < NA4 ? i : NA4 - 1]; }
#pragma unroll
              for (int q = 0; q < (NA4 + 511) / 512; ++q) { const int i = tid + 512 * q; if (i < NA4) ((LAS f32x4*)tabA)[i] = va[q]; } }
            __syncthreads();
            Ctx X{ws}; GWVARS
            unsigned char* kcache = (bx & 255) < 128 ? ws + MP.mb + (size_t)(NTOK / 2) * 1024 * 2 + (size_t)(bx & 255) * 262144 : ws + MP.end + (size_t)((bx & 255) - 128) * 262144;
#pragma unroll 1
            for (int rep = 0; rep < ((DUP & 2) ? 2 : 1); ++rep) {
            if ((DUP & 4096) && rep == 1) xcd_barrier(bar);
            if (MK_MIXERS & 2) {
                for (int pr0 = bx; pr0 < 64 * NBC; pr0 += G) {
                    int pr = pr0;
                    if (G == 256 && NBC == 4) { const int x = pr0 & 7, r = pr0 >> 3; pr = ((x >> 1) << 6) | ((x & 1) << 5) | r; }
                    const int bl = pr >> 6, i = pr & 63;
                    mixA_unit(X, lds, kcache, bl, i, tid);
                    mixA_unit(X, lds, kcache, bl, 127 - i, tid);
                }
            } }
            __syncthreads();
            { const f32x4* biasC = (const f32x4*)(ws + MP.biasC); constexpr int NC4 = 12 * TABC / 4;
              f32x4 vc[(NC4 + 511) / 512];
#pragma unroll
              for (int q = 0; q < (NC4 + 511) / 512; ++q) { const int i = tid + 512 * q; vc[q] = biasC[i < NC4 ? i : NC4 - 1]; }
#pragma unroll
              for (int q = 0; q < (NC4 + 511) / 512; ++q) { const int i = tid + 512 * q; if (i < NC4) ((LAS f32x4*)tabC)[i] = vc[q]; } }
            __syncthreads();
            if (MK_MIXERS & 1) {
                constexpr int nq = 12 * (T / 256);
#pragma unroll 1
                for (int repc = 0; repc < ((DUP & 4) ? 2 : 1); ++repc) {
                unsigned* qctr = ctl + CW_QUEUE + 64 * lcp + 16 * repc;
                LAS unsigned* tkw = (LAS unsigned*)(lds + MISC_OFF + 64);
                if (tid == 0) *tkw = __hip_atomic_fetch_add(qctr, 1u, __ATOMIC_RELAXED, __HIP_MEMORY_SCOPE_AGENT);
                __syncthreads();
                unsigned cur = *tkw;
#pragma unroll 1
                while (cur < (unsigned)nq) {
                    __syncthreads();
                    unsigned nxt = 0u;
                    if (tid == 0) nxt = __hip_atomic_fetch_add(qctr, 1u, __ATOMIC_RELAXED, __HIP_MEMORY_SCOPE_AGENT);
                    mixC_ticket(X, lds, tabC, (int)cur / (T / 256), (int)cur % (T / 256), tid);
                    if (tid == 0) *tkw = nxt;
                    __syncthreads();
                    cur = *tkw;
                }
                __syncthreads();
                }
            }
            __syncthreads();
        }
        SEAM(pb + 1);

        if (IN(pb + 2) && ((PHMASK >> 3) & 1)) { LCVARS
            LAS float* tabB = (LAS float*)(lds + P3_TABB);
            __syncthreads();
            { const f32x4* biasB = (const f32x4*)(ws + MP.biasB); constexpr int NB4 = 8 * TABS / 4;
              f32x4 vb[(NB4 + 511) / 512];
#pragma unroll
              for (int q = 0; q < (NB4 + 511) / 512; ++q) { const int i = tid + 512 * q; vb[q] = biasB[i < NB4 ? i : NB4 - 1]; }
#pragma unroll
              for (int q = 0; q < (NB4 + 511) / 512; ++q) { const int i = tid + 512 * q; if (i < NB4) ((LAS f32x4*)tabB)[i] = vb[q]; } }
            __syncthreads();
            Ctx X{ws}; GWVARS
#pragma unroll 1
            for (int rep = 0; rep < ((DUP & 8) ? 2 : 1); ++rep)
            if (MK_MIXERS & 4) {
                for (int pr0 = bx; pr0 < 64 * NBC; pr0 += G) {
                    int pr = pr0;
                    if (G == 256 && NBC == 4) pr = ((pr0 & 7) << 5) | (pr0 >> 3);
                    const int bgp = pr >> 5, i = pr & 31, bl = bgp >> 1, g = bgp & 1;
                    mixB_unit(X, lds, bl, g, i, tid);
                    mixB_unit(X, lds, bl, g, 63 - i, tid);
                }
            }
            if (MK_MIXERS & 1) mixC_combine(X, gw, NGW, lane);
            __syncthreads();
        }
        SEAM(pb + 2);

        if (IN(pb + 3) && ((PHMASK >> 4) & 1)) { LCVARS
#pragma unroll 1
            for (int jj = 0; jj < ((DUP & 16) ? 6 : 3); ++jj) {
                const int j = jj % 3;
                const int Kb = j == 2 ? 256 : 512;
                const bf16* Ao = (const bf16*)(ws + (j == 0 ? MP.oa : (j == 1 ? MP.ob : MP.oc)));
                pg8::Gemm g{Ao, (const bf16*)(ws + MP.w[0][W_BA] + lw + (size_t)j * (MP.w[0][W_BB] - MP.w[0][W_BA])), T, DM, Kb, Kb, Kb}; pg8::StaticOrder S; S.init(T, DM, G, bx);
                EpiBranch E{(const unsigned char*)(ws + MP.mixg) + j * 1024, (bf16*)(ws + MP.mb) + row0 * DM, j == 0 ? 1 : 0};
                pg8::gemm_phase<EpiBranch>(lds, g, S, E);
            }
        }
        SEAM(pb + 3);
    }

        const int pf = 1 + layer * PH_LAYER + NCH * 4;
#define LVARS int lp = layer; asm volatile("" : "+s"(lp)); const int l = lp; const size_t lw = (size_t)l * (MP.w[1][0] - MP.w[0][0]); (void)lw; \
        const int G = gridDim.x, bx = blockIdx.x; (void)G; (void)bx; int tid = threadIdx.x; asm volatile("" : "+v"(tid)); (void)tid;
        if (IN(pf + 0) && ((PHMASK >> 5) & 1)) { LVARS
            pg8::Gemm g{(const bf16*)(ws + MP.mb), (const bf16*)(ws + MP.w[0][W_OUT] + lw), NTOK, DM, DM, DM, DM}; pg8::StaticOrder S; S.init(NTOK, DM, G, bx);
#pragma unroll 1
            for (int rep = ((DUP & 1024) ? 0 : 1); rep < 2; ++rep) {
            EpiRes E{(bf16*)(ws + MP.xb), nullptr, (float*)(ws + MP.ssq2), rep == 0 ? 1 : 0};
            pg8::gemm_phase<EpiRes>(lds, g, S, E); }
        }
        SEAM(pf + 0);

        if (IN(pf + 1) && ((PHMASK >> 6) & 1)) { LVARS
            pg8::Gemm g{(const bf16*)(ws + MP.xb), (const bf16*)(ws + MP.w[0][W_FI] + lw), NTOK, N_FF2, DM, DM, DM}; pg8::StaticOrder S; S.init(NTOK, N_FF2, G, bx);
            EpiSwiGLU E{(const float*)(ws + MP.ssq2), (bf16*)(ws + MP.hid)};
#pragma unroll 1
            for (int rep = 0; rep < ((DUP & 32) ? 2 : 1); ++rep)
            pg8::gemm_phase<EpiSwiGLU>(lds, g, S, E);
        }
        SEAM(pf + 1);

        if (IN(pf + 2) && ((PHMASK >> 7) & 1)) { LVARS
            pg8::Gemm g{(const bf16*)(ws + MP.hid), (const bf16*)(ws + MP.w[0][W_FO] + lw), NTOK, DM, DFF, DFF, DFF}; pg8::StaticOrder S; S.init(NTOK, DM, G, bx);
#pragma unroll 1
            for (int rep = ((DUP & 2048) ? 0 : 1); rep < 2; ++rep) {
            EpiRes E{(bf16*)(ws + MP.xb), l == NLAYER - 1 ? args.out : nullptr, (float*)(ws + MP.ssq1), rep == 0 ? 1 : 0};
            pg8::gemm_phase<EpiRes>(lds, g, S, E); }
        }
        SEAM(pf + 2);
    }
#undef IN
#undef SEAM
#undef LCVARS
#undef LVARS
#undef GWVARS
}

extern "C" void kernel_launch(void* const* d_in, const int* in_sizes, int n_in, void* d_out, int out_size, void* d_ws, size_t ws_size, hipStream_t stream) {
    static int grid = 0;
    if (grid == 0) {
        int dev = 0, cus = 0;
        if (hipGetDevice(&dev) != hipSuccess || hipDeviceGetAttribute(&cus, hipDeviceAttributeMultiprocessorCount, dev) != hipSuccess) { fprintf(stderr, "kernel_launch: device query failed\n"); grid = -1; return; }
        if (hipFuncSetAttribute((const void*)mk_fwd, hipFuncAttributeMaxDynamicSharedMemorySize, LDS_BYTES) != hipSuccess) { fprintf(stderr, "kernel_launch: hipFuncSetAttribute failed\n"); grid = -1; return; }
        (void)hipGetLastError();
        if (n_in != 14 || out_size != NTOK * DM || MP.end + (size_t)128 * 262144 > ws_size) { fprintf(stderr, "kernel_launch: unexpected problem (n_in %d, out %d, ws %zu, need %zu)\n", n_in, out_size, ws_size, (size_t)MP.end); grid = -1; return; }
        grid = cus < 256 ? cus : 256;
    }
    if (grid < 0) return;
    (void)hipMemsetAsync((char*)d_ws, 0, MiB, stream);
    Args a{};
    for (int i = 0; i < 14; ++i) a.in[i] = (const float*)d_in[i];
    a.out = (float*)d_out; a.ws = (unsigned char*)d_ws; a.nbc = NBC; a.li = 0;
    constexpr int nph = 1 + NLAYER * (NCH * 4 + 3);
#if MK_SINGLE
    a.ph_lo = 0; a.ph_hi = nph;
    hipLaunchKernelGGL(mk_fwd, dim3(grid), dim3(NWAVES * 64), LDS_BYTES, stream, a);
#else
    for (int p = 0; p < nph; ++p) { a.ph_lo = p; a.ph_hi = p + 1; hipLaunchKernelGGL(mk_fwd, dim3(grid), dim3(NWAVES * 64), LDS_BYTES, stream, a); }
#endif
    const hipError_t le = hipPeekAtLastError();
    if (le != hipSuccess) fprintf(stderr, "kernel_launch: launch failed: %s\n", hipGetErrorName(le));
}
```

```cpp
#include <hip/hip_runtime.h>
#include <cstdio>
#include <cstdint>

#ifndef MK_SINGLE
#define MK_SINGLE 1
#endif
#ifndef DUP
#define DUP 0
#endif
#ifndef PHMASK
#define PHMASK 0xff
#define DUPA 0
#endif
#ifndef MK_MIXERS
#define MK_MIXERS 7
#endif

#define GAS __attribute__((address_space(1)))
#define LAS __attribute__((address_space(3)))
typedef unsigned short bf16;
typedef short bf16x8 __attribute__((ext_vector_type(8)));
typedef float f32x4 __attribute__((ext_vector_type(4)));
typedef float f32x2 __attribute__((ext_vector_type(2)));
typedef float f32x16 __attribute__((ext_vector_type(16)));
typedef unsigned u32x4 __attribute__((ext_vector_type(4)));
typedef unsigned u32x2 __attribute__((ext_vector_type(2)));
typedef short s16x4_t __attribute__((ext_vector_type(4)));
typedef short v4i16_t __attribute__((ext_vector_type(4)));

constexpr int BATCH = 8, SEQ = 4096, DM = 1024, NTOK = BATCH * SEQ, DFF = 2816, NLAYER = 2, IN_TOTAL = 7644;
constexpr int N_MAIN = 6656, N_VT = 1280, N_FF2 = 5632;
constexpr float NEPS = 1e-6f, LOG2E = 1.4426950408889634f, QSCALE = 0.125f * LOG2E;
constexpr int TABS = 1668;
constexpr int TABC = 192;

typedef __bf16 bf16x2_t __attribute__((ext_vector_type(2)));
__device__ __forceinline__ unsigned cvt_pk_bf16(float lo, float hi) { const f32x2 v = {lo, hi}; return __builtin_bit_cast(unsigned, __builtin_convertvector(v, bf16x2_t)); }
__device__ __forceinline__ unsigned f2bf(float f) { unsigned u = __builtin_bit_cast(unsigned, f); return (u + 0x7fffu + ((u >> 16) & 1u)) >> 16; }
__device__ __forceinline__ unsigned pk2(float lo, float hi) { return f2bf(lo) | (f2bf(hi) << 16); }
__device__ __forceinline__ float bflo(unsigned w) { return __builtin_bit_cast(float, w << 16); }
__device__ __forceinline__ float bfhi(unsigned w) { return __builtin_bit_cast(float, w & 0xffff0000u); }
__device__ __forceinline__ float fsigmoid(float v) { return __builtin_amdgcn_rcpf(1.f + __builtin_amdgcn_exp2f(-v * LOG2E)); }
__device__ __forceinline__ float partner32(float v, int hh) { const auto r = __builtin_amdgcn_permlane32_swap(__float_as_uint(v), __float_as_uint(v), false, false); return __uint_as_float(hh ? r[0] : r[1]); }
__device__ __forceinline__ float xsum1(float v) { return v + __int_as_float(__builtin_amdgcn_update_dpp(0, __float_as_int(v), 0xB1, 0xf, 0xf, false)); }
__device__ __forceinline__ float xsum2(float v) { return v + __int_as_float(__builtin_amdgcn_update_dpp(0, __float_as_int(v), 0x4E, 0xf, 0xf, false)); }
__device__ __forceinline__ unsigned wave_prefix_u32(unsigned v) {
    v += (unsigned)__builtin_amdgcn_update_dpp(0, (int)v, 0x111, 0xf, 0xf, false);
    v += (unsigned)__builtin_amdgcn_update_dpp(0, (int)v, 0x112, 0xf, 0xf, false);
    v += (unsigned)__builtin_amdgcn_update_dpp(0, (int)v, 0x114, 0xf, 0xf, false);
    v += (unsigned)__builtin_amdgcn_update_dpp(0, (int)v, 0x118, 0xf, 0xf, false);
    v += (unsigned)__builtin_amdgcn_update_dpp(0, (int)v, 0x142, 0xa, 0xf, false);
    v += (unsigned)__builtin_amdgcn_update_dpp(0, (int)v, 0x143, 0xc, 0xf, false);
    return v;
}
__device__ __forceinline__ int rdlane(int v, int l) { return __builtin_amdgcn_readlane(v, l); }
__device__ __forceinline__ float xsum16(float v) { const auto r = __builtin_amdgcn_permlane16_swap(__float_as_uint(v), __float_as_uint(v), false, false); return __uint_as_float(r[0]) + __uint_as_float(r[1]); }
__device__ __forceinline__ float xsum32(float v) { const auto r = __builtin_amdgcn_permlane32_swap(__float_as_uint(v), __float_as_uint(v), false, false); return __uint_as_float(r[0]) + __uint_as_float(r[1]); }

namespace pg8 {
constexpr int BM = 256, BK = 64, HALF = 128, HTB = HALF * BK * 2, STAGE_BYTES = 8 * HTB, NXCD = 8, WGM = 8;
__host__ __device__ __forceinline__ int lds_byte(int r, int c) { const int st = (r >> 4) * 2 + (c >> 5), rr = r & 15, cc = c & 31, ob = rr * 64 + cc * 2; return st * 1024 + (ob ^ (((ob >> 9) & 1) << 5)); }
__host__ __device__ __forceinline__ void stage_rc(int b, int& R, int& C) { const int st = b / 1024, sb = b % 1024, swz = sb ^ (((sb >> 9) & 1) << 5); R = (st >> 1) * 16 + swz / 64; C = (st & 1) * 32 + (swz % 64) / 2; }
__host__ __device__ __forceinline__ int perm32(int rho) { const int n = rho >> 4, i = rho & 15; return 8 * (i >> 2) + 4 * n + (i & 3); }

struct Unit { int pm, pn, w; };
struct Gemm { const bf16* A; const bf16* Bt; int M, N, K, lda, ldb_;
    __device__ __forceinline__ const char* aptr(const Unit& u) const { return (const char*)A + (size_t)u.pm * BM * lda * 2; }
    __device__ __forceinline__ const char* bptr(const Unit& u) const { return (const char*)Bt + (size_t)u.pn * BM * ldb_ * 2; }
    __device__ __forceinline__ int ldb(const Unit&) const { return ldb_; }
};
struct GemmP1 { const bf16* xb; const bf16* win; const bf16* wvt; static constexpr int K = 1024, lda = 1024;
    __device__ __forceinline__ const char* aptr(const Unit& u) const {
        if (u.w == 0) return (const char*)xb + (size_t)u.pm * BM * 1024 * 2;
        const int rb = u.w == 1 ? 0 : (u.w == 2 ? 768 : 1024);
        return (const char*)wvt + ((size_t)rb + (size_t)u.pm * BM) * 1024 * 2; }
    __device__ __forceinline__ const char* bptr(const Unit& u) const {
        if (u.w == 0) return (const char*)win + (size_t)u.pn * BM * 1024 * 2;
        const int dil = u.w == 1 ? 1 : (u.w == 2 ? 4 : 16);
        const int p0 = (u.pn & 15) * 256, bl = u.pn >> 4, L = SEQ / dil, r = p0 / L, n0 = p0 % L;
        return (const char*)xb + ((size_t)bl * SEQ + r + (size_t)dil * n0) * 1024 * 2; }
    __device__ __forceinline__ int ldb(const Unit& u) const { return u.w <= 1 ? 1024 : (u.w == 2 ? 4096 : 16384); }
};
struct StaticOrder {
    int nM, nN, nwg, G, c;
    __host__ __device__ void init(int M, int N, int G_, int c_) { nM = M / BM; nN = N / BM; nwg = nM * nN; G = G_; c = c_; }
    __host__ __device__ void map(int L, Unit& u) const {
        int wgid = L; { const int q = nwg / NXCD, r = nwg % NXCD, xcd = wgid % NXCD, off = wgid / NXCD; wgid = (xcd < r ? xcd * (q + 1) : r * (q + 1) + (xcd - r) * q) + off; }
        const int nig = WGM * nN, gid = wgid / nig, fm = gid * WGM, gsz = (nM - fm) < WGM ? (nM - fm) : WGM;
        u.pm = fm + ((wgid % nig) % gsz); u.pn = (wgid % nig) / gsz; u.w = 0; }
    __host__ __device__ bool next(int i, Unit& u) const { const long L = (long)i * G + c; if (L >= nwg) return false; map((int)L, u); return true; }
};
template <int T>
struct P1Order {
    static constexpr int ntn = T / BM, nwg0 = ntn * (N_MAIN / BM);
    int G, c;
    __host__ __device__ void init(int G_, int c_) { G = G_; c = c_; }
    __host__ __device__ bool next(int i, Unit& u) const {
        const int L = i * G + c;
        if (L < nwg0) { StaticOrder so; so.nM = ntn; so.nN = N_MAIN / BM; so.nwg = nwg0; so.G = G; so.c = c; so.map(L, u); return true; }
        const int q = L - nwg0;
        if (q < 3 * ntn) { u.w = 1; u.pm = q % 3; u.pn = q / 3; return true; }
        if (q < 5 * ntn) { const int q2 = q - 3 * ntn; u.w = 2 + q2 / ntn; u.pm = 0; u.pn = q2 % ntn; return true; }
        return false; }
};

template <class Epi, class GD = Gemm, class Sched = StaticOrder>
__device__ __forceinline__ void gemm_phase(LAS unsigned char* lds, const GD g, const Sched& S, const Epi& E) {
    int tid = threadIdx.x; asm volatile("" : "+v"(tid));
    const int wid = __builtin_amdgcn_readfirstlane(tid >> 6), lane = tid & 63, wr = wid >> 2, wc = wid & 3, fr = lane & 15, fq = lane >> 4;
    const int K = g.K, nt = K / BK;
    unsigned voffA[2], voffB[2];
#pragma unroll
    for (int i = 0; i < 2; ++i) { int R, C; stage_rc(tid * 16 + i * 8192, R, C); voffA[i] = (unsigned)(R * g.lda + C) * 2u; }
#define PG8_VOFFB(ldb_) do { int _t = tid; asm volatile("" : "+v"(_t)); _Pragma("unroll") for (int _i = 0; _i < 2; ++_i) { int R, C; stage_rc(_t * 16 + _i * 8192, R, C); \
        const int Rb = (R & ~31) + perm32(R & 31); voffB[_i] = (unsigned)(Rb * (ldb_) + C) * 2u; } } while (0)
    const size_t kstep = (size_t)(BK * 2);
    const size_t hsA = (size_t)HALF * g.lda * 2;
    const unsigned ldsw = (unsigned)wid * 1024u;
    const int aoff = lds_byte(wr * 64 + fr, fq * 8), boff = lds_byte(wc * 32 + fr, fq * 8);
#define PG8_SA(b, h) (((b) * 2 + (h)) * HTB)
#define PG8_SB(b, h) ((4 + (b) * 2 + (h)) * HTB)
#define PG8_STAGE(bufoff, gbase, voff) do { _Pragma("unroll") for (int _i = 0; _i < 2; ++_i) \
        __builtin_amdgcn_global_load_lds((const unsigned*)((const char*)(gbase) + (voff)[_i]), (LAS unsigned*)(lds + (bufoff) + ldsw + _i * 8192), 16, 0, 0); } while (0)
#define PG8_LDA(dst, b, h) do { _Pragma("unroll") for (int m = 0; m < 4; ++m) _Pragma("unroll") for (int k = 0; k < 2; ++k) dst[m][k] = *(const LAS bf16x8*)(lds + PG8_SA(b, h) + aoff + m * 2048 + k * 1024); } while (0)
#define PG8_LDB(dst, b, h) do { _Pragma("unroll") for (int n = 0; n < 2; ++n) _Pragma("unroll") for (int k = 0; k < 2; ++k) dst[n][k] = *(const LAS bf16x8*)(lds + PG8_SB(b, h) + boff + n * 2048 + k * 1024); } while (0)
#define PG8_MMA(ai, bj, At, Bt) do { __builtin_amdgcn_s_setprio(1); _Pragma("unroll") for (int m = 0; m < 4; ++m) _Pragma("unroll") for (int n = 0; n < 2; ++n) _Pragma("unroll") for (int k = 0; k < 2; ++k) \
        acc[ai][bj][m][n] = __builtin_amdgcn_mfma_f32_16x16x32_bf16(Bt[n][k], At[m][k], acc[ai][bj][m][n], 0, 0, 0); __builtin_amdgcn_s_setprio(0); } while (0)
#define PG8_WAIT_V(n) asm volatile("s_waitcnt vmcnt(" #n ")" ::: "memory")
#define PG8_WAIT_L(n) asm volatile("s_waitcnt lgkmcnt(" #n ")" ::: "memory")
#define PG8_BAR __builtin_amdgcn_s_barrier()
#define PG8_SCHED __builtin_amdgcn_sched_barrier(0)
    Unit cur, nxt; int ui = 0;
    if (!S.next(0, cur)) return;
    f32x4 acc[2][2][4][2];
#pragma unroll
    for (int a = 0; a < 2; ++a)
#pragma unroll
        for (int b = 0; b < 2; ++b)
#pragma unroll
            for (int m = 0; m < 4; ++m)
#pragma unroll
                for (int n = 0; n < 2; ++n) acc[a][b][m][n] = (f32x4){0.f, 0.f, 0.f, 0.f};
    bf16x8 At[4][2], B0[2][2], B1[2][2];
    const char* cA = g.aptr(cur); const char* cB = g.bptr(cur);
    int ldbc = g.ldb(cur); size_t hsB = (size_t)HALF * ldbc * 2;
    PG8_VOFFB(ldbc);
    PG8_STAGE(PG8_SB(0, 0), cB, voffB); PG8_STAGE(PG8_SB(0, 1), cB + hsB, voffB); PG8_STAGE(PG8_SA(0, 0), cA, voffA); PG8_STAGE(PG8_SA(0, 1), cA + hsA, voffA);
    if (wr == 1) PG8_BAR;
    PG8_WAIT_V(2); PG8_BAR;
    PG8_STAGE(PG8_SB(1, 0), cB + kstep, voffB); PG8_STAGE(PG8_SA(1, 0), cA + kstep, voffA); PG8_STAGE(PG8_SB(1, 1), cB + hsB + kstep, voffB);
    PG8_WAIT_V(6); PG8_BAR;
    for (;;) {
        const bool has_next = S.next(ui + 1, nxt);
        const char* nA = has_next ? g.aptr(nxt) : cA; const char* nB = has_next ? g.bptr(nxt) : cB;
        const int ldbn = has_next ? g.ldb(nxt) : ldbc;
        for (int t = 0; t < nt; t += 2) {
            const bool last = (t == nt - 2);
            if (last && ldbn != ldbc) { ldbc = ldbn; hsB = (size_t)HALF * ldbc * 2; PG8_VOFFB(ldbc); }
            const char* a1 = cA + (size_t)(t + 1) * kstep;
            const char* a2 = last ? nA : cA + (size_t)(t + 2) * kstep; const char* b2 = last ? nB : cB + (size_t)(t + 2) * kstep;
            const char* a3 = a2 + kstep; const char* b3 = b2 + kstep;
            PG8_LDB(B0, 0, 0); PG8_LDB(B1, 0, 1); PG8_SCHED; PG8_LDA(At, 0, 0); PG8_STAGE(PG8_SA(1, 1), a1 + hsA, voffA);
            PG8_WAIT_V(8); PG8_WAIT_L(0); PG8_BAR; PG8_MMA(0, 0, At, B0); PG8_MMA(0, 1, At, B1); PG8_BAR; PG8_SCHED;
            PG8_LDA(At, 0, 1); PG8_STAGE(PG8_SB(0, 0), b2, voffB); PG8_STAGE(PG8_SB(0, 1), b2 + hsB, voffB); PG8_STAGE(PG8_SA(0, 0), a2, voffA);
            PG8_WAIT_V(8); PG8_WAIT_L(0); PG8_BAR; PG8_MMA(1, 0, At, B0); PG8_MMA(1, 1, At, B1); PG8_BAR; PG8_SCHED;
            PG8_LDB(B0, 1, 0); PG8_LDB(B1, 1, 1); PG8_SCHED; PG8_LDA(At, 1, 0); PG8_STAGE(PG8_SA(0, 1), a2 + hsA, voffA);
            PG8_WAIT_V(8); PG8_WAIT_L(0); PG8_BAR; PG8_MMA(0, 0, At, B0); PG8_MMA(0, 1, At, B1); PG8_BAR; PG8_SCHED;
            PG8_LDA(At, 1, 1); PG8_STAGE(PG8_SB(1, 0), b3, voffB); PG8_STAGE(PG8_SB(1, 1), b3 + hsB, voffB); PG8_STAGE(PG8_SA(1, 0), a3, voffA);
            PG8_WAIT_V(8); PG8_WAIT_L(0); PG8_BAR; PG8_MMA(1, 0, At, B0); PG8_MMA(1, 1, At, B1); PG8_BAR; PG8_SCHED;
        }
        if (wr == 0) PG8_BAR;
        E(acc, cur, wr, wc, fr, fq);
        if (!has_next) break;
#pragma unroll
        for (int a = 0; a < 2; ++a)
#pragma unroll
            for (int b = 0; b < 2; ++b)
#pragma unroll
                for (int m = 0; m < 4; ++m)
#pragma unroll
                    for (int n = 0; n < 2; ++n) acc[a][b][m][n] = (f32x4){0.f, 0.f, 0.f, 0.f};
        cur = nxt; cA = nA; cB = nB; ++ui;
        if (wr == 1) PG8_BAR;
    }
    PG8_WAIT_V(0);
    PG8_BAR;
#undef PG8_VOFFB
#undef PG8_SA
#undef PG8_SB
#undef PG8_STAGE
#undef PG8_LDA
#undef PG8_LDB
#undef PG8_MMA
#undef PG8_WAIT_V
#undef PG8_WAIT_L
#undef PG8_BAR
#undef PG8_SCHED
}
}
typedef f32x4 AccT[2][2][4][2];

constexpr size_t MiB = 1u << 20;
struct WSMap {
    size_t ctl, biasA, biasB, biasC, cmpb, w[NLAYER][10], xb, ssq1, ssq2;
    size_t aq, ak, av, iq, ik, misc, bq, bkc, bvc, bks, bkw, cq, ck, mixg, avt, bvst, bvwt, cvt, kcmp, vcmpt, oa, ob, oc, cgo, cgl, mb, hid, end;
};
enum { W_IN = 0, W_VT, W_BA, W_BB, W_BC, W_OUT, W_FI, W_FO, W_CK, W_CV };
__host__ __device__ constexpr WSMap make_map(int nbc) {
    WSMap m{}; size_t o = 0;
    m.ctl = o; o += MiB;
    m.biasA = o; o += 64 * 1024; m.biasB = o; o += 64 * 1024; m.biasC = o; o += 16 * 1024; m.cmpb = o; o += 16 * 1024;
    o = 2 * MiB;
    const size_t wsz[10] = {(size_t)N_MAIN * 1024 * 2, (size_t)N_VT * 1024 * 2, 1024 * 512 * 2, 1024 * 512 * 2, 1024 * 256 * 2, 1024 * 1024 * 2, (size_t)N_FF2 * 1024 * 2, (size_t)1024 * DFF * 2, 256 * 2048 * 2, 256 * 2048 * 2};
    for (int l = 0; l < NLAYER; ++l) for (int i = 0; i < 10; ++i) { m.w[l][i] = o; o += wsz[i]; }
    o = (o + MiB - 1) / MiB * MiB;
    m.xb = o; o += (size_t)NTOK * DM * 2;
    m.ssq1 = o; o += (size_t)NTOK * 16 * 4; m.ssq2 = o; o += (size_t)NTOK * 16 * 4;
    m.mb = o; o += (size_t)NTOK * 1024 * 2;
    const size_t chunk0 = o;
    const size_t T = (size_t)nbc * SEQ;
    m.aq = o; o += T * 512 * 2; m.ak = o; m.av = o + 128; o += T * 128 * 2;        m.iq = o; o += T * 256 * 2; m.ik = o; o += T * 64 * 2; m.misc = o; o += T * 32 * 4;
    m.bq = o; o += T * 512 * 2; m.bkc = o; o += T * 128 * 2 + 4096; m.bvc = o; o += T * 128 * 2 + 4096; m.bks = o; o += T * 128 * 2; m.bkw = o; o += T * 128 * 2;
    m.cq = o; o += T * 768 * 2; m.ck = o; o += T * 768 * 2; m.mixg = o; o += T * 3072;
    m.avt = o; o += T * 64 * 2; m.bvst = o; o += T * 128 * 2; m.bvwt = o; o += T * 128 * 2; m.cvt = o; o += T * 768 * 2;
    m.kcmp = o; o += (size_t)nbc * 2 * 256 * 64 * 2; m.vcmpt = o; o += (size_t)nbc * 2 * 256 * 64 * 2;
    m.oa = o; o += T * 512 * 2; m.ob = o; o += T * 512 * 2; m.oc = o; o += T * 256 * 2;
    m.cgo = o; o += T * 768 * 2; m.cgl = o; o += T * 12 * 4;
    m.hid = chunk0;
    if (o < chunk0 + (size_t)NTOK * DFF * 2) o = chunk0 + (size_t)NTOK * DFF * 2;
    m.end = o;
    return m;
}

constexpr int NBC = 4, NCH = BATCH / NBC, TCH = NBC * SEQ;
constexpr WSMap MP = make_map(NBC);

#define XB_TMO      128
#define XB_XCNT(j)  (256  + 64 * (j))
#define XB_XSUB(j)  (1280 + 64 * (j))
#define XB_XGEN(j)  (2304 + 64 * (j))
#define XB_TOP      3328
#define XB_TOPGEN   3392
#define XCD_BAR_WORDS 3456
#define XB_SPIN_CAP (1u << 21)
__device__ __forceinline__ unsigned xb_ld(unsigned* p)              { return __hip_atomic_load(p, __ATOMIC_RELAXED, __HIP_MEMORY_SCOPE_AGENT); }
__device__ __forceinline__ unsigned xb_add(unsigned* p, unsigned v) { return __hip_atomic_fetch_add(p, v, __ATOMIC_RELAXED, __HIP_MEMORY_SCOPE_AGENT); }
__device__ __forceinline__ unsigned xb_xcc_id() { return (unsigned)__builtin_amdgcn_s_getreg((3 << 11) | 20) & 0xFu; }
#define XB_SPIN(cond, bar) do { unsigned _sp = 0; while (cond) { __builtin_amdgcn_s_sleep(1); \
    if ((++_sp & 255u) == 0u) { if (xb_ld(&(bar)[XB_TMO])) break; if (_sp > XB_SPIN_CAP) { atomicAdd(&(bar)[XB_TMO], 1u); break; } } } } while (0)
struct XcdBarrier { unsigned* bar; unsigned x; volatile LAS unsigned* st; };
__device__ __forceinline__ XcdBarrier xcd_barrier_post(unsigned* bar, volatile LAS unsigned* st) {
    XcdBarrier b; b.bar = bar; b.x = xb_xcc_id(); b.st = st;
    if (threadIdx.x == 0) (void)xb_add(&bar[XB_XCNT(b.x)], 1u);
    return b;
}
__device__ __forceinline__ void xcd_barrier_complete(unsigned* bar, unsigned x, unsigned& nloc, unsigned& nx) {
    const unsigned G = gridDim.x * gridDim.y * gridDim.z;
    unsigned sum, cnt, mine, sp = 0u;
    for (;;) {
        sum = 0u; cnt = 0u; mine = 0u;
#pragma unroll
        for (unsigned j = 0; j < 16; ++j) { const unsigned c = xb_ld(&bar[XB_XCNT(j)]); sum += c; cnt += (c > 0u) ? 1u : 0u; mine = (j == x) ? c : mine; }
        if (sum == G) break;
        __builtin_amdgcn_s_sleep(1);
        if ((++sp & 255u) == 0u) { if (xb_ld(&bar[XB_TMO])) break; if (sp > XB_SPIN_CAP) { atomicAdd(&bar[XB_TMO], 1u); break; } }
    }
    nloc = mine > 0u ? mine : 1u; nx = cnt > 0u ? cnt : 1u;
}
__device__ __forceinline__ void xcd_barrier(const XcdBarrier& b) {
    asm volatile("s_waitcnt vmcnt(0)" ::: "memory");
    __syncthreads();
    if (threadIdx.x == 0) {
        unsigned* bar = b.bar;
        __builtin_amdgcn_s_waitcnt(0);
        unsigned nloc = b.st[0], nx = b.st[1];
        if (nloc == 0u) { xcd_barrier_complete(bar, b.x, nloc, nx); b.st[0] = nloc; b.st[1] = nx; }
        const unsigned old = xb_add(&bar[XB_XSUB(b.x)], 1u);
        const unsigned gen = old / nloc;
        if (old + 1u == (gen + 1u) * nloc) {
            __builtin_amdgcn_fence(__ATOMIC_RELEASE, "agent");
            asm volatile("s_waitcnt vmcnt(0)" ::: "memory");
            const unsigned og = xb_add(&bar[XB_TOP], 1u);
            const unsigned tg = og / nx;
            if (og + 1u == (tg + 1u) * nx) xb_add(&bar[XB_TOPGEN], 1u);
            else XB_SPIN(xb_ld(&bar[XB_TOPGEN]) == tg, bar);
            __builtin_amdgcn_fence(__ATOMIC_ACQUIRE, "agent");
            xb_add(&bar[XB_XGEN(b.x)], 1u);
            asm volatile("s_waitcnt vmcnt(0)" ::: "memory");
        } else {
            XB_SPIN(xb_ld(&bar[XB_XGEN(b.x)]) == gen, bar);
            __builtin_amdgcn_fence(__ATOMIC_ACQUIRE, "agent");
            asm volatile("s_waitcnt vmcnt(0)" ::: "memory");
        }
    }
    __syncthreads();
}

struct Args {
    const float* in[14];
    float* out; unsigned char* ws; int ph_lo, ph_hi, nbc, li;
};

__device__ __forceinline__ int rowmap_p(int t, int rm) { return rm == 0 ? t : (rm == 1 ? (((t & 3) << 10) | (t >> 2)) : (((t & 15) << 8) | (t >> 4))); }

struct EpiIn {
    const float* ssq; const float* qkg; unsigned char* ws;
    __device__ __forceinline__ void operator()(const AccT& acc, const pg8::Unit& u, int wr, int wc, int fr, int fq) const {
        constexpr int T = TCH;
        bf16 *aq = (bf16*)(ws + MP.aq), *ak = (bf16*)(ws + MP.ak), *iq = (bf16*)(ws + MP.iq), *ik = (bf16*)(ws + MP.ik), *bq = (bf16*)(ws + MP.bq), *bkc = (bf16*)(ws + MP.bkc), *bvc = (bf16*)(ws + MP.bvc),
             *bks = (bf16*)(ws + MP.bks), *bkw = (bf16*)(ws + MP.bkw), *cq = (bf16*)(ws + MP.cq), *ck = (bf16*)(ws + MP.ck), *mixg = (bf16*)(ws + MP.mixg); float* misc = (float*)(ws + MP.misc);
        const int s = 4 * u.pn + wc;
        int gain = -1, sig = 0, rm = 0, pitch = 64; float scale = 1.f; bf16* base; size_t bstr = (size_t)SEQ * 64;
        if (s < 8) { base = aq + 64 * s; pitch = 512; bstr = (size_t)SEQ * 512; gain = 0; scale = QSCALE; }
        else if (s == 8) { base = ak; gain = 1; pitch = 128; bstr = (size_t)SEQ * 128; }
        else if (s < 13) { base = iq + 64 * (s - 9); pitch = 256; bstr = (size_t)SEQ * 256; }
        else if (s == 13) { base = ik; }
        else if (s == 14) { base = nullptr; }
        else if (s < 23) { base = bq + 64 * (s - 15); pitch = 512; bstr = (size_t)SEQ * 512; gain = 2; scale = QSCALE; }
        else if (s < 25) { base = bkc + (size_t)(s - 23) * SEQ * 64; bstr = (size_t)2 * SEQ * 64; }
        else if (s < 27) { base = bvc + (size_t)(s - 25) * SEQ * 64; bstr = (size_t)2 * SEQ * 64; }
        else if (s < 29) { base = bks + (size_t)(s - 27) * SEQ * 64; bstr = (size_t)2 * SEQ * 64; gain = 3; }
        else if (s < 31) { base = bkw + (size_t)(s - 29) * SEQ * 64; bstr = (size_t)2 * SEQ * 64; gain = 3; }
        else if (s < 43) { base = cq + (size_t)(s - 31) * T * 64; gain = 4; scale = QSCALE; rm = (s - 31) >> 2; }
        else if (s < 55) { base = ck + (size_t)(s - 43) * T * 64; gain = 5; rm = (s - 43) >> 2; }
        else if (s < 103) { base = mixg; sig = 1; }
        else { base = (bf16*)(ws + MP.av); pitch = 128; bstr = (size_t)SEQ * 128; }
        f32x4 gv[2][2];
        if (gain >= 0) {
#pragma unroll
            for (int bj = 0; bj < 2; ++bj)
#pragma unroll
                for (int n = 0; n < 2; ++n) gv[bj][n] = *(const f32x4*)(qkg + gain * 64 + 32 * bj + 8 * fq + 4 * n) * scale;
        }
        float rsv[2][4];
        { f32x4 pq[2][4];
#pragma unroll
          for (int ai = 0; ai < 2; ++ai)
#pragma unroll
              for (int m = 0; m < 4; ++m) pq[ai][m] = *(const f32x4*)(ssq + (size_t)(u.pm * 256 + 128 * ai + 64 * wr + 16 * m + fr) * 16 + 4 * fq);
          __builtin_amdgcn_sched_barrier(0);
#pragma unroll
          for (int ai = 0; ai < 2; ++ai)
#pragma unroll
              for (int m = 0; m < 4; ++m) { const f32x4 p = pq[ai][m]; float sm = (p[0] + p[1]) + (p[2] + p[3]); sm = xsum16(sm); sm = xsum32(sm); rsv[ai][m] = __builtin_amdgcn_rsqf(sm * (1.f / DM) + NEPS); } }
        if (sig) rows<0>(acc, u, wr, fr, fq, rsv, s, base, pitch, bstr, rm, gv, misc, mixg);
        else if (s == 14) rows<1>(acc, u, wr, fr, fq, rsv, s, base, pitch, bstr, rm, gv, misc, mixg);
        else if (gain >= 0) rows<2>(acc, u, wr, fr, fq, rsv, s, base, pitch, bstr, rm, gv, misc, mixg);
        else rows<3>(acc, u, wr, fr, fq, rsv, s, base, pitch, bstr, rm, gv, misc, mixg);
    }
    template <int MODE>
    __device__ __forceinline__ void rows(const AccT& acc, const pg8::Unit& u, int wr, int fr, int fq, const float (&rsv)[2][4], int s, bf16* base, int pitch, size_t bstr, int rm,
                                         const f32x4 (&gv)[2][2], float* misc, bf16* mixg) const {
#pragma unroll
        for (int ai = 0; ai < 2; ++ai)
#pragma unroll
            for (int m = 0; m < 4; ++m) {
                const int tl = u.pm * 256 + 128 * ai + 64 * wr + 16 * m + fr;
                const float rs = rsv[ai][m];
                f32x4 v[2][2];
#pragma unroll
                for (int bj = 0; bj < 2; ++bj)
#pragma unroll
                    for (int n = 0; n < 2; ++n) v[bj][n] = acc[ai][bj][m][n] * rs;
                if (MODE == 1) {
#pragma unroll
                    for (int n = 0; n < 2; ++n) { f32x4 o = v[0][n];
#pragma unroll
                        for (int j = 0; j < 4; ++j) { const int col = 8 * fq + 4 * n + j; if (col >= 4) o[j] = fsigmoid(o[j]); }
                        *(f32x4*)(misc + (size_t)tl * 32 + 8 * fq + 4 * n) = o; }
                    continue;
                }
                if (MODE == 2) {
                    float ss = 0.f;
#pragma unroll
                    for (int bj = 0; bj < 2; ++bj)
#pragma unroll
                        for (int n = 0; n < 2; ++n) ss += (v[bj][n][0] * v[bj][n][0] + v[bj][n][1] * v[bj][n][1]) + (v[bj][n][2] * v[bj][n][2] + v[bj][n][3] * v[bj][n][3]);
                    ss = xsum16(ss); ss = xsum32(ss);
                    const float inv = __builtin_amdgcn_rsqf(ss * (1.f / 64.f) + NEPS);
#pragma unroll
                    for (int bj = 0; bj < 2; ++bj)
#pragma unroll
                        for (int n = 0; n < 2; ++n) v[bj][n] = v[bj][n] * inv * gv[bj][n];
                }
                if (MODE == 0) {
                    unsigned q[2][2]; const float rsn = -rs * LOG2E;
#pragma unroll
                    for (int bj = 0; bj < 2; ++bj)
#pragma unroll
                        for (int n = 0; n < 2; ++n) { unsigned w4 = 0u;
#pragma unroll
                            for (int j = 0; j < 4; ++j) w4 = __builtin_amdgcn_cvt_pk_u8_f32(__builtin_amdgcn_rcpf(1.f + __builtin_amdgcn_exp2f(acc[ai][bj][m][n][j] * rsn)) * 255.f, j, w4);
                            q[bj][n] = w4; }
                    const auto ra = __builtin_amdgcn_permlane16_swap(q[0][0], q[1][0], false, false), rb = __builtin_amdgcn_permlane16_swap(q[0][1], q[1][1], false, false);
                    u32x4 w; w.x = ra[0]; w.y = rb[0]; w.z = ra[1]; w.w = rb[1];
                    __builtin_nontemporal_store(w, (u32x4*)((unsigned char*)mixg + (size_t)tl * 3072 + 64 * (s - 55) + ((fq & 1) ? 32 + 8 * (fq - 1) : 8 * fq)));
                    continue;
                }
                const int bl = tl >> 12, t = tl & (SEQ - 1), p = rowmap_p(t, rm);
                bf16* rowp = base + (size_t)bl * bstr + (size_t)p * pitch + 8 * fq;
#pragma unroll
                for (int bj = 0; bj < 2; ++bj) { u32x4 w; w.x = cvt_pk_bf16(v[bj][0][0], v[bj][0][1]); w.y = cvt_pk_bf16(v[bj][0][2], v[bj][0][3]); w.z = cvt_pk_bf16(v[bj][1][0], v[bj][1][1]); w.w = cvt_pk_bf16(v[bj][1][2], v[bj][1][3]);
                    *(u32x4*)(rowp + 32 * bj) = w; }
            }
    }
};

struct EpiVT {
    const float* ssq; unsigned char* ws; int call, dil;
    __device__ __forceinline__ void operator()(const AccT& acc, const pg8::Unit& u, int wr, int wc, int fr, int fq) const {
        constexpr int T = TCH;
        bf16 *avt = (bf16*)(ws + MP.avt), *bvst = (bf16*)(ws + MP.bvst), *bvwt = (bf16*)(ws + MP.bvwt), *cvt = (bf16*)(ws + MP.cvt);
        float rs;
        {
            const int bj = fr >> 3, n = (fr >> 2) & 1, j = fr & 3;
            const int pc = u.pn * 256 + 128 * bj + 32 * wc + 8 * fq + 4 * n + j;
            const int bl = pc >> 12, p = pc & (SEQ - 1), L = SEQ / dil, t = dil * (p & (L - 1)) + p / L;
            const float* q = ssq + ((size_t)bl * SEQ + t) * 16;
            const f32x4 a = *(const f32x4*)q, b = *(const f32x4*)(q + 4), c = *(const f32x4*)(q + 8), d = *(const f32x4*)(q + 12);
            const float s = ((a[0] + a[1]) + (a[2] + a[3])) + ((b[0] + b[1]) + (b[2] + b[3])) + ((c[0] + c[1]) + (c[2] + c[3])) + ((d[0] + d[1]) + (d[2] + d[3]));
            rs = __builtin_amdgcn_rsqf(s * (1.f / DM) + NEPS);
        }
        const int lane = fq * 16 + fr;
#pragma unroll
        for (int bj = 0; bj < 2; ++bj) {
            const int pc0 = u.pn * 256 + 128 * bj + 32 * wc;
            const int bl = pc0 >> 12, pp = pc0 & (SEQ - 1);
            float r4[2][4];
#pragma unroll
            for (int n = 0; n < 2; ++n)
#pragma unroll
                for (int j = 0; j < 4; ++j) r4[n][j] = __shfl(rs, (lane & 48) | (bj * 8 + n * 4 + j));
#pragma unroll
            for (int ai = 0; ai < 2; ++ai) {
                const int hb = (u.pm * 256 + 128 * ai + 64 * wr) >> 6;
                bf16* base; bool perkv = false;
                if (call == 0) {
                    if (hb == 0) base = avt;
                    else if (hb < 3) { base = bvst + (size_t)(hb - 1) * SEQ * 64; perkv = true; }
                    else if (hb < 5) { base = bvwt + (size_t)(hb - 3) * SEQ * 64; perkv = true; }
                    else if (hb < 9) base = cvt + (size_t)(hb - 5) * T * 64;
                    else continue;
                } else base = cvt + (size_t)(4 * call + hb) * T * 64;
                const size_t off = perkv ? ((size_t)bl * 2 * SEQ * 64 + (size_t)(pp >> 6) * 4096) : ((size_t)(pc0 >> 6) * 4096);
                bf16* tp = base + off + (pp & 32) + 16 * (fq >> 1) + 8 * (fq & 1) + fr * 64;
#pragma unroll
                for (int m = 0; m < 4; ++m) { const f32x4 a0 = acc[ai][bj][m][0], a1 = acc[ai][bj][m][1];
                    const unsigned w0x = cvt_pk_bf16(a0[0] * r4[0][0], a0[1] * r4[0][1]), w0y = cvt_pk_bf16(a0[2] * r4[0][2], a0[3] * r4[0][3]);
                    const unsigned w1x = cvt_pk_bf16(a1[0] * r4[1][0], a1[1] * r4[1][1]), w1y = cvt_pk_bf16(a1[2] * r4[1][2], a1[3] * r4[1][3]);
                    const auto rx = __builtin_amdgcn_permlane16_swap(w0x, w1x, false, false), ry = __builtin_amdgcn_permlane16_swap(w0y, w1y, false, false);
                    u32x4 w; w.x = rx[0]; w.y = ry[0]; w.z = rx[1]; w.w = ry[1];
                    *(u32x4*)(tp + m * 16 * 64) = w; }
            }
        }
    }
};
struct EpiP1 {
    const float* ssq; const float* qkg; unsigned char* ws;
    __device__ __forceinline__ void operator()(const AccT& acc, const pg8::Unit& u, int wr, int wc, int fr, int fq) const {
        if (u.w == 0) { const EpiIn E{ssq, qkg, ws}; E(acc, u, wr, wc, fr, fq); }
        else { const EpiVT E{ssq, ws, u.w - 1, u.w == 1 ? 1 : (u.w == 2 ? 4 : 16)}; E(acc, u, wr, wc, fr, fq); }
    }
};
struct EpiCmpK {
    const float* cb; const float* gain; bf16* kcmp;
    __device__ __forceinline__ void operator()(const AccT& acc, const pg8::Unit& u, int wr, int wc, int fr, int fq) const {
        if (wc != 0) return;
        f32x4 cbv[2][2], gv[2][2];
#pragma unroll
        for (int bj = 0; bj < 2; ++bj)
#pragma unroll
            for (int n = 0; n < 2; ++n) { cbv[bj][n] = *(const f32x4*)(cb + 32 * bj + 8 * fq + 4 * n); gv[bj][n] = *(const f32x4*)(gain + 32 * bj + 8 * fq + 4 * n); }
#pragma unroll
        for (int ai = 0; ai < 2; ++ai)
#pragma unroll
            for (int m = 0; m < 4; ++m) {
                const int row = u.pm * 256 + 128 * ai + 64 * wr + 16 * m + fr;
                f32x4 v[2][2]; float ss = 0.f;
#pragma unroll
                for (int bj = 0; bj < 2; ++bj)
#pragma unroll
                    for (int n = 0; n < 2; ++n) { v[bj][n] = acc[ai][bj][m][n] + cbv[bj][n]; ss += (v[bj][n][0] * v[bj][n][0] + v[bj][n][1] * v[bj][n][1]) + (v[bj][n][2] * v[bj][n][2] + v[bj][n][3] * v[bj][n][3]); }
                ss = xsum16(ss); ss = xsum32(ss);
                const float inv = __builtin_amdgcn_rsqf(ss * (1.f / 64.f) + NEPS);
#pragma unroll
                for (int bj = 0; bj < 2; ++bj) { const f32x4 a = v[bj][0] * inv * gv[bj][0], b = v[bj][1] * inv * gv[bj][1];
                    u32x4 w; w.x = cvt_pk_bf16(a[0], a[1]); w.y = cvt_pk_bf16(a[2], a[3]); w.z = cvt_pk_bf16(b[0], b[1]); w.w = cvt_pk_bf16(b[2], b[3]);
                    *(u32x4*)(kcmp + (size_t)row * 64 + 32 * bj + 8 * fq) = w; }
            }
    }
};
struct EpiCmpV {
    const float* cb; bf16* vcmpt;
    __device__ __forceinline__ void operator()(const AccT& acc, const pg8::Unit& u, int wr, int wc, int fr, int fq) const {
        if (wr != 0) return;
#pragma unroll
        for (int m = 0; m < 4; ++m) {
            const int e = 16 * m + fr; const float c = cb[e];
#pragma unroll
            for (int bj = 0; bj < 2; ++bj) {
                bf16* tp = vcmpt + (size_t)u.pn * 64 * 256 + e * 256 + 128 * bj + 32 * wc + 16 * (fq >> 1) + 4 * (fq & 1);
#pragma unroll
                for (int n = 0; n < 2; ++n) { const f32x4 a = acc[0][bj][m][n];
                    u32x2 w; w.x = cvt_pk_bf16(a[0] + c, a[1] + c); w.y = cvt_pk_bf16(a[2] + c, a[3] + c);
                    *(u32x2*)(tp + 8 * n) = w; }
            }
        }
    }
};
struct EpiBranch {
    const unsigned char* gate; bf16* mb; int first;
    __device__ __forceinline__ void operator()(const AccT& acc, const pg8::Unit& u, int wr, int wc, int fr, int fq) const {
#pragma unroll
        for (int ai = 0; ai < 2; ++ai) {
            u32x2 gr[4][2]; u32x4 orr[4][2];
#pragma unroll
            for (int m = 0; m < 4; ++m)
#pragma unroll
                for (int bj = 0; bj < 2; ++bj) {
                    const int row = u.pm * 256 + 128 * ai + 64 * wr + 16 * m + fr, col = u.pn * 256 + 128 * bj + 32 * wc + 8 * fq;
                    gr[m][bj] = *(const u32x2*)(gate + (size_t)row * 3072 + col);
                    if (first != 1) orr[m][bj] = *(const u32x4*)(mb + (size_t)row * 1024 + col);
                }
            __builtin_amdgcn_sched_barrier(0);
#pragma unroll
            for (int m = 0; m < 4; ++m) {
                const int row = u.pm * 256 + 128 * ai + 64 * wr + 16 * m + fr;
#pragma unroll
                for (int bj = 0; bj < 2; ++bj) {
                    const int col = u.pn * 256 + 128 * bj + 32 * wc + 8 * fq;
                    const u32x2 g = gr[m][bj];
                    bf16* mp = mb + (size_t)row * 1024 + col;
                    constexpr float k = 1.f / 255.f;
                    f32x4 a = acc[ai][bj][m][0], b = acc[ai][bj][m][1];
                    a[0] *= (float)(g.x & 0xff) * k; a[1] *= (float)((g.x >> 8) & 0xff) * k; a[2] *= (float)((g.x >> 16) & 0xff) * k; a[3] *= (float)(g.x >> 24) * k;
                    b[0] *= (float)(g.y & 0xff) * k; b[1] *= (float)((g.y >> 8) & 0xff) * k; b[2] *= (float)((g.y >> 16) & 0xff) * k; b[3] *= (float)(g.y >> 24) * k;
                    if (first != 1) { const u32x4 o = orr[m][bj];
                        a[0] += bflo(o.x); a[1] += bfhi(o.x); a[2] += bflo(o.y); a[3] += bfhi(o.y);
                        b[0] += bflo(o.z); b[1] += bfhi(o.z); b[2] += bflo(o.w); b[3] += bfhi(o.w); }
                    u32x4 w; w.x = cvt_pk_bf16(a[0], a[1]); w.y = cvt_pk_bf16(a[2], a[3]); w.z = cvt_pk_bf16(b[0], b[1]); w.w = cvt_pk_bf16(b[2], b[3]);
                    if (first == 2) __builtin_nontemporal_store(w, (u32x4*)mp); else *(u32x4*)mp = w;
                }
            }
        }
    }
};
struct EpiRes {
    bf16* xb; float* xout; float* ssq; int dry;
    __device__ __forceinline__ void operator()(const AccT& acc, const pg8::Unit& u, int wr, int wc, int fr, int fq) const {
#pragma unroll
        for (int ai = 0; ai < 2; ++ai) {
            u32x4 xr[4][2];
#pragma unroll
            for (int m = 0; m < 4; ++m)
#pragma unroll
                for (int bj = 0; bj < 2; ++bj) xr[m][bj] = *(const u32x4*)(xb + (size_t)(u.pm * 256 + 128 * ai + 64 * wr + 16 * m + fr) * DM + u.pn * 256 + 128 * bj + 32 * wc + 8 * fq);
            __builtin_amdgcn_sched_barrier(0);
#pragma unroll
            for (int m = 0; m < 4; ++m) {
                const int row = u.pm * 256 + 128 * ai + 64 * wr + 16 * m + fr; float ss = 0.f;
#pragma unroll
                for (int bj = 0; bj < 2; ++bj) {
                    const size_t o = (size_t)row * DM + u.pn * 256 + 128 * bj + 32 * wc + 8 * fq;
                    const u32x4 xo = xr[m][bj];
                    f32x4 a = acc[ai][bj][m][0], b = acc[ai][bj][m][1];
                    a[0] += bflo(xo.x); a[1] += bfhi(xo.x); a[2] += bflo(xo.y); a[3] += bfhi(xo.y);
                    b[0] += bflo(xo.z); b[1] += bfhi(xo.z); b[2] += bflo(xo.w); b[3] += bfhi(xo.w);
                    ss += (a[0] * a[0] + a[1] * a[1]) + (a[2] * a[2] + a[3] * a[3]) + (b[0] * b[0] + b[1] * b[1]) + (b[2] * b[2] + b[3] * b[3]);
                    if (!dry) {
                        if (xout) { __builtin_nontemporal_store(a, (f32x4*)(xout + o)); __builtin_nontemporal_store(b, (f32x4*)(xout + o + 4)); }
                        else { u32x4 w; w.x = cvt_pk_bf16(a[0], a[1]); w.y = cvt_pk_bf16(a[2], a[3]); w.z = cvt_pk_bf16(b[0], b[1]); w.w = cvt_pk_bf16(b[2], b[3]); *(u32x4*)(xb + o) = w; }
                    }
                }
                ss = xsum16(ss); ss = xsum32(ss);
                if (fq == 0 && !dry) ssq[(size_t)row * 16 + 4 * u.pn + wc] = ss;
            }
        }
    }
};
struct EpiSwiGLU {
    const float* ssq; bf16* hid;
    __device__ __forceinline__ void operator()(const AccT& acc, const pg8::Unit& u, int wr, int wc, int fr, int fq) const {
        float rsv[2][4];
        { f32x4 pq[2][4];
#pragma unroll
          for (int ai = 0; ai < 2; ++ai)
#pragma unroll
              for (int m = 0; m < 4; ++m) pq[ai][m] = *(const f32x4*)(ssq + (size_t)(u.pm * 256 + 128 * ai + 64 * wr + 16 * m + fr) * 16 + 4 * fq);
          __builtin_amdgcn_sched_barrier(0);
#pragma unroll
          for (int ai = 0; ai < 2; ++ai)
#pragma unroll
              for (int m = 0; m < 4; ++m) { const f32x4 p = pq[ai][m]; float sm = (p[0] + p[1]) + (p[2] + p[3]); sm = xsum16(sm); sm = xsum32(sm); rsv[ai][m] = __builtin_amdgcn_rsqf(sm * (1.f / DM) + NEPS); } }
#pragma unroll
        for (int ai = 0; ai < 2; ++ai)
#pragma unroll
            for (int m = 0; m < 4; ++m) {
                const int row = u.pm * 256 + 128 * ai + 64 * wr + 16 * m + fr;
                const float rs = rsv[ai][m];
                float h[8];
#pragma unroll
                for (int n = 0; n < 2; ++n)
#pragma unroll
                    for (int j = 0; j < 4; ++j) { const float g = acc[ai][0][m][n][j] * rs, up = acc[ai][1][m][n][j] * rs; h[4 * n + j] = g * fsigmoid(g) * up; }
                u32x4 w; w.x = cvt_pk_bf16(h[0], h[1]); w.y = cvt_pk_bf16(h[2], h[3]); w.z = cvt_pk_bf16(h[4], h[5]); w.w = cvt_pk_bf16(h[6], h[7]);
                *(u32x4*)(hid + (size_t)row * DFF + u.pn * 128 + 32 * wc + 8 * fq) = w;
            }
    }
};

__host__ __device__ constexpr int nitm_of(int q) { return q == 0 ? 16 * (N_MAIN / 32) : q == 1 ? 16 * (N_VT / 32) : (q == 2 || q == 3) ? 8 * 32 : q == 4 ? 4 * 32 : q == 5 ? 16 * 32 : q == 6 ? 16 * (N_FF2 / 32) : q == 7 ? (DFF / 64) * 32 : 32 * 8; }
__host__ __device__ constexpr int ord_of(int p) { return p < 5 ? p : (p < 7 ? p + 3 : p - 2); }
constexpr int NF = nitm_of(0) + nitm_of(1) + nitm_of(2) + nitm_of(3) + nitm_of(4) + nitm_of(8) + nitm_of(9);
constexpr int NL = nitm_of(0) + nitm_of(1) + nitm_of(2) + nitm_of(3) + nitm_of(4) + nitm_of(5) + nitm_of(6) + nitm_of(7) + nitm_of(8) + nitm_of(9);
__device__ __forceinline__ int main_src(int row) {
    const int s = 4 * (row >> 8) + ((row & 127) >> 5), col = 32 * ((row & 255) >> 7) + (row & 31);
    if (s < 8) return 64 * s + col;
    if (s == 8) return 512 + col;
    if (s < 13) return 640 + 64 * (s - 9) + col;
    if (s == 13) return 896 + col;
    if (s == 14) return col < 4 ? 960 + col : (col < 28 ? 2244 + col - 4 : -1);
    if (s < 23) return 964 + 64 * (s - 15) + col;
    if (s < 25) return 1476 + 64 * (s - 23) + col;
    if (s < 27) return 1476 + 128 + 64 * (s - 25) + col;
    if (s < 29) return 1476 + 256 + 64 * (s - 27) + col;
    if (s < 31) return 1476 + 512 + 64 * (s - 29) + col;
    if (s < 43) return 2268 + 64 * (s - 31) + col;
    if (s < 55) return 3036 + 64 * (s - 43) + col;
    if (s < 103) return 4572 + 64 * (s - 55) + col;
    return 576 + col;
}
__device__ __forceinline__ int vt_src(int r) {
    if (r < 64) return 576 + r;
    if (r < 192) return 1860 + (r - 64);
    if (r < 320) return 2116 + (r - 192);
    if (r < 576) return 3804 + (r - 320);
    if (r < 768) return -1;
    return 3804 + 256 + (r - 768);
}
__device__ __forceinline__ int ffn_src(int row) { return ((row & 128) ? DFF : 0) + 128 * (row >> 8) + (row & 127 & ~31) + (row & 31); }
__device__ __forceinline__ void ti_load(const float* W, int Nsrc, int k0, int sc4c  , const float* gsrc  , int lane, f32x4 (&v)[8], float (&g)[8]) {
    const int kq = lane >> 3;
#pragma unroll
    for (int i = 0; i < 8; ++i) { const int kk = kq + 8 * i; v[i] = __builtin_nontemporal_load((const f32x4*)(W + (size_t)(k0 + kk) * Nsrc + sc4c)); g[i] = gsrc[(k0 + kk) & (DM - 1)]; }
}
__device__ __forceinline__ void ti_finish(const f32x4 (&v)[8], const float (&g)[8], int flags  , int K, bf16* WT, LAS float* scr, int k0, int n0, int lane) {
    const int kq = lane >> 3, n4 = lane & 7;
#pragma unroll
    for (int i = 0; i < 8; ++i) { const int kk = kq + 8 * i; const float gi = (flags & 2) ? 0.f : ((flags & 1) ? g[i] : 1.f);
#pragma unroll
        for (int j = 0; j < 4; ++j) scr[kk * 33 + 4 * n4 + j] = (flags & 2) ? 0.f : v[i][j] * gi; }
    asm volatile("s_waitcnt lgkmcnt(0)" ::: "memory");
    const int c = lane & 7;
#pragma unroll
    for (int j = 0; j < 4; ++j) { const int n = (lane >> 3) + 8 * j; const LAS float* s = scr + (8 * c) * 33 + n;
        u32x4 o; o.x = pk2(s[0 * 33], s[1 * 33]); o.y = pk2(s[2 * 33], s[3 * 33]); o.z = pk2(s[4 * 33], s[5 * 33]); o.w = pk2(s[6 * 33], s[7 * 33]);
        *(u32x4*)(WT + (size_t)(n0 + n) * K + k0 + 8 * c) = o; }
    asm volatile("s_waitcnt lgkmcnt(0)" ::: "memory");
}
__device__ __forceinline__ int rel_bucket(int n) {
    if (n < 16) return n < 0 ? 0 : n;
    const int lg = 16 + (int)(logf((float)n / 16.0f) / 4.852030263919617f * 16.0f);
    return lg < 31 ? lg : 31;
}
__device__ __forceinline__ float wave_sum(float v) {
    v = xsum1(v); v = xsum2(v);
    v += __int_as_float(__builtin_amdgcn_update_dpp(0, __float_as_int(v), 0x124, 0xf, 0xf, false));
    v += __int_as_float(__builtin_amdgcn_update_dpp(0, __float_as_int(v), 0x128, 0xf, 0xf, false));
    v = xsum16(v); v = xsum32(v);
    return v;
}

__device__ __forceinline__ f32x16 mfma32(bf16x8 a, bf16x8 b, f32x16 c) { return __builtin_amdgcn_mfma_f32_32x32x16_bf16(a, b, c, 0, 0, 0); }
__device__ __forceinline__ f32x4 mfma16(bf16x8 a, bf16x8 b, f32x4 c) { return __builtin_amdgcn_mfma_f32_16x16x32_bf16(a, b, c, 0, 0, 0); }
__device__ __forceinline__ f32x16 zero16() { f32x16 z;
#pragma unroll
    for (int i = 0; i < 16; ++i) z[i] = 0.f; return z; }
#define ROWC(reg) (((reg) & 3) + 8 * ((reg) >> 2))
__device__ __forceinline__ unsigned keep_le(int lim) { return lim < 0 ? 0u : (lim >= 31 ? 0xffffffffu : ((2u << lim) - 1u)); }
__device__ __forceinline__ unsigned keep_ge(int lo) { return lo <= 0 ? 0xffffffffu : (lo > 31 ? 0u : ~((1u << lo) - 1u)); }

template <int BIAS, int MASK>
__device__ __forceinline__ f32x16 acc_init(const LAS float* bt, float bc, unsigned keep) {
    f32x16 st;
#pragma unroll
    for (int r = 0; r < 16; ++r) {
        float b = BIAS == 1 ? bt[27 - ROWC(r)] : (BIAS == 2 ? bc : 0.f);
        if (MASK) { const int sel = MASK == 2 ? (int)keep : __builtin_amdgcn_sbfe((int)keep, ROWC(r), 1); b = __int_as_float(__builtin_amdgcn_bitop3_b32(__float_as_int(b), (int)0xc6ea6000, sel, 0xe4)); }
        st[r] = b;
    }
    return st;
}
__device__ __forceinline__ void exp_pack(const f32x16& st, bf16x8 (&pb)[2]) {
    float e[16];
#pragma unroll
    for (int r = 0; r < 16; ++r) e[r] = __builtin_amdgcn_exp2f(st[r]);
#pragma unroll
    for (int s = 0; s < 2; ++s) { u32x4 w; w.x = cvt_pk_bf16(e[8 * s + 0], e[8 * s + 1]); w.y = cvt_pk_bf16(e[8 * s + 2], e[8 * s + 3]); w.z = cvt_pk_bf16(e[8 * s + 4], e[8 * s + 5]); w.w = cvt_pk_bf16(e[8 * s + 6], e[8 * s + 7]);
        pb[s] = __builtin_bit_cast(bf16x8, w); }
}
__device__ __forceinline__ void exp_pack_sum(const f32x16& st, bf16x8 (&pb)[2], float& l) {
    float e[16];
#pragma unroll
    for (int r = 0; r < 16; ++r) { e[r] = __builtin_amdgcn_exp2f(st[r]); l += e[r]; }
#pragma unroll
    for (int s = 0; s < 2; ++s) { u32x4 w; w.x = cvt_pk_bf16(e[8 * s + 0], e[8 * s + 1]); w.y = cvt_pk_bf16(e[8 * s + 2], e[8 * s + 3]); w.z = cvt_pk_bf16(e[8 * s + 4], e[8 * s + 5]); w.w = cvt_pk_bf16(e[8 * s + 6], e[8 * s + 7]);
        pb[s] = __builtin_bit_cast(bf16x8, w); }
}
template <int BIAS, int MASK>
__device__ __forceinline__ void qks32_ls(const LAS bf16* krow, const bf16x8 (&qf)[4], const LAS float* bt, float bc, unsigned keep, bf16x8 (&pb)[2], float& l) {
    f32x16 st = acc_init<BIAS, MASK>(bt, bc, keep);
#pragma unroll
    for (int ks = 0; ks < 4; ++ks) { const bf16x8 kf = *(const LAS bf16x8*)(krow + 16 * ks); st = mfma32(kf, qf[ks], st); }
    exp_pack_sum(st, pb, l);
}
__device__ __forceinline__ bf16x8 ones_frag() { const u32x4 w = {0x3f803f80u, 0x3f803f80u, 0x3f803f80u, 0x3f803f80u}; return __builtin_bit_cast(bf16x8, w); }
struct Ctx {
    unsigned char* ws; static constexpr int T = TCH;
    __device__ __forceinline__ bf16* aq() const { return (bf16*)(ws + MP.aq); }
    __device__ __forceinline__ bf16* ak() const { return (bf16*)(ws + MP.ak); }
    __device__ __forceinline__ bf16* av() const { return (bf16*)(ws + MP.av); }
    __device__ __forceinline__ bf16* iq() const { return (bf16*)(ws + MP.iq); }
    __device__ __forceinline__ bf16* ik() const { return (bf16*)(ws + MP.ik); }
    __device__ __forceinline__ bf16* bq() const { return (bf16*)(ws + MP.bq); }
    __device__ __forceinline__ bf16* bks() const { return (bf16*)(ws + MP.bks); }
    __device__ __forceinline__ bf16* bkw() const { return (bf16*)(ws + MP.bkw); }
    __device__ __forceinline__ bf16* cq() const { return (bf16*)(ws + MP.cq); }
    __device__ __forceinline__ bf16* ck() const { return (bf16*)(ws + MP.ck); }
    __device__ __forceinline__ bf16* avt() const { return (bf16*)(ws + MP.avt); }
    __device__ __forceinline__ bf16* bvst() const { return (bf16*)(ws + MP.bvst); }
    __device__ __forceinline__ bf16* bvwt() const { return (bf16*)(ws + MP.bvwt); }
    __device__ __forceinline__ bf16* cvt() const { return (bf16*)(ws + MP.cvt); }
    __device__ __forceinline__ bf16* kcmp() const { return (bf16*)(ws + MP.kcmp); }
    __device__ __forceinline__ bf16* vcmpt() const { return (bf16*)(ws + MP.vcmpt); }
    __device__ __forceinline__ bf16* oa() const { return (bf16*)(ws + MP.oa); }
    __device__ __forceinline__ bf16* ob() const { return (bf16*)(ws + MP.ob); }
    __device__ __forceinline__ bf16* oc() const { return (bf16*)(ws + MP.oc); }
    __device__ __forceinline__ bf16* cgo() const { return (bf16*)(ws + MP.cgo); }
    __device__ __forceinline__ float* misc() const { return (float*)(ws + MP.misc); }
    __device__ __forceinline__ float* cgl() const { return (float*)(ws + MP.cgl); }
};

__device__ __forceinline__ void mixC_combine(const Ctx& X, int gw, int ngw, int lane) {
    const int nitem = X.T * 32;
#pragma unroll 1
    for (int idx0 = gw * 64 + lane; idx0 < nitem; idx0 += 4 * ngw * 64) {
        u32x4 a[4], b[4], c[4]; float l0[4], l1[4], l2[4];
#pragma unroll
        for (int k = 0; k < 4; ++k) {
            int idx = idx0 + k * ngw * 64; if (idx >= nitem) idx = nitem - 1;
            const int tl = idx >> 5, i = (idx >> 3) & 3, oct = idx & 7;
            const int bl = tl >> 12, t = tl & (SEQ - 1);
            const size_t r0 = (size_t)bl * SEQ + t, r1 = (size_t)bl * SEQ + rowmap_p(t, 1), r2 = (size_t)bl * SEQ + rowmap_p(t, 2);
            const size_t h0 = (size_t)i * X.T + r0, h1 = (size_t)(4 + i) * X.T + r1, h2 = (size_t)(8 + i) * X.T + r2;
            a[k] = *(const u32x4*)(X.cgo() + h0 * 64 + 8 * oct); b[k] = *(const u32x4*)(X.cgo() + h1 * 64 + 8 * oct); c[k] = *(const u32x4*)(X.cgo() + h2 * 64 + 8 * oct);
            l0[k] = X.cgl()[h0]; l1[k] = X.cgl()[h1]; l2[k] = X.cgl()[h2];
        }
#pragma unroll
        for (int k = 0; k < 4; ++k) {
            const int idx = idx0 + k * ngw * 64;
            if (idx < nitem) {
                const int tl = idx >> 5, i = (idx >> 3) & 3, oct = idx & 7;
                const float inv = 1.f / (l0[k] + l1[k] + l2[k]);
                u32x4 w;
                w.x = cvt_pk_bf16((bflo(a[k].x) + bflo(b[k].x) + bflo(c[k].x)) * inv, (bfhi(a[k].x) + bfhi(b[k].x) + bfhi(c[k].x)) * inv);
                w.y = cvt_pk_bf16((bflo(a[k].y) + bflo(b[k].y) + bflo(c[k].y)) * inv, (bfhi(a[k].y) + bfhi(b[k].y) + bfhi(c[k].y)) * inv);
                w.z = cvt_pk_bf16((bflo(a[k].z) + bflo(b[k].z) + bflo(c[k].z)) * inv, (bfhi(a[k].z) + bfhi(b[k].z) + bfhi(c[k].z)) * inv);
                w.w = cvt_pk_bf16((bflo(a[k].w) + bflo(b[k].w) + bflo(c[k].w)) * inv, (bfhi(a[k].w) + bfhi(b[k].w) + bfhi(c[k].w)) * inv);
                *(u32x4*)(X.oc() + (size_t)tl * 256 + 64 * i + 8 * oct) = w;
            }
        }
    }
}

__device__ __forceinline__ void idx_keys(const bf16* ikrow  , const bf16x8 (&iqf)[2], const float (&w)[4], int (&key)[4]) {
#pragma unroll
    for (int blk = 0; blk < 4; ++blk) {
        const bf16x8 b0 = *(const bf16x8*)(ikrow + blk * 16 * 64), b1 = *(const bf16x8*)(ikrow + blk * 16 * 64 + 32);
        f32x4 a = {0.f, 0.f, 0.f, 0.f};
        a = mfma16(iqf[0], b0, a); a = mfma16(iqf[1], b1, a);
        const float r0 = fmaxf(a[0], 0.f), r1 = fmaxf(a[1], 0.f), r2 = fmaxf(a[2], 0.f), r3 = fmaxf(a[3], 0.f);
        float sc = __builtin_fmaf(w[3], r3, __builtin_fmaf(w[2], r2, __builtin_fmaf(w[1], r1, w[0] * r0)));
        sc = fminf(fmaxf(sc, -524288.f), 524287.f);
        key[blk] = (int)sc;
    }
}
constexpr int TSTR = 72, TILE_LDS = 64 * TSTR * 2;
constexpr int TSTRI = 80, TILE_LDSI = 64 * TSTRI * 2;
__device__ __forceinline__ u32x4 tile_ld(const bf16* tile, int pitch, int tid) { return *(const u32x4*)(tile + (size_t)(tid >> 3) * pitch + (tid & 7) * 8); }
__device__ __forceinline__ void tile_st(LAS bf16* buf, int tid, u32x4 v) { *(LAS u32x4*)(buf + (tid >> 3) * TSTR + (tid & 7) * 8) = v; }
__device__ __forceinline__ void tile_sti(LAS bf16* buf, int tid, u32x4 v) { *(LAS u32x4*)(buf + (tid >> 3) * TSTRI + (tid & 7) * 8) = v; }
__device__ __forceinline__ f32x16 qk32_l(const LAS bf16* krow, const bf16x8 (&qf)[4]) {
    f32x16 st = zero16();
#pragma unroll
    for (int ks = 0; ks < 4; ++ks) { const bf16x8 kf = *(const LAS bf16x8*)(krow + 16 * ks); st = mfma32(kf, qf[ks], st); }
    return st;
}
__device__ __forceinline__ void pv32_l(f32x16 (&ot)[2], const LAS bf16* vb, const bf16x8 (&pb)[2]) {
#pragma unroll
    for (int db = 0; db < 2; ++db)
#pragma unroll
        for (int s = 0; s < 2; ++s) { const bf16x8 vf = *(const LAS bf16x8*)(vb + db * 32 * TSTR + 16 * s); ot[db] = mfma32(vf, pb[s], ot[db]); }
}
template <int BIAS, int MASK>
__device__ __forceinline__ void tile64_l(const LAS bf16* krow, const LAS bf16* vrow, const bf16x8 (&qf)[4], const LAS float* bt, float bc, unsigned keep0, unsigned keep1, f32x16 (&ot)[2], float& l) {
    f32x16 st0 = acc_init<BIAS, MASK>(bt, bc, keep0);
#pragma unroll
    for (int ks = 0; ks < 4; ++ks) { const bf16x8 kf = *(const LAS bf16x8*)(krow + 16 * ks); st0 = mfma32(kf, qf[ks], st0); }
    f32x16 st1 = acc_init<BIAS, MASK>(BIAS == 1 ? bt - 32 : bt, bc, keep1);
#pragma unroll
    for (int ks = 0; ks < 4; ++ks) { const bf16x8 kf = *(const LAS bf16x8*)(krow + 32 * TSTR + 16 * ks); st1 = mfma32(kf, qf[ks], st1); }
    bf16x8 pb0[2], pb1[2];
    exp_pack_sum(st0, pb0, l);
#pragma unroll
    for (int db = 0; db < 2; ++db)
#pragma unroll
        for (int s = 0; s < 2; ++s) { const bf16x8 vf = *(const LAS bf16x8*)(vrow + db * 32 * TSTR + 16 * s); ot[db] = mfma32(vf, pb0[s], ot[db]); }
    exp_pack_sum(st1, pb1, l);
#pragma unroll
    for (int db = 0; db < 2; ++db)
#pragma unroll
        for (int s = 0; s < 2; ++s) { const bf16x8 vf = *(const LAS bf16x8*)(vrow + 32 + db * 32 * TSTR + 16 * s); ot[db] = mfma32(vf, pb1[s], ot[db]); }
}
__device__ __forceinline__ void idx_keys_l(const LAS bf16* ikrow  , const bf16x8 (&iqf)[2], const float (&w)[4], int (&key)[4]) {
#pragma unroll
    for (int blk = 0; blk < 4; ++blk) {
        const bf16x8 b0 = *(const LAS bf16x8*)(ikrow + blk * 16 * TSTRI), b1 = *(const LAS bf16x8*)(ikrow + blk * 16 * TSTRI + 32);
        f32x4 a = {0.f, 0.f, 0.f, 0.f};
        a = mfma16(iqf[0], b0, a); a = mfma16(iqf[1], b1, a);
        const float a0 = a[0], a1 = a[1], a2 = a[2], a3 = a[3];
        const float r0 = __int_as_float(max(__float_as_int(a0), 0)), r1 = __int_as_float(max(__float_as_int(a1), 0)),
                    r2 = __int_as_float(max(__float_as_int(a2), 0)), r3 = __int_as_float(max(__float_as_int(a3), 0));
        float sc = __builtin_fmaf(w[3], r3, __builtin_fmaf(w[2], r2, __builtin_fmaf(w[1], r1, w[0] * r0)));
        sc = __builtin_amdgcn_fmed3f(sc, -524288.f, 524287.f);
        key[blk] = (int)sc;
    }
}
__device__ __forceinline__ void idx_frag_ld(const LAS bf16* ikrow, bf16x8 (&fr)[4][2]) {
#pragma unroll
    for (int blk = 0; blk < 4; ++blk) { fr[blk][0] = *(const LAS bf16x8*)(ikrow + blk * 16 * TSTRI); fr[blk][1] = *(const LAS bf16x8*)(ikrow + blk * 16 * TSTRI + 32); }
}
__device__ __forceinline__ void idx_keys_f(const bf16x8 (&fr)[4][2], const bf16x8 (&iqf)[2], const float (&w)[4], int (&key)[4]) {
    f32x4 a[4];
#pragma unroll
    for (int blk = 0; blk < 4; ++blk) { a[blk] = (f32x4){0.f, 0.f, 0.f, 0.f}; a[blk] = mfma16(iqf[0], fr[blk][0], a[blk]); }
#pragma unroll
    for (int blk = 0; blk < 4; ++blk) a[blk] = mfma16(iqf[1], fr[blk][1], a[blk]);
    __builtin_amdgcn_sched_barrier(0);
#pragma unroll
    for (int blk = 0; blk < 4; ++blk) {
        const float a0 = a[blk][0], a1 = a[blk][1], a2 = a[blk][2], a3 = a[blk][3];
        const float r0 = __int_as_float(max(__float_as_int(a0), 0)), r1 = __int_as_float(max(__float_as_int(a1), 0)),
                    r2 = __int_as_float(max(__float_as_int(a2), 0)), r3 = __int_as_float(max(__float_as_int(a3), 0));
        float sc = __builtin_fmaf(w[3], r3, __builtin_fmaf(w[2], r2, __builtin_fmaf(w[1], r1, __builtin_fmaf(w[0], r0, 32768.f))));
        sc = __builtin_amdgcn_fmed3f(sc, 0.f, 65535.f);
        key[blk] = (int)sc;
    }
}
constexpr int P2C_K = 16384, P2C_V = P2C_K + 384 * TSTR * 2, P2C_END = P2C_V + 384 * TSTR * 2;
__device__ __forceinline__ void mixC_ticket(const Ctx& X, LAS unsigned char* lds, const LAS float* tabC, int j, int tkq, int tid) {
    const int lane = tid & 63, wave = __builtin_amdgcn_readfirstlane(tid >> 6);
    const int g = j >> 2, dil = g == 0 ? 1 : (g == 1 ? 4 : 16), L = SEQ / dil;
    const int p0t = tkq * 256, bl = p0t >> 12, ppt = p0t & (SEQ - 1), ss = ppt & ~(L - 1), n0t = ppt & (L - 1);
    const size_t hb = (size_t)j * X.T;
    const int skip = n0t == 0 ? 128 : 0;
    const long rowb = (long)hb + (long)bl * SEQ + ss + n0t - 128;
    LAS bf16* Kl = (LAS bf16*)(lds + P2C_K); LAS bf16* Vl = (LAS bf16*)(lds + P2C_V);
    const int c = lane & 31, hh = lane >> 5;
    const int p = p0t + 32 * wave + c;
    bf16x8 qf[4];
    { const bf16* qrow = X.cq() + (hb + (size_t)p) * 64 + 8 * hh;
#pragma unroll
      for (int ks = 0; ks < 4; ++ks) qf[ks] = *(const bf16x8*)(qrow + 16 * ks); }
    u32x4 rk[6], rv[6];
#pragma unroll
    for (int i = 0; i < 6; ++i) {
        const int id = tid + 512 * i, row = id >> 3, ch = (id & 7) * 8;
        const int rr = row < skip ? skip : row;
        rk[i] = *(const u32x4*)(X.ck() + (rowb + rr) * 64 + ch);
        rv[i] = *(const u32x4*)(X.cvt() + (rowb + (rr & ~63)) * 64 + (size_t)(rr & 63) * 64 + ch);
    }
#pragma unroll
    for (int i = 0; i < 6; ++i) {
        const int id = tid + 512 * i, row = id >> 3, ch = (id & 7) * 8;
        *(LAS u32x4*)(Kl + row * TSTR + ch) = rk[i]; *(LAS u32x4*)(Vl + row * TSTR + ch) = rv[i];
    }
    __syncthreads();
    f32x16 ot[2] = {zero16(), zero16()}, lt = zero16();
    const int n0 = n0t + 32 * wave;
    const int kbf = n0 >= 128 ? 0 : 4 - (n0 >> 5);
#pragma unroll
    for (int kb = 0; kb < 5; ++kb) {
        if (kb < kbf) continue;
        const int r0 = 32 * (wave + kb);
        const LAS float* bt = tabC + j * TABC + 32 + (128 - 32 * kb + c - 4 * hh) - 27;
        f32x16 st = kb == 0 ? acc_init<1, 1>(bt, 0.f, keep_ge(c - 4 * hh)) : (kb == 4 ? acc_init<1, 1>(bt, 0.f, keep_le(c - 4 * hh)) : acc_init<1, 0>(bt, 0.f, 0u));
        const LAS bf16* krow = Kl + (r0 + c) * TSTR + 8 * hh;
#pragma unroll
        for (int ks = 0; ks < 4; ++ks) { const bf16x8 kf = *(const LAS bf16x8*)(krow + 16 * ks); st = mfma32(kf, qf[ks], st); }
        bf16x8 pb[2];
        exp_pack(st, pb);
        const LAS bf16* vb = Vl + ((r0 >> 6) * 64 + c) * TSTR + (r0 & 32) + 8 * hh;
#pragma unroll
        for (int db = 0; db < 2; ++db)
#pragma unroll
            for (int s2 = 0; s2 < 2; ++s2) { const bf16x8 vf = *(const LAS bf16x8*)(vb + db * 32 * TSTR + 16 * s2); ot[db] = mfma32(vf, pb[s2], ot[db]); }
        { const bf16x8 one = ones_frag(); lt = mfma32(one, pb[0], lt); lt = mfma32(one, pb[1], lt); }
    }
    const float l = lt[0];
    bf16* op = X.cgo() + (hb + (size_t)p) * 64 + 4 * hh;
#pragma unroll
    for (int db = 0; db < 2; ++db)
#pragma unroll
        for (int q4 = 0; q4 < 4; ++q4) { u32x2 w; w.x = cvt_pk_bf16(ot[db][4 * q4], ot[db][4 * q4 + 1]); w.y = cvt_pk_bf16(ot[db][4 * q4 + 2], ot[db][4 * q4 + 3]);
            *(u32x2*)(op + 32 * db + 8 * q4) = w; }
    if (hh == 0) X.cgl()[hb + (size_t)p] = l;
}
constexpr int P2_TABC = 0  , P2_IK1 = 65536, P2_TABA = 109056, P2_END = P2_TABA + 8 * TABS * 4;
static_assert(P2_IK1 + 4 * TILE_LDSI <= P2_TABA, "LDS map (DSA pass 1)");
constexpr int A_UTH = 20;
constexpr int A_WBUF = 2 * 32 * TSTR * 2, A_LIST = 8 * A_WBUF, A_LCAP = 440, A_LSTR = 5 * A_LCAP * 2, A_FILL = 352;
static_assert((A_FILL + 64 + 31) / 32 * 32 <= A_LCAP, "list capacity: a full tile after A_FILL entries, padded to whole blocks");
static_assert(A_LIST + 8 * A_LSTR <= P2_TABA && A_LSTR % 8 == 0, "LDS map (compacted DSA pass)");
__device__ __forceinline__ void mixA_unit(const Ctx& X, LAS unsigned char* lds, unsigned char* kcache  , int bl, int u, int tid) {
    const int lane = tid & 63, wave = __builtin_amdgcn_readfirstlane(tid >> 6);
    const LAS float* tabA = (const LAS float*)(lds + P2_TABA);
    LAS unsigned* hist = (LAS unsigned*)(lds + wave * 8192);
    const int t0 = 32 * u + 4 * wave;
    const size_t tok0 = (size_t)bl * SEQ + t0;
    const int qi = lane >> 4, kk = lane & 15, t = t0 + qi;
    bf16x8 iqf[2];
    { const int row = lane & 15, qa = row >> 2, ih = row & 3, kq = lane >> 4;
      const bf16* p = X.iq() + (tok0 + qa) * 256 + ih * 64 + 8 * kq;
      iqf[0] = *(const bf16x8*)p; iqf[1] = *(const bf16x8*)(p + 32); }
    float w[4];
    { const f32x4 wv = *(const f32x4*)(X.misc() + (tok0 + qi) * 32); w[0] = wv[0] * 512.f; w[1] = wv[1] * 512.f; w[2] = wv[2] * 512.f; w[3] = wv[3] * 512.f; }
    const int ktl = (32 * u + 31) >> 6;
    const bf16* ikg = X.ik() + (size_t)bl * SEQ * 64;
    const int ikoff = (lane & 15) * TSTRI + 8 * (lane >> 4);
    unsigned short* kcw8 = (unsigned short*)(kcache + wave * 32768) + 64 * qi + 4 * kk;
    const u32x2* kc = (const u32x2*)(kcache + wave * 32768) + lane;
    const bf16* kg = X.ak() + (size_t)bl * SEQ * 128;
    const bf16* vg = X.avt() + (size_t)bl * SEQ * 64;
    int lo = 0, need = t + 1 < 256 ? t + 1 : 256, ties = 0;
    u32x4 pf0 = tile_ld(ikg, 64, tid), pf1 = tile_ld(ikg + 4096, 64, tid);
#pragma unroll
    for (int i = 0; i < 4; ++i) *(LAS u32x4*)(hist + 4 * lane + 256 * i) = (u32x4){0u, 0u, 0u, 0u};
    tile_sti((LAS bf16*)(lds + P2_IK1), tid, pf0); tile_sti((LAS bf16*)(lds + P2_IK1 + TILE_LDSI), tid, pf1);
    __syncthreads();
#pragma unroll 1
    for (int rep0 = 0; rep0 < ((DUPA & 1) ? 2 : 1); ++rep0)
    {
        if ((DUPA & 1) && rep0 == 1) {
            pf0 = tile_ld(ikg, 64, tid); pf1 = tile_ld(ikg + 4096, 64, tid);
#pragma unroll
            for (int i = 0; i < 4; ++i) *(LAS u32x4*)(hist + 4 * lane + 256 * i) = (u32x4){0u, 0u, 0u, 0u};
            tile_sti((LAS bf16*)(lds + P2_IK1), tid, pf0); tile_sti((LAS bf16*)(lds + P2_IK1 + TILE_LDSI), tid, pf1);
            __syncthreads();
        }
        const int nst = (ktl >> 1) + 1;
#pragma unroll 1
        for (int st = 0; st < nst; ++st) {
            u32x4 rn0, rn1; const bool more = st + 1 < nst;
            if (more) { rn0 = tile_ld(ikg + (size_t)(2 * st + 2) * 4096, 64, tid); rn1 = tile_ld(ikg + (size_t)(2 * st + 3) * 4096, 64, tid); }
            bf16x8 fr[2][4][2];
            idx_frag_ld((const LAS bf16*)(lds + P2_IK1 + ((st & 1) * 2 + 0) * TILE_LDSI) + ikoff, fr[0]);
            idx_frag_ld((const LAS bf16*)(lds + P2_IK1 + ((st & 1) * 2 + 1) * TILE_LDSI) + ikoff, fr[1]);
            __builtin_amdgcn_sched_barrier(0);
#pragma unroll
            for (int h2 = 0; h2 < 2; ++h2) {
                const int kt = 2 * st + h2;
                int key[4]; idx_keys_f(fr[h2], iqf, w, key);
                {
                  const auto s0 = __builtin_amdgcn_permlane16_swap((unsigned)key[0], (unsigned)key[1], false, false), s1 = __builtin_amdgcn_permlane16_swap((unsigned)key[2], (unsigned)key[3], false, false);
                  const auto tA = __builtin_amdgcn_permlane32_swap(s0[0], s1[0], false, false), tB = __builtin_amdgcn_permlane32_swap(s0[1], s1[1], false, false);
                  u32x2 kw; kw.x = tA[0] | (tB[0] << 16); kw.y = tA[1] | (tB[1] << 16);
                  *(u32x2*)(kcw8 + 256 * kt) = kw; }
                if (kt < ktl) {
#pragma unroll
                    for (int blk = 0; blk < 4; ++blk) __hip_atomic_fetch_add(hist + qi * 256 + ((unsigned)key[blk] >> 8), 1u, __ATOMIC_RELAXED, __HIP_MEMORY_SCOPE_WORKGROUP);
                } else {
#pragma unroll
                    for (int blk = 0; blk < 4; ++blk) { const int sk = kt * 64 + 16 * blk + kk;
                        if (sk <= t) __hip_atomic_fetch_add(hist + qi * 256 + ((unsigned)key[blk] >> 8), 1u, __ATOMIC_RELAXED, __HIP_MEMORY_SCOPE_WORKGROUP); }
                }
            }
            if (more) { tile_sti((LAS bf16*)(lds + P2_IK1 + (((st + 1) & 1) * 2) * TILE_LDSI), tid, rn0); tile_sti((LAS bf16*)(lds + P2_IK1 + (((st + 1) & 1) * 2 + 1) * TILE_LDSI), tid, rn1); }
            __syncthreads();
        }
    }
    const bool compact = u >= A_UTH;
    if (!compact) { pf0 = tile_ld(kg, 128, tid); pf1 = tile_ld(vg, 64, tid); }
    int sv_lo = 0, sv_need = 0, sv_ties = 0, l1rep = 0;
#pragma unroll 1
    for (int lvl = 0; lvl < 2; ++lvl) {
        if ((DUPA & 8) && lvl == 1) { if (l1rep == 0) { sv_lo = lo; sv_need = need; sv_ties = ties; } else { lo = sv_lo; need = sv_need; ties = sv_ties; } }
        const int shift = lvl == 0 ? 8 : 0;
        if (lvl == 1) {
#pragma unroll
            for (int i = 0; i < 4; ++i) *(LAS u32x4*)(hist + 4 * lane + 256 * i) = (u32x4){0u, 0u, 0u, 0u};
            const int lo0 = rdlane(lo, 0), lo1 = rdlane(lo, 16), lo2 = rdlane(lo, 32), lo3 = rdlane(lo, 48);
#pragma unroll 1
            for (int kt0 = 0; kt0 <= ktl; kt0 += 4) {
                u32x2 cw[4];
#pragma unroll
                for (int j = 0; j < 4; ++j) { const int kt = kt0 + j < ktl ? kt0 + j : ktl; cw[j] = kc[64 * kt]; }
#pragma unroll
                for (int j = 0; j < 4; ++j) {
                    const int kt = kt0 + j;
                    if (kt <= ktl) {
                        const int sk = kt * 64 + lane;
#pragma unroll
                        for (int q = 0; q < 4; ++q) {
                            const unsigned k16 = q == 0 ? (cw[j].x & 0xffffu) : (q == 1 ? (cw[j].x >> 16) : (q == 2 ? (cw[j].y & 0xffffu) : (cw[j].y >> 16)));
                            const unsigned d = k16 - (unsigned)(q == 0 ? lo0 : (q == 1 ? lo1 : (q == 2 ? lo2 : lo3)));
                            if (d < 256u && (kt < ktl || sk <= t0 + q)) __hip_atomic_fetch_add(hist + q * 256 + d, 1u, __ATOMIC_RELAXED, __HIP_MEMORY_SCOPE_WORKGROUP);
                        }
                    }
                }
            }
        }
#pragma unroll
        for (int q = 0; q < 4; ++q) {
            const u32x4 w0 = *(const LAS u32x4*)(hist + q * 256 + 4 * lane);
            const unsigned cn[4] = {w0.x, w0.y, w0.z, w0.w};
            const unsigned sum = (cn[0] + cn[1]) + (cn[2] + cn[3]);
            const unsigned pre = wave_prefix_u32(sum);
            const unsigned v = (unsigned)rdlane((int)pre, 63) - pre + sum;
            const int needq = rdlane(need, 16 * q);
            const unsigned long long ball = __ballot((int)v >= needq);
            const int Ls = 63 - __builtin_clzll(ball | 1ull);
            const int rem = needq - rdlane((int)(v - sum), Ls);
            int c = 0, bsel = 0, abv = 0, cb = 0; bool found = false;
#pragma unroll
            for (int i = 3; i >= 0; --i) { const int ci = (int)cn[i]; const bool hit = !found && (c + ci >= rem); if (hit) { bsel = i; abv = c; cb = ci; } found = found || hit; c += ci; }
            const int bstar = 4 * Ls + rdlane(bsel, Ls), above = rdlane((int)(v - sum), Ls) + rdlane(abv, Ls), cnt = rdlane(cb, Ls);
            if (qi == q) { lo += bstar << shift; need -= above; ties = cnt; }
        }
        if ((DUPA & 8) && lvl == 1 && l1rep == 0) { l1rep = 1; lvl = 0; }
    }
    int Tq[4], rq[4], tsq[4]; bool slq[4];
#pragma unroll
    for (int q = 0; q < 4; ++q) { int a = rdlane(lo, 16 * q), b = rdlane(need, 16 * q), c = rdlane(ties, 16 * q);
        asm volatile("" : "+v"(a), "+v"(b), "+v"(c));
        Tq[q] = a; rq[q] = b; slq[q] = c != b; tsq[q] = 0; }
    __syncthreads();
    const int c = lane & 31, hh = lane >> 5, qa = c >> 3, h = c & 7;
    bf16x8 qf[4];
    { const bf16* qrow = X.aq() + (tok0 + qa) * 512 + h * 64 + 8 * hh;
#pragma unroll
      for (int ks = 0; ks < 4; ++ks) qf[ks] = *(const bf16x8*)(qrow + 16 * ks); }
    f32x16 ot[2] = {zero16(), zero16()}; float l = 0.f;
    const LAS float* tabh = tabA + h * TABS + 64;
    const float bfar = tabh[1599];
    const int kvoff = c * TSTR + 8 * hh;
    if (compact) {
        LAS unsigned short* lidx = (LAS unsigned short*)(lds + A_LIST + wave * A_LSTR); LAS unsigned short* loff = lidx + A_LCAP;
        LAS bf16* Kb = (LAS bf16*)(lds + wave * A_WBUF); LAS bf16* Vb = Kb + 32 * TSTR;
        const int grow = lane >> 3, gch = (lane & 7) * 8;
        const int m16 = lane & 15, g16 = lane >> 4;
        const LAS bf16* vtr0 = Vb + (4 * (g16 >> 1) + (m16 >> 2)) * TSTR + 16 * (g16 & 1) + 4 * (m16 & 3);
        const LAS unsigned char* tabq = lds + P2_TABA + (h * TABS + qa) * 4;
        const LAS unsigned short* loq = loff + qa * A_LCAP;
        u32x4 gk[4], gv[4];
#pragma unroll 1
        for (int repm = 0; repm < ((DUPA & 16) ? 2 : 1); ++repm) {
        if ((DUPA & 16) && repm == 1) { ot[0] = zero16(); ot[1] = zero16(); l = 0.f; tsq[0] = tsq[1] = tsq[2] = tsq[3] = 0; }
        int n = 0, kt = 0; bool inflight = false;
        u32x2 cwn = kc[0];
#pragma unroll 1
        for (;;) {
#pragma unroll 1
            while (kt <= ktl && n <= A_FILL) {
                const int s0 = kt * 64; const u32x2 cw = cwn;
                if (kt < ktl) cwn = kc[64 * (kt + 1)];
                const int kq[4] = {(int)(cw.x & 0xffffu), (int)(cw.x >> 16), (int)(cw.y & 0xffffu), (int)(cw.y >> 16)};
                unsigned nib = 0u;
#pragma unroll
                for (int q = 0; q < 4; ++q) {
                    const bool causal = (kt < ktl) || (s0 + lane <= t0 + q);
                    bool sel;
                    if (!slq[q]) sel = causal && kq[q] >= Tq[q];
                    else {
                        const unsigned long long be = __ballot(causal && kq[q] == Tq[q]);
                        const int below = (int)__builtin_amdgcn_mbcnt_hi((unsigned)(be >> 32), __builtin_amdgcn_mbcnt_lo((unsigned)be, 0u));
                        sel = causal && (kq[q] > Tq[q] || (kq[q] == Tq[q] && tsq[q] + below < rq[q]));
                        tsq[q] += __builtin_popcountll(be);
                    }
                    nib |= sel ? (1u << q) : 0u;
                }
                const unsigned long long bu = __ballot(nib != 0u);
                const int pos = n + (int)__builtin_amdgcn_mbcnt_hi((unsigned)(bu >> 32), __builtin_amdgcn_mbcnt_lo((unsigned)bu, 0u));
                if (nib != 0u) {
                    int e = t0 - (s0 + lane); e = e > 1596 ? 1596 : e;
                    const unsigned off = (unsigned)(e + 64) * 4u;
                    lidx[pos] = (unsigned short)(s0 + lane);
#pragma unroll
                    for (int q = 0; q < 4; ++q) loff[q * A_LCAP + pos] = (unsigned short)(((nib >> q) & 1u) ? off : 0u);
                }
                n += __builtin_popcountll(bu);
                ++kt;
            }
            const bool last = kt > ktl;
            int nb;
            if (last) { nb = (n + 31) >> 5; const int p = n + lane;
                if (p < 32 * nb) { lidx[p] = (unsigned short)t0; loff[p] = 0; loff[A_LCAP + p] = 0; loff[2 * A_LCAP + p] = 0; loff[3 * A_LCAP + p] = 0; } }
            else nb = (n >> 5) - 1;
            asm volatile("" ::: "memory");
            if (!inflight) {
#pragma unroll
                for (int i = 0; i < 4; ++i) { const int sk = lidx[grow + 8 * i]; const bf16* rp = kg + (size_t)sk * 128 + gch; gk[i] = *(const u32x4*)rp; gv[i] = *(const u32x4*)(rp + 64); }
            }
#pragma unroll 1
            for (int blkc = 0; blkc < nb; ++blkc) {
#pragma unroll
                for (int i = 0; i < 4; ++i) { *(LAS u32x4*)(Kb + (grow + 8 * i) * TSTR + gch) = gk[i]; *(LAS u32x4*)(Vb + (grow + 8 * i) * TSTR + gch) = gv[i]; }
                asm volatile("" ::: "memory");
                if (blkc + 1 < nb || !last) {
#pragma unroll
                    for (int i = 0; i < 4; ++i) { const int sk = lidx[32 * (blkc + 1) + grow + 8 * i]; const bf16* rp = kg + (size_t)sk * 128 + gch; gk[i] = *(const u32x4*)rp; gv[i] = *(const u32x4*)(rp + 64); }
                }
                bf16x8 kf[4], vf[2][2];
#pragma unroll
                for (int ks = 0; ks < 4; ++ks) kf[ks] = *(const LAS bf16x8*)(Kb + c * TSTR + 8 * hh + 16 * ks);
                u32x2 ow[4];
#pragma unroll
                for (int j = 0; j < 4; ++j) ow[j] = *(const LAS u32x2*)(loq + 32 * blkc + 8 * j + 4 * hh);
#pragma unroll
                for (int db = 0; db < 2; ++db)
#pragma unroll
                    for (int s2 = 0; s2 < 2; ++s2) {
                        const s16x4_t lo4 = __builtin_bit_cast(s16x4_t, __builtin_amdgcn_ds_read_tr16_b64_v4i16((LAS v4i16_t*)(vtr0 + (16 * s2) * TSTR + 32 * db)));
                        const s16x4_t hi4 = __builtin_bit_cast(s16x4_t, __builtin_amdgcn_ds_read_tr16_b64_v4i16((LAS v4i16_t*)(vtr0 + (16 * s2 + 8) * TSTR + 32 * db)));
                        vf[db][s2] = (bf16x8){lo4[0], lo4[1], lo4[2], lo4[3], hi4[0], hi4[1], hi4[2], hi4[3]};
                    }
                f32x16 st;
#pragma unroll
                for (int j = 0; j < 4; ++j)
#pragma unroll
                    for (int i2 = 0; i2 < 4; ++i2) {
                        const unsigned off = ((i2 < 2 ? ow[j].x : ow[j].y) >> (16 * (i2 & 1))) & 0xffffu;
                        st[4 * j + i2] = *(const LAS float*)(tabq + off);
                    }
                __builtin_amdgcn_sched_barrier(0);
#pragma unroll
                for (int ks = 0; ks < 4; ++ks) st = mfma32(kf[ks], qf[ks], st);
                bf16x8 pb[2];
                exp_pack_sum(st, pb, l);
#pragma unroll
                for (int db = 0; db < 2; ++db)
#pragma unroll
                    for (int s2 = 0; s2 < 2; ++s2) ot[db] = mfma32(vf[db][s2], pb[s2], ot[db]);
                asm volatile("" ::: "memory");
            }
            if (last) break;
            { const int src = 32 * nb + lane; const bool mv = src < n;
              unsigned short vi = 0, v0 = 0, v1 = 0, v2 = 0, v3 = 0;
              if (mv) { vi = lidx[src]; v0 = loff[src]; v1 = loff[A_LCAP + src]; v2 = loff[2 * A_LCAP + src]; v3 = loff[3 * A_LCAP + src]; }
              asm volatile("" ::: "memory");
              if (mv) { lidx[lane] = vi; loff[lane] = v0; loff[A_LCAP + lane] = v1; loff[2 * A_LCAP + lane] = v2; loff[3 * A_LCAP + lane] = v3; }
              asm volatile("" ::: "memory"); }
            n -= 32 * nb; inflight = true;
        }
        }
        __syncthreads();
    } else {
    tile_st((LAS bf16*)lds, tid, pf0); tile_st((LAS bf16*)(lds + TILE_LDS), tid, pf1);
        u32x2 cwn = kc[0];
        __syncthreads();
    #pragma unroll 1
        for (int kt = 0; kt <= ktl; ++kt) {
            const int s0 = kt * 64; const bool more = kt < ktl;
            u32x4 rk, rv;
            const u32x2 cw = cwn;
            if (more) { rk = tile_ld(kg + (size_t)(kt + 1) * 8192, 128, tid); rv = tile_ld(vg + (size_t)(kt + 1) * 4096, 64, tid); cwn = kc[64 * (kt + 1)]; }
            const LAS bf16* kb_ = (const LAS bf16*)(lds + (kt & 1) * (2 * TILE_LDS)); const LAS bf16* vb_ = kb_ + 64 * TSTR;
            const int kq[4] = {(int)(cw.x & 0xffffu), (int)(cw.x >> 16), (int)(cw.y & 0xffffu), (int)(cw.y >> 16)};
            unsigned long long bq[4];
    #pragma unroll
            for (int q = 0; q < 4; ++q) {
                const bool causal = (kt < ktl) || (s0 + lane <= t0 + q);
                if (!slq[q]) bq[q] = __ballot(causal && kq[q] >= Tq[q]);
                else {
                    const unsigned long long be = __ballot(causal && kq[q] == Tq[q]);
                    const int below = (int)__builtin_amdgcn_mbcnt_hi((unsigned)(be >> 32), __builtin_amdgcn_mbcnt_lo((unsigned)be, 0u));
                    bq[q] = __ballot(causal && (kq[q] > Tq[q] || (kq[q] == Tq[q] && tsq[q] + below < rq[q])));
                    tsq[q] += __builtin_popcountll(be);
                }
            }
            const unsigned long long mq = qa == 0 ? bq[0] : (qa == 1 ? bq[1] : (qa == 2 ? bq[2] : bq[3]));
            const unsigned mw[2] = {(unsigned)mq >> (4 * hh), (unsigned)(mq >> 32) >> (4 * hh)};
            const bool farT = (s0 + 63 <= t0 - 1512);
    #pragma unroll
            for (int kb = 0; kb < 2; ++kb) {
                bf16x8 pb[2];
                if (farT) qks32_ls<2, 1>(kb_ + kvoff + 32 * kb * TSTR, qf, nullptr, bfar, mw[kb], pb, l);
                else qks32_ls<1, 1>(kb_ + kvoff + 32 * kb * TSTR, qf, tabh + (t0 + qa - s0 - 4 * hh - 32 * kb) - 27, 0.f, mw[kb], pb, l);
                pv32_l(ot, vb_ + kvoff + 32 * kb, pb);
            }
            if (more) { LAS bf16* nb_ = (LAS bf16*)(lds + ((kt + 1) & 1) * (2 * TILE_LDS)); tile_st(nb_, tid, rk); tile_st(nb_ + 64 * TSTR, tid, rv); }
            __syncthreads();
        }
    }
    l = xsum32(l);
    const float inv = 1.f / fmaxf(l, 1e-30f);
    bf16* op = X.oa() + (tok0 + qa) * 512 + h * 64 + 4 * hh;
#pragma unroll
    for (int db = 0; db < 2; ++db)
#pragma unroll
        for (int q4 = 0; q4 < 4; ++q4) { u32x2 wv; wv.x = cvt_pk_bf16(ot[db][4 * q4] * inv, ot[db][4 * q4 + 1] * inv); wv.y = cvt_pk_bf16(ot[db][4 * q4 + 2] * inv, ot[db][4 * q4 + 3] * inv);
            *(u32x2*)(op + 32 * db + 8 * q4) = wv; }
}

__device__ __forceinline__ void ob_flush(bf16* op, const f32x16 (&acc)[2], float sc, bool add) {
#pragma unroll
    for (int db = 0; db < 2; ++db)
#pragma unroll
        for (int q4 = 0; q4 < 4; ++q4) {
            float v[4];
#pragma unroll
            for (int j = 0; j < 4; ++j) v[j] = sc * acc[db][4 * q4 + j];
            if (add) { const u32x2 o = *(const u32x2*)(op + 32 * db + 8 * q4);
                v[0] += __uint_as_float(o.x << 16); v[1] += __uint_as_float(o.x & 0xffff0000u); v[2] += __uint_as_float(o.y << 16); v[3] += __uint_as_float(o.y & 0xffff0000u); }
            u32x2 wv; wv.x = cvt_pk_bf16(v[0], v[1]); wv.y = cvt_pk_bf16(v[2], v[3]);
            *(u32x2*)(op + 32 * db + 8 * q4) = wv; }
}
constexpr int P3_TABB = 65536, P3_SCR = P3_TABB + 8 * TABS * 4, P3_UM = P3_SCR + 8 * 4096, P3_END = P3_UM + 64;
__device__ __forceinline__ void mixB_unit(const Ctx& X, LAS unsigned char* lds, int bl, int g, int it, int tid) {
    const int lane = tid & 63, wave = __builtin_amdgcn_readfirstlane(tid >> 6);
    const LAS float* tabB = (const LAS float*)(lds + P3_TABB);
    LAS unsigned* scr = (LAS unsigned*)(lds + P3_SCR + wave * 4096);
    LAS unsigned long long* um = (LAS unsigned long long*)(lds + P3_UM);
    const int t0 = 64 * it + 8 * wave;
    const int c = lane & 31, hh = lane >> 5, qa = c >> 2, h = c & 3, head = 4 * g + h, t = t0 + qa;
    const size_t tok = (size_t)bl * SEQ + t;
    const int bg = bl * 2 + g;
    bf16x8 qf[4];
    { const bf16* qrow = X.bq() + tok * 512 + head * 64 + 8 * hh;
#pragma unroll
      for (int ks = 0; ks < 4; ++ks) qf[ks] = *(const bf16x8*)(qrow + 16 * ks); }
    const float g0 = X.misc()[tok * 32 + 4 + head * 3 + 0], g1 = X.misc()[tok * 32 + 4 + head * 3 + 1], g2 = X.misc()[tok * 32 + 4 + head * 3 + 2];
    f32x16 out[2] = {zero16(), zero16()};
    const int kvoff = c * TSTR + 8 * hh;
#define KBUF(b) ((LAS bf16*)(lds + (b) * 2 * TILE_LDS))
#define VBUF(b) ((LAS bf16*)(lds + (b) * 2 * TILE_LDS + TILE_LDS))
    const int nmW = ((64 * it + 63) - 31) >> 4;
    const int nmw = ((t0 + 7) - 31) >> 4, nm = (t - 31) >> 4;
    const int nblw = nmw >> 5;
    LAS float* impb = (LAS float*)scr;
#pragma unroll
    for (int i = 0; i < 8; ++i) impb[lane + 64 * i] = 0.f;
    if (nmW >= 0) {
        const int ntl = nmW >> 6;
        const bf16* kcg = X.kcmp() + (size_t)bg * 256 * 64;
        const bf16* vcg = X.vcmpt() + (size_t)bg * 64 * 256;
        float lc = 0.f; u32x4 pfk, pfv;
        { const u32x4 r0 = tile_ld(kcg, 64, tid); tile_st(KBUF(0), tid, r0); }
        __syncthreads();
#pragma unroll 1
        for (int tl = 0; tl <= ntl; ++tl) {
            u32x4 rk; const bool more = tl < ntl;
            if (more) rk = tile_ld(kcg + (size_t)(tl + 1) * 4096, 64, tid);
            else { pfk = tile_ld(kcg, 64, tid); pfv = tile_ld(vcg, 256, tid); }
#pragma unroll
            for (int kb = 0; kb < 2; ++kb) {
                const int nb = 2 * tl + kb;
                if (nb <= nblw) {
                    const f32x16 st = qk32_l(KBUF(tl & 1) + kvoff + 32 * kb * TSTR, qf);
                    const unsigned keep = keep_le(nm - 32 * nb - 4 * hh);
#pragma unroll
                    for (int r = 0; r < 16; ++r) { const int sel = ((int)(keep << (31 - ROWC(r)))) >> 31; lc += __builtin_bit_cast(float, __builtin_bit_cast(int, __builtin_amdgcn_exp2f(st[r])) & sel); }
                }
            }
            if (more) tile_st(KBUF((tl + 1) & 1), tid, rk);
            __syncthreads();
        }
        lc = xsum32(lc);
        const float invc = lc > 0.f ? 1.f / lc : 0.f;
        f32x16 oc[2] = {zero16(), zero16()};
        float carry = 0.f;
        tile_st(KBUF(0), tid, pfk); tile_st(VBUF(0), tid, pfv);
        __syncthreads();
#pragma unroll 1
        for (int tl = 0; tl <= ntl; ++tl) {
            u32x4 rk, rv; const bool more = tl < ntl;
            if (more) { rk = tile_ld(kcg + (size_t)(tl + 1) * 4096, 64, tid); rv = tile_ld(vcg + (tl + 1) * 64, 256, tid); }
#pragma unroll
            for (int kb = 0; kb < 2; ++kb) {
                const int nb = 2 * tl + kb;
                if (nb <= nblw) {
                    const f32x16 st = qk32_l(KBUF(tl & 1) + kvoff + 32 * kb * TSTR, qf);
                    const unsigned keep = keep_le(nm - 32 * nb - 4 * hh);
                    float p[16];
#pragma unroll
                    for (int r = 0; r < 16; ++r) { const int sel = ((int)(keep << (31 - ROWC(r)))) >> 31; p[r] = __builtin_bit_cast(float, __builtin_bit_cast(int, __builtin_amdgcn_exp2f(st[r])) & sel) * invc; }
                    bf16x8 pb[2];
#pragma unroll
                    for (int s = 0; s < 2; ++s) { u32x4 wv; wv.x = cvt_pk_bf16(p[8 * s + 0], p[8 * s + 1]); wv.y = cvt_pk_bf16(p[8 * s + 2], p[8 * s + 3]); wv.z = cvt_pk_bf16(p[8 * s + 4], p[8 * s + 5]); wv.w = cvt_pk_bf16(p[8 * s + 6], p[8 * s + 7]);
                        pb[s] = __builtin_bit_cast(bf16x8, wv); }
                    pv32_l(oc, VBUF(tl & 1) + kvoff + 32 * kb, pb);
                    float rc[4];
#pragma unroll
                    for (int qd = 0; qd < 4; ++qd) rc[qd] = partner32(p[4 * qd + 3], hh);
#pragma unroll
                    for (int qd = 0; qd < 4; ++qd) {
                        const float ex = hh ? rc[qd] : (qd == 0 ? carry : rc[qd - 1]);
                        float v = (p[4 * qd] + p[4 * qd + 1]) + (p[4 * qd + 2] + p[4 * qd + 3]) + ex;
                        v = xsum1(v); v = xsum2(v);
                        if (h == 0) impb[qa * 64 + 8 * nb + 2 * qd + hh] = v;
                    }
                    carry = rc[3];
                }
            }
            if (more) { tile_st(KBUF((tl + 1) & 1), tid, rk); tile_st(VBUF((tl + 1) & 1), tid, rv); }
            __syncthreads();
        }
#pragma unroll
        for (int db = 0; db < 2; ++db)
#pragma unroll
            for (int r = 0; r < 16; ++r) out[db][r] = g0 * oc[db][r];
    }
    const bf16* ksg = X.bks() + (size_t)bg * SEQ * 64; const bf16* vsg = X.bvst() + (size_t)bg * SEQ * 64;
    const u32x4 ps0 = tile_ld(ksg, 64, tid), ps1 = tile_ld(vsg, 64, tid);
    LAS unsigned long long* selm = (LAS unsigned long long*)(scr + 512);
    unsigned long long ormask = 0ull;
#pragma unroll 1
    for (int q0 = 0; q0 < 8; q0 += 4) {
        const int m = lane;
        unsigned key[4], Tq[4];
#pragma unroll
        for (int j = 0; j < 4; ++j) {
            const float iv = impb[(q0 + j) * 64 + m];
            key[j] = 0u; Tq[j] = 0u;
            if (m <= it) { const bool forced = (m == 0) || (m == it) || (m == it - 1);
                key[j] = forced ? (0xffffff00u | (unsigned)(63 - m)) : ((__builtin_bit_cast(unsigned, iv) & ~63u) | (unsigned)(63 - m)); }
        }
#pragma unroll 1
        for (int bit = 31; bit >= 0; --bit) {
#pragma unroll
            for (int j = 0; j < 4; ++j) { const unsigned cand = Tq[j] | (1u << bit); if (__builtin_popcountll(__ballot(key[j] >= cand)) >= 16) Tq[j] = cand; }
        }
#pragma unroll
        for (int j = 0; j < 4; ++j) {
            const unsigned long long mk = __ballot(key[j] >= Tq[j] && key[j] != 0u);
            if (lane == 0) selm[q0 + j] = mk;
            ormask |= mk;
        }
    }
    const unsigned long long mymask = selm[qa];
    if (lane == 0) um[wave] = ormask;
    __syncthreads();
    unsigned long long U = 0ull;
#pragma unroll
    for (int i = 0; i < 8; ++i) U |= um[i];
    const LAS float* tabh = tabB + head * TABS + 64;
    const float bfar = tabh[1599];
    const bf16* kwg = X.bkw() + (size_t)bg * SEQ * 64; const bf16* vwg = X.bvwt() + (size_t)bg * SEQ * 64;
    int m0W = (64 * it - 511) >> 6; if (m0W < 0) m0W = 0;
    u32x4 pw0, pw1;
    {
        f32x16 os[2] = {zero16(), zero16()}; float ls = 0.f;
        const bf16* kg = ksg; const bf16* vg = vsg;
        int m = 0;
        tile_st(KBUF(0), tid, ps0); tile_st(VBUF(0), tid, ps1);
        __syncthreads();
        int b = 0;
#pragma unroll 1
        for (;;) {
            const unsigned long long rest = (m >= 63) ? 0ull : (U >> (m + 1));
            const bool more = rest != 0ull; const int mn = more ? m + 1 + __builtin_ctzll(rest) : m;
            u32x4 rk, rv;
            if (more) { rk = tile_ld(kg + (size_t)mn * 4096, 64, tid); rv = tile_ld(vg + (size_t)mn * 4096, 64, tid); }
            else { pw0 = tile_ld(kwg + (size_t)m0W * 4096, 64, tid); pw1 = tile_ld(vwg + (size_t)m0W * 4096, 64, tid); }
            if ((ormask >> m) & 1ull) {
                const int s0 = m * 64;
                const unsigned lanekeep = ((mymask >> m) & 1ull) ? 0xffffffffu : 0u;
                const bool farT = (s0 + 63 <= t0 - 1512);
                const LAS float* bt = tabh + (t - s0 - 4 * hh) - 27;
                if (m == it) tile64_l<1, 1>(KBUF(b) + kvoff, VBUF(b) + kvoff, qf, bt, 0.f, lanekeep & keep_le(t - s0 - 4 * hh), lanekeep & keep_le(t - s0 - 32 - 4 * hh), os, ls);
                else if (farT) tile64_l<2, 2>(KBUF(b) + kvoff, VBUF(b) + kvoff, qf, nullptr, bfar, lanekeep, lanekeep, os, ls);
                else tile64_l<1, 2>(KBUF(b) + kvoff, VBUF(b) + kvoff, qf, bt, 0.f, lanekeep, lanekeep, os, ls);
            }
            if (more) { tile_st(KBUF(b ^ 1), tid, rk); tile_st(VBUF(b ^ 1), tid, rv); }
            __syncthreads();
            if (!more) break;
            m = mn; b ^= 1;
        }
        ls = xsum32(ls);
        const float sc = g1 / fmaxf(ls, 1e-30f);
#pragma unroll
        for (int db = 0; db < 2; ++db)
#pragma unroll
            for (int r = 0; r < 16; ++r) out[db][r] += sc * os[db][r];
    }
    {
        f32x16 ow[2] = {zero16(), zero16()}; float lw = 0.f;
        const bf16* kg = kwg; const bf16* vg = vwg;
        int m0 = (t0 - 511) >> 6; if (m0 < 0) m0 = 0;
        tile_st(KBUF(0), tid, pw0); tile_st(VBUF(0), tid, pw1);
        __syncthreads();
#pragma unroll 1
        for (int m = m0W; m <= it; ++m) {
            const int b = (m - m0W) & 1; const bool more = m < it;
            u32x4 rk, rv;
            if (more) { rk = tile_ld(kg + (size_t)(m + 1) * 4096, 64, tid); rv = tile_ld(vg + (size_t)(m + 1) * 4096, 64, tid); }
            if (m >= m0) {
                const int s0 = m * 64;
#pragma unroll
                for (int kb = 0; kb < 2; ++kb) {
                    bf16x8 pb[2];
                    if (s0 + 63 <= t0 && s0 >= t0 + 7 - 511)
                        qks32_ls<1, 0>(KBUF(b) + kvoff + 32 * kb * TSTR, qf, tabh + (t - s0 - 4 * hh - 32 * kb) - 27, 0.f, 0u, pb, lw);
                    else qks32_ls<1, 1>(KBUF(b) + kvoff + 32 * kb * TSTR, qf, tabh + (t - s0 - 4 * hh - 32 * kb) - 27, 0.f, keep_le(t - s0 - 32 * kb - 4 * hh) & keep_ge(t - 511 - s0 - 32 * kb - 4 * hh), pb, lw);
                    pv32_l(ow, VBUF(b) + kvoff + 32 * kb, pb);
                }
            }
            if (more) { tile_st(KBUF(b ^ 1), tid, rk); tile_st(VBUF(b ^ 1), tid, rv); }
            __syncthreads();
        }
        lw = xsum32(lw);
        const float sc = g2 / fmaxf(lw, 1e-30f);
#pragma unroll
        for (int db = 0; db < 2; ++db)
#pragma unroll
            for (int r = 0; r < 16; ++r) out[db][r] += sc * ow[db][r];
    }
#undef KBUF
#undef VBUF
    bf16* op = X.ob() + tok * 512 + head * 64 + 4 * hh;
#pragma unroll
    for (int db = 0; db < 2; ++db)
#pragma unroll
        for (int q4 = 0; q4 < 4; ++q4) { u32x2 wv; wv.x = cvt_pk_bf16(out[db][4 * q4], out[db][4 * q4 + 1]); wv.y = cvt_pk_bf16(out[db][4 * q4 + 2], out[db][4 * q4 + 3]);
            *(u32x2*)(op + 32 * db + 8 * q4) = wv; }
}

constexpr int NWAVES = 8;
constexpr int LDS_BYTES = 163840, LDSCTL_OFF = 162816, MISC_OFF = LDSCTL_OFF + 320;
static_assert(P2_END <= LDSCTL_OFF && P3_END <= LDSCTL_OFF, "LDS map");
constexpr int CW_BAR = 4096, CW_QUEUE = 16384;
constexpr int PH_PER = 7;

__global__ void __launch_bounds__(NWAVES * 64, 2) mk_fwd(Args args) {
    extern __shared__ __attribute__((aligned(16))) unsigned char lds_raw[];
    LAS unsigned char* lds = (LAS unsigned char*)lds_raw;
    volatile LAS unsigned* MISCW = (volatile LAS unsigned*)(lds + MISC_OFF);
    const int tid = threadIdx.x, lane = tid & 63, wave = __builtin_amdgcn_readfirstlane(tid >> 6);
    constexpr int T = TCH;
    unsigned char* ws = args.ws;
    unsigned* ctl = (unsigned*)(ws + MP.ctl);
    for (int u = tid; u < (LDS_BYTES - LDSCTL_OFF) / 4; u += NWAVES * 64) ((LAS unsigned*)(lds + LDSCTL_OFF))[u] = 0u;
    __syncthreads();
    XcdBarrier bar; bar.bar = ctl + CW_BAR; bar.x = 0; bar.st = nullptr;
    if (MK_SINGLE) bar = xcd_barrier_post(ctl + CW_BAR, MISCW + 8);
    const int lo = args.ph_lo, hi = args.ph_hi;
#define IN(k) (lo <= (k) && (k) < hi)
#define SEAM(k) do { if (IN(k) && IN((k) + 1)) { xcd_barrier(bar); if (DUP & 128) xcd_barrier(bar); } } while (0)
#define GWVARS const int vcu = (G % 8 == 0) ? (bx % 8) * (G / 8) + bx / 8 : bx, gw = vcu * NWAVES + wave, NGW = G * NWAVES; (void)gw; (void)NGW;

    constexpr int TAILW0 = 192;
    auto conv_items = [&](int first, int stride, int NI, int lane, LAS float* scr) __attribute__((always_inline)) {
            auto item_load = [&](int itg, f32x4 (&vv)[8], float (&gg)[8], int& oK, int& ok0, int& on0, bf16*& odst, int& ofl) __attribute__((always_inline)) {
                const int l = itg / NL; int it = itg % NL, mi = 0;
#pragma unroll
                for (int q = 0; q < 9; ++q) if (mi == q && it >= nitm_of(ord_of(q))) { it -= nitm_of(ord_of(q)); mi = q + 1; }
                mi = ord_of(mi);
                const float* win = args.in[3] + (size_t)l * DM * IN_TOTAL;
                const float* src; int K, Nsrc, Nd; const float* gk = nullptr;
                switch (mi) {
                    case W_IN: src = win; K = DM; Nsrc = IN_TOTAL; Nd = N_MAIN; gk = args.in[1] + l * DM; break;
                    case W_VT: src = win; K = DM; Nsrc = IN_TOTAL; Nd = N_VT; gk = args.in[1] + l * DM; break;
                    case W_BA: src = args.in[7] + (size_t)l * 512 * DM; K = 512; Nsrc = DM; Nd = DM; break;
                    case W_BB: src = args.in[8] + (size_t)l * 512 * DM; K = 512; Nsrc = DM; Nd = DM; break;
                    case W_BC: src = args.in[9] + (size_t)l * 256 * DM; K = 256; Nsrc = DM; Nd = DM; break;
                    case W_OUT: src = args.in[10] + (size_t)l * DM * DM; K = DM; Nsrc = DM; Nd = DM; break;
                    case W_FI: src = args.in[11] + (size_t)l * DM * N_FF2; K = DM; Nsrc = N_FF2; Nd = N_FF2; gk = args.in[2] + l * DM; break;
                    case W_FO: src = args.in[12] + (size_t)l * DFF * DM; K = DFF; Nsrc = DM; Nd = DM; break;
                    case W_CK: src = args.in[6] + (size_t)(l * 2 + 0) * 2048 * 64; K = 2048; Nsrc = 64; Nd = 256; break;
                    default:   src = args.in[6] + (size_t)(l * 2 + 1) * 2048 * 64; K = 2048; Nsrc = 64; Nd = 256; break;
                }
                bf16* dst = (bf16*)(ws + MP.w[0][0] + (size_t)l * (MP.w[1][0] - MP.w[0][0])) ;
                { size_t off = 0;
#pragma unroll
                  for (int q = 0; q < 10; ++q) if (q == mi) off = MP.w[0][q] - MP.w[0][0];
                  dst = (bf16*)((unsigned char*)dst + off); }
                const int nblk = Nd / 32, kb = it / nblk, nb = it % nblk, row = nb * 32 + 4 * (lane & 7);
                int sc;
                if (mi == W_IN) sc = main_src(row); else if (mi == W_VT) sc = vt_src(row); else if (mi == W_FI) sc = ffn_src(row);
                else if (mi == W_CK) sc = (((row & 127) >> 5) == 0) ? (32 * ((row & 255) >> 7) + (row & 31)) : -1;
                else if (mi == W_CV) sc = row < 64 ? row : -1; else sc = row;
ti_load(src, Nsrc, kb * 64, sc < 0 ? 0 : sc, gk ? gk : args.in[1], lane, vv, gg); oK = K; ok0 = kb * 64; on0 = nb * 32; odst = dst; ofl = (gk ? 1 : 0) | (sc < 0 ? 2 : 0);
            };
            f32x4 va[8], vb[8]; float ga[8], gb[8]; int aK = 0, ak0 = 0, an0 = 0, bK = 0, bk0 = 0, bn0 = 0, afl = 0, bfl = 0; bf16* adst = nullptr; bf16* bdst = nullptr;
            int itg = first; bool hA = itg < NI;
            if (hA) item_load(itg, va, ga, aK, ak0, an0, adst, afl);
#pragma unroll 1
            while (hA) {
                const bool hB = itg + stride < NI;
                if (hB) item_load(itg + stride, vb, gb, bK, bk0, bn0, bdst, bfl);
                ti_finish(va, ga, afl, aK, adst, scr, ak0, an0, lane);
                if (!hB) break;
                itg += 2 * stride; hA = itg < NI;
                if (hA) item_load(itg, va, ga, aK, ak0, an0, adst, afl);
                ti_finish(vb, gb, bfl, bK, bdst, scr, bk0, bn0, lane);
            }
    };

#pragma unroll 1
    for (int rep0 = 0; rep0 < ((DUP & 64) ? 2 : 1); ++rep0)
    if (IN(0) && (PHMASK & 1)) {
        const int G = gridDim.x, bx = blockIdx.x; GWVARS
        float* biasA = (float*)(ws + MP.biasA); float* biasB = (float*)(ws + MP.biasB); float* biasC = (float*)(ws + MP.biasC); float* cmpb = (float*)(ws + MP.cmpb);
        bf16* XB = (bf16*)(ws + MP.xb); float* SSQ1 = (float*)(ws + MP.ssq1);
        LAS float* scr = (LAS float*)(lds + wave * 16384);
        conv_items(gw, NGW, G > TAILW0 ? NF : NLAYER * NL, lane, scr);
        {
            bf16* XB = (bf16*)(ws + MP.xb); float* SSQ1 = (float*)(ws + MP.ssq1);
            auto xload = [&](f32x4 (&d)[2][4], int r) {
#pragma unroll
                for (int h = 0; h < 2; ++h) { const f32x4* xr = (const f32x4*)(args.in[0] + (size_t)(r + h * (NTOK / 2)) * DM) + lane;
#pragma unroll
                    for (int j = 0; j < 4; ++j) d[h][j] = __builtin_nontemporal_load(&xr[64 * j]); }
            };
            auto xproc = [&](const f32x4 (&d)[2][4], int r) {
#pragma unroll
                for (int h = 0; h < 2; ++h) { const size_t row = (size_t)(r + h * (NTOK / 2)); float sq = 0.f;
                    unsigned long long* o8 = (unsigned long long*)(XB + row * DM) + lane;
#pragma unroll
                    for (int j = 0; j < 4; ++j) { const f32x4 x = d[h][j]; sq += (x[0] * x[0] + x[1] * x[1]) + (x[2] * x[2] + x[3] * x[3]);
                        o8[64 * j] = (unsigned long long)pk2(x[0], x[1]) | ((unsigned long long)pk2(x[2], x[3]) << 32); }
                    sq = wave_sum(sq);
                    if (lane < 16) SSQ1[row * 16 + lane] = lane == 0 ? sq : 0.f; }
            };
            f32x4 xa[2][4], xbuf[2][4];
            int r = gw; bool hA = r < NTOK / 2;
            if (hA) xload(xa, r);
#pragma unroll 1
            while (hA) {
                const bool hB = r + NGW < NTOK / 2;
                if (hB) xload(xbuf, r + NGW);
                xproc(xa, r);
                if (!hB) break;
                const int r1 = r + NGW; r += 2 * NGW; hA = r < NTOK / 2;
                if (hA) xload(xa, r);
                xproc(xbuf, r1);
            }
        }
        const float* rel = args.in[13];
        for (int i = bx * 512 + tid; i < 16 * TABS; i += G * 512) {
            const int hd = i / TABS, e = i % TABS, d = e - 64;
            const float v = d < 0 ? -30000.f   : (d >= 1600 ? 0.f : rel[rel_bucket(d) * 28 + hd] * LOG2E);
            if (hd < 8) biasA[hd * TABS + e] = v; else biasB[(hd - 8) * TABS + e] = v;
        }
        for (int i = bx * 512 + tid; i < 12 * TABC; i += G * 512) {
            const int j = i / TABC, e = i % TABC, jj = e - 32, dil = (j >> 2) == 0 ? 1 : ((j >> 2) == 1 ? 4 : 16);
            biasC[i] = (jj < 0 || jj > 128) ? 0.f : rel[rel_bucket(jj * dil) * 28 + 16 + j] * LOG2E;
        }
        for (int o = bx; o < NLAYER * 2 * 64; o += G) {
            const int lk = o >> 6, e = o & 63; const float* pos = args.in[5] + (size_t)lk * 2048; const float* wv = args.in[6] + (size_t)lk * 2048 * 64;
            float pv[4], wq[4];
#pragma unroll
            for (int i = 0; i < 4; ++i) { const int k = 256 * wave + 64 * i + lane; pv[i] = pos[k]; wq[i] = wv[(size_t)k * 64 + e]; }
            float sp = (pv[0] * wq[0] + pv[1] * wq[1]) + (pv[2] * wq[2] + pv[3] * wq[3]);
            sp = wave_sum(sp);
            LAS float* slot = (LAS float*)(lds + wave * 16384);
            if (lane == 0) slot[0] = sp;
            __syncthreads();
            if (tid == 0) { float t8 = 0.f;
#pragma unroll
                for (int w8 = 0; w8 < 8; ++w8) t8 += ((LAS float*)(lds + w8 * 16384))[0];
                cmpb[o] = t8; }
            __syncthreads();
        }
    }
    SEAM(0);

    constexpr int PH_LAYER = NCH * 4 + 3;
#pragma unroll 1
    for (int layer = 0; layer < NLAYER; ++layer) {
#pragma unroll 1
    for (int chk = 0; chk < NCH; ++chk) {
        const int lc = layer * NCH + chk;
        const int pb = 1 + layer * PH_LAYER + chk * 4;
#define LCVARS int lcp = lc; asm volatile("" : "+s"(lcp)); const int l = lcp / NCH, ch = lcp % NCH; const size_t row0 = (size_t)ch * T; const size_t lw = (size_t)l * (MP.w[1][0] - MP.w[0][0]); (void)row0; (void)lw; \
        const int G = gridDim.x, bx = blockIdx.x; (void)G; (void)bx; int tid = threadIdx.x; asm volatile("" : "+v"(tid)); const int lane = tid & 63; (void)lane;

        if (IN(pb + 0) && ((PHMASK >> 1) & 1)) { LCVARS
            const bf16* xbc = (const bf16*)(ws + MP.xb) + row0 * DM; const float* ssq1 = (const float*)(ws + MP.ssq1) + row0 * 16;
#pragma unroll 1
            for (int rep = 0; rep < ((DUP & 1) ? 2 : 1); ++rep)
            { pg8::GemmP1 g{xbc, (const bf16*)(ws + MP.w[0][W_IN] + lw), (const bf16*)(ws + MP.w[0][W_VT] + lw), }; pg8::P1Order<T> S; S.init(G, bx);
              EpiP1 E{ssq1, args.in[4] + (size_t)l * 6 * 64, ws};
              pg8::gemm_phase<EpiP1, pg8::GemmP1, pg8::P1Order<T>>(lds, g, S, E); }
        }
        if (IN(pb + 0) && ((PHMASK >> 1) & 1)) { LCVARS
            if (G > TAILW0 && bx >= TAILW0) {
                __syncthreads();
                const int wv = __builtin_amdgcn_readfirstlane(tid >> 6), cnt = l == 0 ? NL / 2 : (NL - NF) / 2, lo1 = (l == 0 ? NF : NF + NL) + ch * cnt;
                conv_items(lo1 + (bx - TAILW0) * NWAVES + wv, (G - TAILW0) * NWAVES, lo1 + cnt, lane, (LAS float*)(lds + wv * 16384));
            }
        }
        SEAM(pb + 0);

        if (IN(pb + 1) && ((PHMASK >> 2) & 1)) { LCVARS
            const float* cmpb = (const float*)(ws + MP.cmpb); const float* qkg = args.in[4] + (size_t)l * 6 * 64;
            { pg8::Gemm g{(const bf16*)(ws + MP.bkc), (const bf16*)(ws + MP.w[0][W_CK] + lw), NBC * 2 * 256, 256, 2048, 1024, 2048}; pg8::StaticOrder S; S.init(NBC * 2 * 256, 256, G, (bx < 64 && (bx & 7) == 0) ? (bx >> 3) : (1 << 20));
              EpiCmpK E{cmpb + (l * 2 + 0) * 64, qkg + 3 * 64, (bf16*)(ws + MP.kcmp)}; pg8::gemm_phase<EpiCmpK>(lds, g, S, E); }
            { pg8::Gemm g{(const bf16*)(ws + MP.w[0][W_CV] + lw), (const bf16*)(ws + MP.bvc), 256, NBC * 2 * 256, 2048, 2048, 1024}; pg8::StaticOrder S; S.init(256, NBC * 2 * 256, G, (bx < 64 && (bx & 7) == 2) ? (bx >> 3) : (1 << 20));
              EpiCmpV E{cmpb + (l * 2 + 1) * 64, (bf16*)(ws + MP.vcmpt)}; pg8::gemm_phase<EpiCmpV>(lds, g, S, E); }
            LAS float* tabA = (LAS float*)(lds + P2_TABA); LAS float* tabC = (LAS float*)(lds + P2_TABC);
            __syncthreads();
            { const f32x4* biasA = (const f32x4*)(ws + MP.biasA); constexpr int NA4 = 8 * TABS / 4;
              f32x4 va[(NA4 + 511) / 512];
#pragma unroll
              for (int q = 0; q < (NA4 + 511) / 512; ++q) { const int i = tid + 512 * q; va[q] = biasA[i < NA4 ? i : NA4 - 1]; }
#pragma unroll
              for (int q = 0; q < (NA4 + 511) / 512; ++q) { const int i = tid + 512 * q; if (i < NA4) ((LAS f32x4*)tabA)[i] = va[q]; } }
            __syncthreads();
            Ctx X{ws}; GWVARS
            unsigned char* kcache = (bx & 255) < 128 ? ws + MP.mb + (size_t)(NTOK / 2) * 1024 * 2 + (size_t)(bx & 255) * 262144 : ws + MP.end + (size_t)((bx & 255) - 128) * 262144;
#pragma unroll 1
            for (int rep = 0; rep < ((DUP & 2) ? 2 : 1); ++rep) {
            if ((DUP & 4096) && rep == 1) xcd_barrier(bar);
            if (MK_MIXERS & 2) {
                for (int pr0 = bx; pr0 < 64 * NBC; pr0 += G) {
                    int pr = pr0;
                    if (G == 256 && NBC == 4) { const int x = pr0 & 7, r = pr0 >> 3; pr = ((x >> 1) << 6) | ((x & 1) << 5) | r; }
                    const int bl = pr >> 6, i = pr & 63;
                    mixA_unit(X, lds, kcache, bl, i, tid);
                    mixA_unit(X, lds, kcache, bl, 127 - i, tid);
                }
            } }
            __syncthreads();
            { const f32x4* biasC = (const f32x4*)(ws + MP.biasC); constexpr int NC4 = 12 * TABC / 4;
              f32x4 vc[(NC4 + 511) / 512];
#pragma unroll
              for (int q = 0; q < (NC4 + 511) / 512; ++q) { const int i = tid + 512 * q; vc[q] = biasC[i < NC4 ? i : NC4 - 1]; }
#pragma unroll
              for (int q = 0; q < (NC4 + 511) / 512; ++q) { const int i = tid + 512 * q; if (i < NC4) ((LAS f32x4*)tabC)[i] = vc[q]; } }
            __syncthreads();
            if (MK_MIXERS & 1) {
                constexpr int nq = 12 * (T / 256);
#pragma unroll 1
                for (int repc = 0; repc < ((DUP & 4) ? 2 : 1); ++repc) {
                unsigned* qctr = ctl + CW_QUEUE + 64 * lcp + 16 * repc;
                LAS unsigned* tkw = (LAS unsigned*)(lds + MISC_OFF + 64);
                if (tid == 0) *tkw = __hip_atomic_fetch_add(qctr, 1u, __ATOMIC_RELAXED, __HIP_MEMORY_SCOPE_AGENT);
                __syncthreads();
                unsigned cur = *tkw;
#pragma unroll 1
                while (cur < (unsigned)nq) {
                    __syncthreads();
                    unsigned nxt = 0u;
                    if (tid == 0) nxt = __hip_atomic_fetch_add(qctr, 1u, __ATOMIC_RELAXED, __HIP_MEMORY_SCOPE_AGENT);
                    mixC_ticket(X, lds, tabC, (int)cur / (T / 256), (int)cur % (T / 256), tid);
                    if (tid == 0) *tkw = nxt;
                    __syncthreads();
                    cur = *tkw;
                }
                __syncthreads();
                }
            }
            __syncthreads();
        }
        SEAM(pb + 1);

        if (IN(pb + 2) && ((PHMASK >> 3) & 1)) { LCVARS
            LAS float* tabB = (LAS float*)(lds + P3_TABB);
            __syncthreads();
            { const f32x4* biasB = (const f32x4*)(ws + MP.biasB); constexpr int NB4 = 8 * TABS / 4;
              f32x4 vb[(NB4 + 511) / 512];
#pragma unroll
              for (int q = 0; q < (NB4 + 511) / 512; ++q) { const int i = tid + 512 * q; vb[q] = biasB[i < NB4 ? i : NB4 - 1]; }
#pragma unroll
              for (int q = 0; q < (NB4 + 511) / 512; ++q) { const int i = tid + 512 * q; if (i < NB4) ((LAS f32x4*)tabB)[i] = vb[q]; } }
            __syncthreads();
            Ctx X{ws}; GWVARS
#pragma unroll 1
            for (int rep = 0; rep < ((DUP & 8) ? 2 : 1); ++rep)
            if (MK_MIXERS & 4) {
                for (int pr0 = bx; pr0 < 64 * NBC; pr0 += G) {
                    int pr = pr0;
                    if (G == 256 && NBC == 4) pr = ((pr0 & 7) << 5) | (pr0 >> 3);
                    const int bgp = pr >> 5, i = pr & 31, bl = bgp >> 1, g = bgp & 1;
                    mixB_unit(X, lds, bl, g, i, tid);
                    mixB_unit(X, lds, bl, g, 63 - i, tid);
                }
            }
            if (MK_MIXERS & 1) mixC_combine(X, gw, NGW, lane);
            __syncthreads();
        }
        SEAM(pb + 2);

        if (IN(pb + 3) && ((PHMASK >> 4) & 1)) { LCVARS
#pragma unroll 1
            for (int jj = 0; jj < ((DUP & 16) ? 6 : 3); ++jj) {
                const int j = jj % 3;
                const int Kb = j == 2 ? 256 : 512;
                const bf16* Ao = (const bf16*)(ws + (j == 0 ? MP.oa : (j == 1 ? MP.ob : MP.oc)));
                pg8::Gemm g{Ao, (const bf16*)(ws + MP.w[0][W_BA] + lw + (size_t)j * (MP.w[0][W_BB] - MP.w[0][W_BA])), T, DM, Kb, Kb, Kb}; pg8::StaticOrder S; S.init(T, DM, G, bx);
                EpiBranch E{(const unsigned char*)(ws + MP.mixg) + j * 1024, (bf16*)(ws + MP.mb) + row0 * DM, j == 0 ? 1 : (j == 2 ? 2 : 0)};
                pg8::gemm_phase<EpiBranch>(lds, g, S, E);
            }
        }
        SEAM(pb + 3);
    }

        const int pf = 1 + layer * PH_LAYER + NCH * 4;
#define LVARS int lp = layer; asm volatile("" : "+s"(lp)); const int l = lp; const size_t lw = (size_t)l * (MP.w[1][0] - MP.w[0][0]); (void)lw; \
        const int G = gridDim.x, bx = blockIdx.x; (void)G; (void)bx; int tid = threadIdx.x; asm volatile("" : "+v"(tid)); (void)tid;
        if (IN(pf + 0) && ((PHMASK >> 5) & 1)) { LVARS
            pg8::Gemm g{(const bf16*)(ws + MP.mb), (const bf16*)(ws + MP.w[0][W_OUT] + lw), NTOK, DM, DM, DM, DM}; pg8::StaticOrder S; S.init(NTOK, DM, G, bx);
#pragma unroll 1
            for (int rep = ((DUP & 1024) ? 0 : 1); rep < 2; ++rep) {
            EpiRes E{(bf16*)(ws + MP.xb), nullptr, (float*)(ws + MP.ssq2), rep == 0 ? 1 : 0};
            pg8::gemm_phase<EpiRes>(lds, g, S, E); }
        }
        SEAM(pf + 0);

        if (IN(pf + 1) && ((PHMASK >> 6) & 1)) { LVARS
            pg8::Gemm g{(const bf16*)(ws + MP.xb), (const bf16*)(ws + MP.w[0][W_FI] + lw), NTOK, N_FF2, DM, DM, DM}; pg8::StaticOrder S; S.init(NTOK, N_FF2, G, bx);
            EpiSwiGLU E{(const float*)(ws + MP.ssq2), (bf16*)(ws + MP.hid)};
#pragma unroll 1
            for (int rep = 0; rep < ((DUP & 32) ? 2 : 1); ++rep)
            pg8::gemm_phase<EpiSwiGLU>(lds, g, S, E);
        }
        SEAM(pf + 1);

        if (IN(pf + 2) && ((PHMASK >> 7) & 1)) { LVARS
            pg8::Gemm g{(const bf16*)(ws + MP.hid), (const bf16*)(ws + MP.w[0][W_FO] + lw), NTOK, DM, DFF, DFF, DFF}; pg8::StaticOrder S; S.init(NTOK, DM, G, bx);
#pragma unroll 1
            for (int rep = ((DUP & 2048) ? 0 : 1); rep < 2; ++rep) {
            EpiRes E{(bf16*)(ws + MP.xb), l == NLAYER - 1 ? args.out : nullptr, (float*)(ws + MP.ssq1), rep == 0 ? 1 : 0};
            pg8::gemm_phase<EpiRes>(lds, g, S, E); }
        }
        SEAM(pf + 2);
    }
#undef IN
#undef SEAM
#undef LCVARS
#undef LVARS
#undef GWVARS
}

extern "C" void kernel_launch(void* const* d_in, const int* in_sizes, int n_in, void* d_out, int out_size, void* d_ws, size_t ws_size, hipStream_t stream) {
    static int grid = 0;
    if (grid == 0) {
        int dev = 0, cus = 0;
        if (hipGetDevice(&dev) != hipSuccess || hipDeviceGetAttribute(&cus, hipDeviceAttributeMultiprocessorCount, dev) != hipSuccess) { fprintf(stderr, "kernel_launch: device query failed\n"); grid = -1; return; }
        if (hipFuncSetAttribute((const void*)mk_fwd, hipFuncAttributeMaxDynamicSharedMemorySize, LDS_BYTES) != hipSuccess) { fprintf(stderr, "kernel_launch: hipFuncSetAttribute failed\n"); grid = -1; return; }
        (void)hipGetLastError();
        if (n_in != 14 || out_size != NTOK * DM || MP.end + (size_t)128 * 262144 > ws_size) { fprintf(stderr, "kernel_launch: unexpected problem (n_in %d, out %d, ws %zu, need %zu)\n", n_in, out_size, ws_size, (size_t)MP.end); grid = -1; return; }
        grid = cus < 256 ? cus : 256;
    }
    if (grid < 0) return;
    (void)hipMemsetAsync((char*)d_ws, 0, MiB, stream);
    Args a{};
    for (int i = 0; i < 14; ++i) a.in[i] = (const float*)d_in[i];
    a.out = (float*)d_out; a.ws = (unsigned char*)d_ws; a.nbc = NBC; a.li = 0;
    constexpr int nph = 1 + NLAYER * (NCH * 4 + 3);
#if MK_SINGLE
    a.ph_lo = 0; a.ph_hi = nph;
    hipLaunchKernelGGL(mk_fwd, dim3(grid), dim3(NWAVES * 64), LDS_BYTES, stream, a);
#else
    for (int p = 0; p < nph; ++p) { a.ph_lo = p; a.ph_hi = p + 1; hipLaunchKernelGGL(mk_fwd, dim3(grid), dim3(NWAVES * 64), LDS_BYTES, stream, a); }
#endif
    const hipError_t le = hipPeekAtLastError();
    if (le != hipSuccess) fprintf(stderr, "kernel_launch: launch failed: %s\n", hipGetErrorName(le));
}
```
